# Optimizing an MI355X kernel written in HIP

```python
import math
import jax, jax.numpy as jnp
from jax import lax
import numpy as np

D_MODEL = 1024
BATCH = 2
SEQ = 16384
DEPTH = 2
DEC_BATCH = 1
DEC_SEQ = 16384
PAST_LEN = 128

N_EVEN = (DEPTH + 1) // 2
N_ODD = DEPTH // 2
N_SUB = 3
D_FF = 2816
EPS = 1e-6
D_A = D_MODEL // 2
CONV_W = 31
D_B = D_MODEL // 2
HY_ORDER = 2
HY_SHORT = 3
HY_EMB = 33
HY_BANDS = (HY_EMB - 1) // 2
HY_HIDDEN = 64
HY_FAST_PCT = 0.3
HY_SLOW_PCT = 1.5
HY_TARGET = 1e-2
D_AB_IN = 2 * D_A + (HY_ORDER + 1) * D_B
N_HEADS = 16
N_KV = 4
GROUP = N_HEADS // N_KV
HEAD_DIM = 64
WINDOW = 128
BLOCK = 128
NEG = -1e30

kernel_name = "hybrid_conv_hyena_swa_encoder"


def rms_norm(x, g):
    xf = x.astype(jnp.float32)
    y = xf * lax.rsqrt(jnp.mean(xf * xf, axis=-1, keepdims=True) + EPS)
    return (y * g.astype(jnp.float32)).astype(x.dtype)


def layer_norm(x, g, b):
    xf = x.astype(jnp.float32)
    mu = jnp.mean(xf, axis=-1, keepdims=True)
    var = jnp.mean(jnp.square(xf - mu), axis=-1, keepdims=True)
    y = (xf - mu) * lax.rsqrt(var + EPS)
    return (y * g.astype(jnp.float32) + b.astype(jnp.float32)).astype(x.dtype)


def modulate(h, shift, scale):
    return h * (1 + scale[:, None, :]) + shift[:, None, :]


def swiglu(h, w_in, w_out):
    g, u = jnp.split(h @ w_in, 2, axis=-1)
    return (jax.nn.silu(g) * u) @ w_out


def depthwise_conv(x, w, b):
    pad = w.shape[0] // 2
    y = lax.conv_general_dilated(
        x, w[:, None, :].astype(x.dtype), window_strides=(1,), padding=[(pad, pad)],
        dimension_numbers=("NWC", "WIO", "NWC"), feature_group_count=x.shape[-1])
    return y + b.astype(x.dtype)


def hyena_filters_freq(L, w1, b1, w2, b2, w3, freq):
    f32 = jnp.float32
    t = jnp.linspace(0.0, 1.0, L, dtype=f32)
    w = 2.0 * math.pi * jnp.arange(L, dtype=f32) / L
    bands = jnp.linspace(1e-4, HY_BANDS - 1, HY_BANDS, dtype=f32)
    fw = w[:, None] * bands[None, :]
    feats = jnp.concatenate([t[:, None], jnp.cos(fw), -jnp.sin(fw)], axis=-1)
    fr = freq.astype(f32)
    h = jnp.sin(fr * (feats @ w1.astype(f32) + b1.astype(f32)))
    h = jnp.sin(fr * (h @ w2.astype(f32) + b2.astype(f32)))
    h = (h @ w3.astype(f32)).reshape(L, 2, HY_ORDER, D_B)
    max_decay = math.log(HY_TARGET) / HY_FAST_PCT
    min_decay = math.log(HY_TARGET) / HY_SLOW_PCT
    deltas = jnp.abs(jnp.linspace(min_decay, max_decay, D_B, dtype=f32))
    h = h * jnp.exp(-t[:, None] * deltas[None, :])[:, None, None, :]
    fwd, bwd = h[:, 0], h[:, 1]
    k = jnp.concatenate([fwd, jnp.zeros((1, HY_ORDER, D_B), f32), bwd[1:][::-1]], axis=0)
    k = k * lax.rsqrt(jnp.sum(k * k, axis=0, keepdims=True) + EPS)
    return jnp.fft.rfft(k, axis=0)


def fft_long_conv(z, k_f, skip):
    L = z.shape[1]
    zf = z.astype(jnp.float32)
    y = jnp.fft.irfft(jnp.fft.rfft(zf, n=2 * L, axis=1) * k_f[None], n=2 * L, axis=1)[:, :L]
    return (y + zf * skip.astype(jnp.float32)).astype(z.dtype)


def conv_hyena_mixer(h, w_in, conv_w, conv_b, ln_g, ln_b, short_w, short_b,
                     hw1, hb1, hw2, hb2, hw3, hfreq, hskip, w_out):
    L = h.shape[1]
    proj = h @ w_in
    a, bp = proj[..., :2 * D_A], proj[..., 2 * D_A:]
    a = jax.nn.glu(a, axis=-1)
    a = jax.nn.silu(layer_norm(depthwise_conv(a, conv_w, conv_b), ln_g, ln_b))
    bp = depthwise_conv(bp, short_w, short_b)
    v, x1, x2 = jnp.split(bp, 3, axis=-1)
    k_f = hyena_filters_freq(L, hw1, hb1, hw2, hb2, hw3, hfreq)
    z = x1 * fft_long_conv(v, k_f[:, 0], hskip[0])
    z = x2 * fft_long_conv(z, k_f[:, 1], hskip[1])
    return jnp.concatenate([a, z], axis=-1) @ w_out


def alibi_slopes():
    return np.asarray([2.0 ** (-8.0 * (i + 1) / N_HEADS) for i in range(N_HEADS)], np.float32)


def window_attention(h, w_qkv, sink, w_out):
    B, L, _ = h.shape
    nb = L // BLOCK
    qkv = h @ w_qkv
    nq, nk = N_HEADS * HEAD_DIM, N_KV * HEAD_DIM
    q = qkv[..., :nq].reshape(B, nb, BLOCK, N_KV, GROUP, HEAD_DIM)
    k = qkv[..., nq:nq + nk].reshape(B, L, N_KV, HEAD_DIM)
    v = qkv[..., nq + nk:].reshape(B, L, N_KV, HEAD_DIM)

    def band(t):
        tp = jnp.pad(t, ((0, 0), (BLOCK, BLOCK), (0, 0), (0, 0))).reshape(B, nb + 2, BLOCK, N_KV, HEAD_DIM)
        return jnp.concatenate([tp[:, :-2], tp[:, 1:-1], tp[:, 2:]], axis=2)

    kb, vb = band(k), band(v)
    s = jnp.einsum("bnqkgd,bnskd->bnkgqs", q, kb).astype(jnp.float32) * (HEAD_DIM ** -0.5)
    qi = np.arange(BLOCK)[:, None]
    kj = np.arange(3 * BLOCK)[None, :]
    dist = kj - BLOCK - qi
    kpos = (np.arange(nb)[:, None, None] - 1) * BLOCK + kj[None]
    valid = (np.abs(dist)[None] <= WINDOW) & (kpos >= 0) & (kpos < L)
    slopes = jnp.asarray(alibi_slopes()).reshape(N_KV, GROUP)
    bias = -slopes[:, :, None, None] * jnp.asarray(np.abs(dist), jnp.float32)[None, None]
    s = jnp.where(jnp.asarray(valid)[None, :, None, None], s + bias[None, None], NEG)
    snk = sink.astype(jnp.float32).reshape(N_KV, GROUP)[None, None, :, :, None]
    m = jnp.maximum(jnp.max(s, axis=-1), snk)
    p = jnp.exp(s - m[..., None])
    denom = jnp.sum(p, axis=-1) + jnp.exp(snk - m)
    o = jnp.einsum("bnkgqs,bnskd->bnqkgd", p, vb.astype(jnp.float32))
    o = o / jnp.moveaxis(denom, 4, 2)[..., None]
    return o.reshape(B, L, N_HEADS * HEAD_DIM).astype(h.dtype) @ w_out


def trunk(x, c, ada_w, ada_b, norm_g, ffn_w_in, ffn_w_out, final_g,
          ab_w_in, conv_w, conv_b, conv_ln_g, conv_ln_b, hy_short_w, hy_short_b,
          hy_w1, hy_b1, hy_w2, hy_b2, hy_w3, hy_freq, hy_skip, ab_w_out,
          attn_w_qkv, attn_sink, attn_w_out):
    cs = jax.nn.silu(c)
    for i in range(DEPTH):
        mod = cs @ ada_w[i] + ada_b[i]
        sh1, sc1, g1, sh2, sc2, g2, sh3, sc3, g3 = jnp.split(mod, 3 * N_SUB, axis=-1)
        h = modulate(rms_norm(x, norm_g[i, 0]), sh1, sc1)
        x = x + 0.5 * g1[:, None, :] * swiglu(h, ffn_w_in[i, 0], ffn_w_out[i, 0])
        h = modulate(rms_norm(x, norm_g[i, 1]), sh2, sc2)
        j = i // 2
        if i % 2 == 0:
            y = conv_hyena_mixer(h, ab_w_in[j], conv_w[j], conv_b[j], conv_ln_g[j], conv_ln_b[j],
                                 hy_short_w[j], hy_short_b[j], hy_w1[j], hy_b1[j], hy_w2[j], hy_b2[j],
                                 hy_w3[j], hy_freq[j], hy_skip[j], ab_w_out[j])
        else:
            y = window_attention(h, attn_w_qkv[j], attn_sink[j], attn_w_out[j])
        x = x + g2[:, None, :] * y
        h = modulate(rms_norm(x, norm_g[i, 2]), sh3, sc3)
        x = x + 0.5 * g3[:, None, :] * swiglu(h, ffn_w_in[i, 1], ffn_w_out[i, 1])
    return rms_norm(x, final_g)


def setup_inputs(seed: int = 0) -> dict:
    key = jax.random.key(seed)
    ks = iter(jax.random.split(key, 40))
    f32 = jnp.float32

    def nrm(shape, scale):
        return jax.random.normal(next(ks), shape, f32) * scale

    D = D_MODEL
    return {
        "x_prompt": nrm((BATCH, SEQ, D), 1.0),
        "x_sample": nrm((DEC_BATCH, DEC_SEQ, D), 1.0),
        "c_prompt": nrm((BATCH, D), 1.0),
        "c_sample": nrm((DEC_BATCH, D), 1.0),
        "ada_w": nrm((DEPTH, D, 3 * N_SUB * D), 0.02),
        "ada_b": nrm((DEPTH, 3 * N_SUB * D), 0.02),
        "norm_g": 1.0 + nrm((DEPTH, N_SUB, D), 0.05),
        "ffn_w_in": nrm((DEPTH, 2, D, 2 * D_FF), D ** -0.5),
        "ffn_w_out": nrm((DEPTH, 2, D_FF, D), D_FF ** -0.5),
        "final_g": 1.0 + nrm((D,), 0.05),
        "ab_w_in": nrm((N_EVEN, D, D_AB_IN), D ** -0.5),
        "conv_w": nrm((N_EVEN, CONV_W, D_A), CONV_W ** -0.5),
        "conv_b": nrm((N_EVEN, D_A), 0.02),
        "conv_ln_g": 1.0 + nrm((N_EVEN, D_A), 0.05),
        "conv_ln_b": nrm((N_EVEN, D_A), 0.02),
        "hy_short_w": nrm((N_EVEN, HY_SHORT, (HY_ORDER + 1) * D_B), HY_SHORT ** -0.5),
        "hy_short_b": nrm((N_EVEN, (HY_ORDER + 1) * D_B), 0.02),
        "hy_w1": nrm((N_EVEN, HY_EMB, HY_HIDDEN), HY_EMB ** -0.5),
        "hy_b1": nrm((N_EVEN, HY_HIDDEN), 0.1),
        "hy_w2": nrm((N_EVEN, HY_HIDDEN, HY_HIDDEN), HY_HIDDEN ** -0.5),
        "hy_b2": nrm((N_EVEN, HY_HIDDEN), 0.1),
        "hy_w3": nrm((N_EVEN, HY_HIDDEN, 2 * HY_ORDER * D_B), HY_HIDDEN ** -0.5),
        "hy_freq": 1.0 + nrm((N_EVEN, HY_HIDDEN), 0.1),
        "hy_skip": nrm((N_EVEN, HY_ORDER, D_B), 0.1),
        "ab_w_out": nrm((N_EVEN, D_A + D_B, D), (D_A + D_B) ** -0.5),
        "attn_w_qkv": nrm((N_ODD, D, (N_HEADS + 2 * N_KV) * HEAD_DIM), D ** -0.5),
        "attn_sink": nrm((N_ODD, N_HEADS), 0.5),
        "attn_w_out": nrm((N_ODD, N_HEADS * HEAD_DIM, D), (N_HEADS * HEAD_DIM) ** -0.5),
    }


def reference(x_prompt, x_sample, c_prompt, c_sample, ada_w, ada_b, norm_g, ffn_w_in, ffn_w_out,
              final_g, ab_w_in, conv_w, conv_b, conv_ln_g, conv_ln_b, hy_short_w, hy_short_b,
              hy_w1, hy_b1, hy_w2, hy_b2, hy_w3, hy_freq, hy_skip, ab_w_out,
              attn_w_qkv, attn_sink, attn_w_out):
    y_prompt = trunk(x_prompt, c_prompt, ada_w, ada_b, norm_g, ffn_w_in, ffn_w_out, final_g,
                     ab_w_in, conv_w, conv_b, conv_ln_g, conv_ln_b, hy_short_w, hy_short_b,
                     hy_w1, hy_b1, hy_w2, hy_b2, hy_w3, hy_freq, hy_skip, ab_w_out,
                     attn_w_qkv, attn_sink, attn_w_out)
    y_sample = trunk(x_sample, c_sample, ada_w, ada_b, norm_g, ffn_w_in, ffn_w_out, final_g,
                     ab_w_in, conv_w, conv_b, conv_ln_g, conv_ln_b, hy_short_w, hy_short_b,
                     hy_w1, hy_b1, hy_w2, hy_b2, hy_w3, hy_freq, hy_skip, ab_w_out,
                     attn_w_qkv, attn_sink, attn_w_out)
    return (y_prompt, y_sample)
```

```cpp
#include <hip/hip_runtime.h>
#include <hip/hip_cooperative_groups.h>
#include <cstdio>
namespace cg = cooperative_groups;

#ifndef PM
#define PM 0xffff
#endif
#define EN(b) ((PM >> (b)) & 1)
#ifndef N_LAUNCH_MODE
#define N_LAUNCH_MODE 1
#endif

#define LAS __attribute__((address_space(3)))
typedef unsigned short bf16_t;
typedef short bf16x8 __attribute__((ext_vector_type(8)));
typedef float f32x4 __attribute__((ext_vector_type(4)));
typedef float f32x16 __attribute__((ext_vector_type(16)));
typedef unsigned u32x4 __attribute__((ext_vector_type(4)));
typedef unsigned u32x2 __attribute__((ext_vector_type(2)));
typedef __bf16 bf16x2v __attribute__((ext_vector_type(2)));
typedef float f32x2v __attribute__((ext_vector_type(2)));
typedef _Float16 half_t;

constexpr int T = 49152, D = 1024, L = 16384, DFF = 2816, NPH = 23;
constexpr float EPS = 1e-6f;
constexpr int LDS_BYTES = 147456;

constexpr size_t WS_WIN = 0;
constexpr size_t WS_WOUT = WS_WIN + 4ull * 5632 * 1024 * 2;
constexpr size_t WS_WABIN = WS_WOUT + 4ull * 1024 * 2816 * 2;
constexpr size_t WS_WABOUT = WS_WABIN + 2560ull * 1024 * 2;
constexpr size_t WS_WQKV = WS_WABOUT + 1024ull * 1024 * 2;
constexpr size_t WS_WATTO = WS_WQKV + 1536ull * 1024 * 2;
constexpr size_t WS_MOD = WS_WATTO + 1024ull * 1024 * 2;
constexpr size_t WS_H = WS_MOD + 262144;
constexpr size_t WS_ACT = WS_H + (size_t)T * 1024 * 2;
constexpr size_t WS_KT = WS_ACT + (size_t)T * DFF * 2;
constexpr size_t WS_END = WS_KT + 2ull * 512 * 2 * L * 2;
constexpr size_t PBT_BYTES = 3ull * 1536 * L * 2;
constexpr size_t FFTSCR_PER_BLOCK = 2ull * L * 8 + 3ull * L * 4;

__device__ __forceinline__ unsigned pk_bf16(float a, float b) { f32x2v f = {a, b}; bf16x2v r = __builtin_convertvector(f, bf16x2v); return __builtin_bit_cast(unsigned, r); }
__device__ __forceinline__ float bf_lo(unsigned v) { return __uint_as_float(v << 16); }
__device__ __forceinline__ float bf_hi(unsigned v) { return __uint_as_float(v & 0xffff0000u); }
__device__ __forceinline__ float bf2f(bf16_t v) { return __uint_as_float((unsigned)v << 16); }
__device__ __forceinline__ bf16_t f2bf(float f) { return (bf16_t)(pk_bf16(f, 0.f) & 0xffffu); }
__device__ __forceinline__ float fsigmoid(float x) { return __builtin_amdgcn_rcpf(1.0f + __expf(-x)); }
__device__ __forceinline__ float hw_sin(float x) { return __builtin_amdgcn_sinf(x * 0.15915494309189535f); }

__device__ __forceinline__ int opaque_tid() { int t = threadIdx.x; asm volatile("" : "+v"(t)); return t; }

struct Args { const float* in[28]; float* out; unsigned char* ws; int ph_lo, ph_hi; };

namespace pg8 {
constexpr int BM = 256, BK = 64, HALF = 128, HTB = HALF * BK * 2, STAGE_BYTES = 8 * HTB, NXCD = 8, WGM = 8;
__device__ __forceinline__ int lds_byte(int r, int c) { const int st = (r >> 4) * 2 + (c >> 5), rr = r & 15, cc = c & 31, ob = rr * 64 + cc * 2; return st * 1024 + (ob ^ (((ob >> 9) & 1) << 5)); }
__device__ __forceinline__ void stage_rc(int b, int& R, int& C) { const int st = b / 1024, sb = b % 1024, swz = sb ^ (((sb >> 9) & 1) << 5); R = (st >> 1) * 16 + swz / 64; C = (st & 1) * 32 + (swz % 64) / 2; }
__device__ __forceinline__ int perm32(int rho) { const int n = rho >> 4, i = rho & 15; return 8 * (i >> 2) + 4 * n + (i & 3); }
struct Unit { int pm, pn; };
struct Gemm { const bf16_t* A; const bf16_t* Bt; int M, N, K; };
struct StaticOrder {
    int nM, nN, nwg, G, c;
    __device__ void init(int M, int N, int G_, int c_) { nM = M / BM; nN = N / BM; nwg = nM * nN; G = G_; c = c_; }
    __device__ bool next(int i, Unit& u) const {
        const long Lx = (long)i * G + c; if (Lx >= nwg) return false;
        int wgid = (int)Lx; { const int q = nwg / NXCD, r = nwg % NXCD, xcd = wgid % NXCD, off = wgid / NXCD; wgid = (xcd < r ? xcd * (q + 1) : r * (q + 1) + (xcd - r) * q) + off; }
        const int nig = WGM * nN, gid = wgid / nig, fm = gid * WGM, gsz = (nM - fm) < WGM ? (nM - fm) : WGM;
        u.pm = fm + ((wgid % nig) % gsz); u.pn = (wgid % nig) / gsz; return true;
    }
};

template <class Epi>
__device__ __forceinline__ void gemm_phase(LAS unsigned char* lds, const Gemm g, const StaticOrder& S, const Epi& E) {
    const int tid = opaque_tid(), wid = __builtin_amdgcn_readfirstlane(tid >> 6), lane = tid & 63, wr = wid >> 2, wc = wid & 3, fr = lane & 15, fq = lane >> 4;
    const int K = g.K, nt = K / BK;
    unsigned voffA[2], voffB[2];
#pragma unroll
    for (int i = 0; i < 2; ++i) { int R, C; stage_rc(tid * 16 + i * 8192, R, C); const int Rb = Epi::PERM ? ((R & ~31) + perm32(R & 31)) : R;
        voffA[i] = (unsigned)(R * K + C) * 2u; voffB[i] = (unsigned)(Rb * K + C) * 2u; }
    const size_t kstep = (size_t)(BK * 2);
    const size_t hstep = (size_t)HALF * K * 2;
    const size_t tstep = 2 * hstep;
    const unsigned ldsw = (unsigned)wid * 1024u;
    const int aoff = lds_byte(wr * 64 + fr, fq * 8), boff = lds_byte(wc * 32 + fr, fq * 8);
#define PG8_SA(b, h) (((b) * 2 + (h)) * HTB)
#define PG8_SB(b, h) ((4 + (b) * 2 + (h)) * HTB)
#define PG8_STAGE(bufoff, gbase, voff) do { _Pragma("unroll") for (int _i = 0; _i < 2; ++_i) \
        __builtin_amdgcn_global_load_lds((const unsigned*)((const char*)(gbase) + (voff)[_i]), (LAS unsigned*)(lds + (bufoff) + ldsw + _i * 8192), 16, 0, 0); } while (0)
#define PG8_LDA(dst, b, h) do { _Pragma("unroll") for (int m = 0; m < 4; ++m) _Pragma("unroll") for (int k = 0; k < 2; ++k) dst[m][k] = *(const LAS bf16x8*)(lds + PG8_SA(b, h) + aoff + m * 2048 + k * 1024); } while (0)
#define PG8_LDB(dst, b, h) do { _Pragma("unroll") for (int n = 0; n < 2; ++n) _Pragma("unroll") for (int k = 0; k < 2; ++k) dst[n][k] = *(const LAS bf16x8*)(lds + PG8_SB(b, h) + boff + n * 2048 + k * 1024); } while (0)
#define PG8_MMA(ai, bj, At, Bt) do { __builtin_amdgcn_s_setprio(1); _Pragma("unroll") for (int m = 0; m < 4; ++m) _Pragma("unroll") for (int n = 0; n < 2; ++n) _Pragma("unroll") for (int k = 0; k < 2; ++k) \
        acc[ai][bj][m][n] = __builtin_amdgcn_mfma_f32_16x16x32_bf16(Bt[n][k], At[m][k], acc[ai][bj][m][n], 0, 0, 0); __builtin_amdgcn_s_setprio(0); } while (0)
#define PG8_WAIT_V(n) asm volatile("s_waitcnt vmcnt(" #n ")" ::: "memory")
#define PG8_WAIT_L(n) asm volatile("s_waitcnt lgkmcnt(" #n ")" ::: "memory")
#define PG8_BAR __builtin_amdgcn_s_barrier()
#define PG8_SCHED __builtin_amdgcn_sched_barrier(0)
    Unit cur, nxt; int ui = 0;
    if (!S.next(0, cur)) return;
    f32x4 acc[2][2][4][2];
#pragma unroll
    for (int a = 0; a < 2; ++a)
#pragma unroll
        for (int b = 0; b < 2; ++b)
#pragma unroll
            for (int m = 0; m < 4; ++m)
#pragma unroll
                for (int n = 0; n < 2; ++n) acc[a][b][m][n] = (f32x4){0.f, 0.f, 0.f, 0.f};
    bf16x8 At[4][2], B0[2][2], B1[2][2];
    const char* cA = (const char*)g.A + (size_t)cur.pm * tstep; const char* cB = (const char*)g.Bt + (size_t)cur.pn * tstep;
    PG8_STAGE(PG8_SB(0, 0), cB, voffB); PG8_STAGE(PG8_SA(0, 0), cA, voffA); PG8_STAGE(PG8_SB(0, 1), cB + hstep, voffB); PG8_STAGE(PG8_SA(0, 1), cA + hstep, voffA);
    if (wr == 1) PG8_BAR;
    PG8_WAIT_V(4); PG8_BAR;
    PG8_STAGE(PG8_SB(1, 0), cB + kstep, voffB); PG8_STAGE(PG8_SA(1, 0), cA + kstep, voffA); PG8_STAGE(PG8_SB(1, 1), cB + hstep + kstep, voffB);
    PG8_WAIT_V(6); PG8_BAR;
    for (;;) {
        const bool has_next = S.next(ui + 1, nxt);
        const char* nA = has_next ? (const char*)g.A + (size_t)nxt.pm * tstep : cA; const char* nB = has_next ? (const char*)g.Bt + (size_t)nxt.pn * tstep : cB;
        for (int t = 0; t < nt; t += 2) {
            const bool last = (t == nt - 2);
            const char* a1 = cA + (size_t)(t + 1) * kstep;
            const char* a2 = last ? nA : cA + (size_t)(t + 2) * kstep; const char* b2 = last ? nB : cB + (size_t)(t + 2) * kstep;
            const char* a3 = a2 + kstep; const char* b3 = b2 + kstep;
            PG8_LDB(B0, 0, 0); PG8_SCHED; PG8_LDA(At, 0, 0); PG8_STAGE(PG8_SA(1, 1), a1 + hstep, voffA);
            PG8_WAIT_L(8); PG8_BAR; PG8_WAIT_L(0); PG8_MMA(0, 0, At, B0); PG8_BAR; PG8_SCHED;
            PG8_LDB(B1, 0, 1); PG8_STAGE(PG8_SB(0, 0), b2, voffB);
            PG8_BAR; PG8_WAIT_L(0); PG8_MMA(0, 1, At, B1); PG8_BAR;
            PG8_LDA(At, 0, 1); PG8_STAGE(PG8_SA(0, 0), a2, voffA);
            PG8_BAR; PG8_WAIT_L(0); PG8_MMA(1, 0, At, B0); PG8_BAR; PG8_SCHED;
            PG8_STAGE(PG8_SB(0, 1), b2 + hstep, voffB);
            PG8_WAIT_V(6); PG8_BAR; PG8_MMA(1, 1, At, B1); PG8_BAR;
            PG8_LDB(B0, 1, 0); PG8_SCHED; PG8_LDA(At, 1, 0); PG8_STAGE(PG8_SA(0, 1), a2 + hstep, voffA);
            PG8_WAIT_L(8); PG8_BAR; PG8_WAIT_L(0); PG8_MMA(0, 0, At, B0); PG8_BAR; PG8_SCHED;
            PG8_LDB(B1, 1, 1); PG8_STAGE(PG8_SB(1, 0), b3, voffB);
            PG8_BAR; PG8_WAIT_L(0); PG8_MMA(0, 1, At, B1); PG8_BAR;
            PG8_LDA(At, 1, 1); PG8_STAGE(PG8_SA(1, 0), a3, voffA);
            PG8_BAR; PG8_WAIT_L(0); PG8_MMA(1, 0, At, B0); PG8_BAR; PG8_SCHED;
            PG8_STAGE(PG8_SB(1, 1), b3 + hstep, voffB);
            PG8_WAIT_V(6); PG8_BAR; PG8_MMA(1, 1, At, B1); PG8_BAR;
        }
        E(acc, cur, wr, wc, fr, fq);
        if (!has_next) break;
#pragma unroll
        for (int a = 0; a < 2; ++a)
#pragma unroll
            for (int b = 0; b < 2; ++b)
#pragma unroll
                for (int m = 0; m < 4; ++m)
#pragma unroll
                    for (int n = 0; n < 2; ++n) acc[a][b][m][n] = (f32x4){0.f, 0.f, 0.f, 0.f};
        cur = nxt; cA = nA; cB = nB; ++ui;
    }
    PG8_WAIT_V(0);
    if (wr == 0) PG8_BAR;
    PG8_BAR;
#undef PG8_SA
#undef PG8_SB
#undef PG8_STAGE
#undef PG8_LDA
#undef PG8_LDB
#undef PG8_MMA
#undef PG8_WAIT_V
#undef PG8_WAIT_L
#undef PG8_BAR
#undef PG8_SCHED
}
}

struct EpiSwiglu {
    static constexpr bool PERM = true;
    bf16_t* O;
    __device__ __forceinline__ void operator()(const f32x4 (&acc)[2][2][4][2], const pg8::Unit& u, int wr, int wc, int fr, int fq) const {
        const int row0 = u.pm * 256 + wr * 64 + fr, col0 = u.pn * 128 + wc * 32 + 8 * fq;
#pragma unroll
        for (int ai = 0; ai < 2; ++ai)
#pragma unroll
            for (int m = 0; m < 4; ++m) {
                bf16_t* rowp = O + (size_t)(row0 + ai * 128 + m * 16) * DFF + col0;
                float v[8];
#pragma unroll
                for (int n = 0; n < 2; ++n)
#pragma unroll
                    for (int j = 0; j < 4; ++j) { const float gg = acc[ai][0][m][n][j], uu = acc[ai][1][m][n][j]; v[n * 4 + j] = gg * fsigmoid(gg) * uu; }
                u32x4 w; w.x = pk_bf16(v[0], v[1]); w.y = pk_bf16(v[2], v[3]); w.z = pk_bf16(v[4], v[5]); w.w = pk_bf16(v[6], v[7]);
                *(u32x4*)rowp = w;
            }
    }
};
struct EpiBf16 {
    static constexpr bool PERM = true;
    bf16_t* O; int ldc;
    __device__ __forceinline__ void operator()(const f32x4 (&acc)[2][2][4][2], const pg8::Unit& u, int wr, int wc, int fr, int fq) const {
        const int row0 = u.pm * 256 + wr * 64 + fr, col0 = u.pn * 256 + wc * 32 + 8 * fq;
#pragma unroll
        for (int ai = 0; ai < 2; ++ai)
#pragma unroll
            for (int m = 0; m < 4; ++m) {
                bf16_t* rowp = O + (size_t)(row0 + ai * 128 + m * 16) * ldc + col0;
#pragma unroll
                for (int bj = 0; bj < 2; ++bj) {
                    const f32x4 v0 = acc[ai][bj][m][0], v1 = acc[ai][bj][m][1];
                    u32x4 w; w.x = pk_bf16(v0[0], v0[1]); w.y = pk_bf16(v0[2], v0[3]); w.z = pk_bf16(v1[0], v1[1]); w.w = pk_bf16(v1[2], v1[3]);
                    *(u32x4*)(rowp + bj * 128) = w;
                }
            }
    }
};
struct EpiProj {
    static constexpr bool PERM = true;
    bf16_t* Oa; bf16_t* ObT;
    __device__ __forceinline__ void operator()(const f32x4 (&acc)[2][2][4][2], const pg8::Unit& u, int wr, int wc, int fr, int fq) const {
        const int row0 = u.pm * 256 + wr * 64 + fr;
        if (u.pn < 4) {
            const int col0 = u.pn * 256 + wc * 32 + 8 * fq;
#pragma unroll
            for (int ai = 0; ai < 2; ++ai)
#pragma unroll
                for (int m = 0; m < 4; ++m) {
                    bf16_t* rowp = Oa + (size_t)(row0 + ai * 128 + m * 16) * 1024 + col0;
#pragma unroll
                    for (int bj = 0; bj < 2; ++bj) {
                        const f32x4 v0 = acc[ai][bj][m][0], v1 = acc[ai][bj][m][1];
                        u32x4 w; w.x = pk_bf16(v0[0], v0[1]); w.y = pk_bf16(v0[2], v0[3]); w.z = pk_bf16(v1[0], v1[1]); w.w = pk_bf16(v1[2], v1[3]);
                        *(u32x4*)(rowp + bj * 128) = w;
                    }
                }
        } else {
            const int seq = (u.pm * 256) >> 14;
            const int c0 = (u.pn - 4) * 256 + wc * 32 + 8 * fq;
#pragma unroll
            for (int ai = 0; ai < 2; ++ai)
#pragma unroll
                for (int m = 0; m < 4; ++m) {
                    const int nn = (row0 + ai * 128 + m * 16) & (L - 1);
#pragma unroll
                    for (int bj = 0; bj < 2; ++bj)
#pragma unroll
                        for (int n = 0; n < 2; ++n)
#pragma unroll
                            for (int j = 0; j < 4; ++j)
                                ObT[((size_t)(seq * 1536 + c0 + bj * 128 + 4 * n + j) << 14) + nn] = f2bf(acc[ai][bj][m][n][j]);
                }
        }
    }
};
struct EpiResid {
    static constexpr bool PERM = false;
    const float* xs0; const float* xs1; float* out; const float* gate; float scale;
    __device__ __forceinline__ void operator()(const f32x4 (&acc)[2][2][4][2], const pg8::Unit& u, int wr, int wc, int fr, int fq) const {
        const int row0 = u.pm * 256 + wr * 64 + fr, col0 = u.pn * 256 + wc * 32 + 4 * fq;
        const int seq = (u.pm * 256) >> 14;
        const float* srcb = (seq < 2 ? xs0 + (size_t)row0 * 1024 : xs1 + (size_t)(row0 - 32768) * 1024) + col0;
        float* dstb = out + (size_t)row0 * 1024 + col0;
        const float* gb = gate + seq * 9216 + col0;
#pragma unroll
        for (int bj = 0; bj < 2; ++bj)
#pragma unroll
            for (int n = 0; n < 2; ++n) {
                const f32x4 gv = *(const f32x4*)(gb + bj * 128 + n * 16) * scale;
#pragma unroll
                for (int ai = 0; ai < 2; ++ai) {
#pragma unroll
                    for (int m = 0; m < 4; ++m) {
                        const size_t off = (size_t)(ai * 128 + m * 16) * 1024 + bj * 128 + n * 16;
                        *(f32x4*)(dstb + off) = *(const f32x4*)(srcb + off) + gv * acc[ai][bj][m][n];
                    }
                    asm volatile("" ::: "memory");
                }
            }
    }
};

__device__ void convert_weights(const Args& a, LAS float* tile) {
    const int tid = opaque_tid();
    unsigned char* ws = a.ws;
    for (int ti = blockIdx.x; ti < 9984; ti += gridDim.x) {
        const float* src; bf16_t* dst; int K, N, mode = 0, lt;
        if (ti < 5632) { const int mi = ti / 1408; lt = ti % 1408; src = a.in[7] + (size_t)mi * 1024 * 5632; dst = (bf16_t*)(ws + WS_WIN) + (size_t)mi * 5632 * 1024; K = 1024; N = 5632; mode = 1; }
        else if (ti < 8448) { const int mi = (ti - 5632) / 704; lt = (ti - 5632) % 704; src = a.in[8] + (size_t)mi * 2816 * 1024; dst = (bf16_t*)(ws + WS_WOUT) + (size_t)mi * 1024 * 2816; K = 2816; N = 1024; }
        else if (ti < 9088) { lt = ti - 8448; src = a.in[10]; dst = (bf16_t*)(ws + WS_WABIN); K = 1024; N = 2560; }
        else if (ti < 9344) { lt = ti - 9088; src = a.in[24]; dst = (bf16_t*)(ws + WS_WABOUT); K = 1024; N = 1024; }
        else if (ti < 9728) { lt = ti - 9344; src = a.in[25]; dst = (bf16_t*)(ws + WS_WQKV); K = 1024; N = 1536; }
        else { lt = ti - 9728; src = a.in[27]; dst = (bf16_t*)(ws + WS_WATTO); K = 1024; N = 1024; }
        const int nkt = K / 64;
        const int kt = lt % nkt, ntp = lt / nkt;
        const int k0 = kt * 64, np0 = ntp * 64;
        int n0 = np0;
        if (mode == 1) { const int pn = np0 >> 8, bj = (np0 >> 7) & 1, c0 = np0 & 127; n0 = bj * DFF + 128 * pn + c0; }
        __syncthreads();
#pragma unroll
        for (int i = 0; i < 8; ++i) { const int k = (tid >> 6) + 8 * i, n = tid & 63; tile[k * 65 + n] = src[(size_t)(k0 + k) * N + n0 + n]; }
        __syncthreads();
        const int nn = tid >> 3, kk = (tid & 7) * 8;
        float v[8];
#pragma unroll
        for (int j = 0; j < 8; ++j) v[j] = tile[(kk + j) * 65 + nn];
        u32x4 w; w.x = pk_bf16(v[0], v[1]); w.y = pk_bf16(v[2], v[3]); w.z = pk_bf16(v[4], v[5]); w.w = pk_bf16(v[6], v[7]);
        *(u32x4*)(dst + (size_t)(np0 + nn) * K + k0 + kk) = w;
    }
    __syncthreads();
}

__device__ void ada_phase(const Args& a, LAS float* lf) {
    const int tid = opaque_tid(), lane = tid & 63, w = tid >> 6;
    LAS float* cs = lf; LAS float* red = lf + 3072;
    float* mod = (float*)(a.ws + WS_MOD);
    __syncthreads();
    for (int i = tid; i < 3072; i += 512) { const int s = i >> 10, k = i & 1023; const float c = s < 2 ? a.in[2][s * 1024 + k] : a.in[3][k]; cs[i] = c * fsigmoid(c); }
    __syncthreads();
    for (int item = blockIdx.x; item < 288; item += gridDim.x) {
        const int layer = item / 144, cgp = item % 144, col = cgp * 64 + lane;
        const float* W = a.in[4] + (size_t)layer * 1024 * 9216 + col;
        float a0 = 0.f, a1 = 0.f, a2 = 0.f;
#pragma unroll 8
        for (int k = w * 128; k < w * 128 + 128; ++k) { const float wv = W[(size_t)k * 9216]; a0 += cs[k] * wv; a1 += cs[1024 + k] * wv; a2 += cs[2048 + k] * wv; }
        red[(w * 3 + 0) * 64 + lane] = a0; red[(w * 3 + 1) * 64 + lane] = a1; red[(w * 3 + 2) * 64 + lane] = a2;
        __syncthreads();
        if (tid < 192) { const int s = tid >> 6; float sum = 0.f;
#pragma unroll
            for (int ww = 0; ww < 8; ++ww) sum += red[(ww * 3 + s) * 64 + lane];
            mod[(size_t)(layer * 3 + s) * 9216 + cgp * 64 + lane] = sum + a.in[5][layer * 9216 + cgp * 64 + lane]; }
        __syncthreads();
    }
}

__device__ void filter_phase(const Args& a, LAS float* lf) {
    const int tid = opaque_tid();
    LAS float* feats = lf;
    LAS float* h1 = lf + 64 * 33;
    LAS float* h2T = h1 + 64 * 65;
    const float* w1 = a.in[17]; const float* b1 = a.in[18]; const float* w2 = a.in[19]; const float* b2 = a.in[20]; const float* w3 = a.in[21]; const float* fr = a.in[22];
    half_t* KT = (half_t*)(a.ws + WS_KT);
    for (int item = blockIdx.x; item < 256; item += gridDim.x) {
        const int p0 = item * 64;
        __syncthreads();
        for (int idx = tid; idx < 64 * 33; idx += 512) {
            const int pos = idx / 33, f = idx % 33, n = p0 + pos; float v;
            if (f == 0) v = (float)n / (float)(L - 1);
            else { const int b = (f - 1) & 15; const double band = 1e-4 + (double)b * ((15.0 - 1e-4) / 15.0); double rev = (double)n * band / (double)L; rev -= floor(rev);
                   v = (f <= 16) ? __builtin_amdgcn_cosf((float)rev) : -__builtin_amdgcn_sinf((float)rev); }
            feats[idx] = v;
        }
        __syncthreads();
        { const int pos = tid >> 3, j0 = (tid & 7) * 8; float acc[8];
#pragma unroll
          for (int j = 0; j < 8; ++j) acc[j] = b1[j0 + j];
#pragma unroll 3
          for (int f = 0; f < 33; ++f) { const float x = feats[pos * 33 + f];
#pragma unroll
              for (int j = 0; j < 8; ++j) acc[j] += x * w1[f * 64 + j0 + j]; }
#pragma unroll
          for (int j = 0; j < 8; ++j) h1[pos * 65 + j0 + j] = hw_sin(fr[j0 + j] * acc[j]); }
        __syncthreads();
        { const int pos = tid >> 3, j0 = (tid & 7) * 8; float acc[8];
#pragma unroll
          for (int j = 0; j < 8; ++j) acc[j] = b2[j0 + j];
#pragma unroll 4
          for (int i = 0; i < 64; ++i) { const float x = h1[pos * 65 + i];
#pragma unroll
              for (int j = 0; j < 8; ++j) acc[j] += x * w2[i * 64 + j0 + j]; }
#pragma unroll
          for (int j = 0; j < 8; ++j) h2T[(j0 + j) * 64 + pos] = hw_sin(fr[j0 + j] * acc[j]); }
        __syncthreads();
        const int col0 = tid * 4;
        const int dir = col0 >> 10, ord = (col0 >> 9) & 1, ch0 = col0 & 511;
#pragma unroll 1
        for (int chunk = 0; chunk < 4; ++chunk) {
            float acc[16][4];
#pragma unroll
            for (int p = 0; p < 16; ++p)
#pragma unroll
                for (int c = 0; c < 4; ++c) acc[p][c] = 0.f;
#pragma unroll 2
            for (int j = 0; j < 64; ++j) {
                const f32x4 wv = *(const f32x4*)(w3 + j * 2048 + col0);
                f32x4 hv[4];
#pragma unroll
                for (int q = 0; q < 4; ++q) hv[q] = *(const LAS f32x4*)(h2T + j * 64 + chunk * 16 + q * 4);
#pragma unroll
                for (int p = 0; p < 16; ++p)
#pragma unroll
                    for (int c = 0; c < 4; ++c) acc[p][c] += hv[p >> 2][p & 3] * wv[c];
            }
#pragma unroll
            for (int c = 0; c < 4; ++c) {
                const int ch = ch0 + c;
                const float delta = 3.0701134573253945f + (float)ch * (12.280453829301578f / 511.0f);
                half_t* dstp = KT + ((size_t)((ord * 512 + ch) * 2 + dir) << 14) + p0 + chunk * 16;
                unsigned pk[8];
#pragma unroll
                for (int p = 0; p < 16; p += 2) {
                    const float t0 = (float)(p0 + chunk * 16 + p) / (float)(L - 1), t1 = (float)(p0 + chunk * 16 + p + 1) / (float)(L - 1);
                    const half_t x0 = (half_t)(acc[p][c] * __expf(-t0 * delta)), x1 = (half_t)(acc[p + 1][c] * __expf(-t1 * delta));
                    pk[p >> 1] = (unsigned)__builtin_bit_cast(unsigned short, x0) | ((unsigned)__builtin_bit_cast(unsigned short, x1) << 16);
                }
                *(u32x4*)dstp = (u32x4){pk[0], pk[1], pk[2], pk[3]};
                *(u32x4*)(dstp + 8) = (u32x4){pk[4], pk[5], pk[6], pk[7]};
            }
        }
    }
    __syncthreads();
}

__device__ void norm_phase(const float* xs0, const float* xs1, const float* g, const float* sh, const float* sc, bf16_t* h) {
    const int tid_ = opaque_tid(); const int lane = tid_ & 63, w = tid_ >> 6;
    f32x4 gg[4];
#pragma unroll
    for (int i = 0; i < 4; ++i) gg[i] = *(const f32x4*)(g + i * 256 + lane * 4);
    for (int row = blockIdx.x * 8 + w; row < T; row += gridDim.x * 8) {
        const int seq = row >> 14;
        const float* xr = seq < 2 ? xs0 + (size_t)row * 1024 : xs1 + (size_t)(row - 32768) * 1024;
        f32x4 v[4]; float ss = 0.f;
#pragma unroll
        for (int i = 0; i < 4; ++i) { v[i] = *(const f32x4*)(xr + i * 256 + lane * 4); ss += v[i][0] * v[i][0] + v[i][1] * v[i][1] + v[i][2] * v[i][2] + v[i][3] * v[i][3]; }
#pragma unroll
        for (int o = 32; o > 0; o >>= 1) ss += __shfl_xor(ss, o);
        const float rstd = rsqrtf(ss * (1.0f / 1024.0f) + EPS);
#pragma unroll
        for (int i = 0; i < 4; ++i) {
            const int col = i * 256 + lane * 4;
            const f32x4 s1 = *(const f32x4*)(sc + seq * 9216 + col), s0 = *(const f32x4*)(sh + seq * 9216 + col);
            const f32x4 y = v[i] * rstd * gg[i] * (s1 + 1.0f) + s0;
            u32x2 o; o.x = pk_bf16(y[0], y[1]); o.y = pk_bf16(y[2], y[3]);
            *(u32x2*)(h + (size_t)row * 1024 + col) = o;
        }
    }
}
__device__ void final_norm_phase(float* x, const float* g) {
    const int tid_ = opaque_tid(); const int lane = tid_ & 63, w = tid_ >> 6;
    f32x4 gg[4];
#pragma unroll
    for (int i = 0; i < 4; ++i) gg[i] = *(const f32x4*)(g + i * 256 + lane * 4);
    for (int row = blockIdx.x * 8 + w; row < T; row += gridDim.x * 8) {
        float* xr = x + (size_t)row * 1024;
        f32x4 v[4]; float ss = 0.f;
#pragma unroll
        for (int i = 0; i < 4; ++i) { v[i] = *(const f32x4*)(xr + i * 256 + lane * 4); ss += v[i][0] * v[i][0] + v[i][1] * v[i][1] + v[i][2] * v[i][2] + v[i][3] * v[i][3]; }
#pragma unroll
        for (int o = 32; o > 0; o >>= 1) ss += __shfl_xor(ss, o);
        const float rstd = rsqrtf(ss * (1.0f / 1024.0f) + EPS);
#pragma unroll
        for (int i = 0; i < 4; ++i) *(f32x4*)(xr + i * 256 + lane * 4) = v[i] * rstd * gg[i];
    }
}

__device__ void conva_phase(const Args& a, const bf16_t* pa, bf16_t* cat, LAS unsigned char* lds) {
    const int tid = opaque_tid(), lane = tid & 63, w = tid >> 6;
    LAS bf16_t* glu = (LAS bf16_t*)lds;
    LAS float* stage = (LAS float*)(lds + 94 * 512 * 2);
    const float* cw = a.in[11]; const float* cb = a.in[12]; const float* lg = a.in[13]; const float* lb = a.in[14];
    float wt[31];
#pragma unroll
    for (int j = 0; j < 31; ++j) wt[j] = cw[j * 512 + tid];
    const float bias = cb[tid];
    float lgv[8], lbv[8];
#pragma unroll
    for (int i = 0; i < 8; ++i) { lgv[i] = lg[lane + 64 * i]; lbv[i] = lb[lane + 64 * i]; }
    for (int tile = blockIdx.x; tile < 768; tile += gridDim.x) {
        const int seq = tile >> 8, t0 = (tile & 255) * 64;
        __syncthreads();
        for (int idx = tid; idx < 94 * 64; idx += 512) {
            const int r = idx >> 6, cc = idx & 63, t = t0 - 15 + r;
            u32x4 res = (u32x4){0u, 0u, 0u, 0u};
            if (t >= 0 && t < L) {
                const bf16_t* rp = pa + (size_t)(seq * L + t) * 1024 + cc * 8;
                const u32x4 x1 = *(const u32x4*)rp, x2 = *(const u32x4*)(rp + 512);
#pragma unroll
                for (int q = 0; q < 4; ++q) res[q] = pk_bf16(bf_lo(x1[q]) * fsigmoid(bf_lo(x2[q])), bf_hi(x1[q]) * fsigmoid(bf_hi(x2[q])));
            }
            *(LAS u32x4*)(glu + r * 512 + cc * 8) = res;
        }
        __syncthreads();
        for (int chunk = 0; chunk < 8; ++chunk) {
            float o[8];
#pragma unroll
            for (int tt = 0; tt < 8; ++tt) o[tt] = bias;
#pragma unroll
            for (int i = 0; i < 38; ++i) {
                const float x = bf2f(glu[(chunk * 8 + i) * 512 + tid]);
#pragma unroll
                for (int tt = 0; tt < 8; ++tt) { const int j = i - tt; if (j >= 0 && j < 31) o[tt] += wt[j] * x; }
            }
#pragma unroll
            for (int tt = 0; tt < 8; ++tt) stage[tt * 512 + tid] = o[tt];
            __syncthreads();
            {
                float v[8]; float s = 0.f;
#pragma unroll
                for (int i = 0; i < 8; ++i) { v[i] = stage[w * 512 + lane + 64 * i]; s += v[i]; }
#pragma unroll
                for (int of = 32; of > 0; of >>= 1) s += __shfl_xor(s, of);
                const float mean = s * (1.0f / 512.0f);
                float q = 0.f;
#pragma unroll
                for (int i = 0; i < 8; ++i) { const float d = v[i] - mean; q += d * d; }
#pragma unroll
                for (int of = 32; of > 0; of >>= 1) q += __shfl_xor(q, of);
                const float rstd = rsqrtf(q * (1.0f / 512.0f) + EPS);
                bf16_t* op = cat + (size_t)(seq * L + t0 + chunk * 8 + w) * 1024;
#pragma unroll
                for (int i = 0; i < 8; ++i) { const float y = (v[i] - mean) * rstd * lgv[i] + lbv[i]; op[lane + 64 * i] = f2bf(y * fsigmoid(y)); }
            }
            __syncthreads();
        }
    }
    __syncthreads();
}

typedef float cf2 __attribute__((ext_vector_type(2)));
__device__ __forceinline__ cf2 mk2(float x, float y) { cf2 r; r.x = x; r.y = y; return r; }
__device__ __forceinline__ int fphys(int i) { return i + ((i >> 6) << 2); }
__device__ __forceinline__ cf2 cmul(cf2 a, cf2 b) { return mk2(a.x * b.x - a.y * b.y, a.x * b.y + a.y * b.x); }
template <bool INV> __device__ __forceinline__ void bf4(cf2& a, cf2& b, cf2& c, cf2& d) {
    const cf2 t0 = mk2(a.x + c.x, a.y + c.y), t1 = mk2(a.x - c.x, a.y - c.y), t2 = mk2(b.x + d.x, b.y + d.y);
    const cf2 e = mk2(b.x - d.x, b.y - d.y);
    const cf2 t3 = INV ? mk2(-e.y, e.x) : mk2(e.y, -e.x);
    a = mk2(t0.x + t2.x, t0.y + t2.y); b = mk2(t1.x + t3.x, t1.y + t3.y);
    c = mk2(t0.x - t2.x, t0.y - t2.y); d = mk2(t1.x - t3.x, t1.y - t3.y);
}
template <bool INV, int K16> __device__ __forceinline__ cf2 c16() {
    constexpr float cs[10] = {1.0f, 0.92387953251128674f, 0.70710678118654752f, 0.38268343236508977f, 0.0f, -0.38268343236508977f, -0.70710678118654752f, -0.92387953251128674f, -1.0f, -0.92387953251128674f};
    constexpr float sn[10] = {0.0f, 0.38268343236508977f, 0.70710678118654752f, 0.92387953251128674f, 1.0f, 0.92387953251128674f, 0.70710678118654752f, 0.38268343236508977f, 0.0f, -0.38268343236508977f};
    return mk2(cs[K16], INV ? sn[K16] : -sn[K16]);
}
template <bool INV, int J> __device__ __forceinline__ void tw16(cf2& x1, cf2& x2, cf2& x3) {
    if (J > 0) { x1 = cmul(x1, c16<INV, J>()); x2 = cmul(x2, c16<INV, 2 * J>()); x3 = cmul(x3, c16<INV, 3 * J>()); }
}
template <bool INV, int LOGQ> __device__ __forceinline__ void r16_pass(LAS cf2* F, int tid) {
    constexpr int Q = 1 << LOGQ;
#pragma unroll 1
    for (int bi = 0; bi < 2; ++bi) {
        const int b = tid + 512 * bi, pos = b & (Q - 1), grp = b >> LOGQ, base = (grp << (LOGQ + 4)) + pos;
        cf2 x[16];
        constexpr int PSTR = (Q >= 64) ? (Q + (Q >> 4)) : Q;
        LAS cf2* Fp = F + fphys(base);
#pragma unroll
        for (int r = 0; r < 16; ++r) x[r] = Fp[r * PSTR];
        int posv = pos; asm volatile("" : "+v"(posv));
        const float rev = (float)posv * (1.0f / (float)(16 * Q));
        const float sn = __builtin_amdgcn_sinf(rev), cs = __builtin_amdgcn_cosf(rev);
        const cf2 w1 = mk2(cs, INV ? sn : -sn);
        const cf2 w2 = cmul(w1, w1), w3 = cmul(w2, w1), w4 = cmul(w2, w2), w8 = cmul(w4, w4), w12 = cmul(w8, w4);
        if (!INV) {
#pragma unroll
            for (int j = 0; j < 4; ++j) {
                bf4<false>(x[j], x[j + 4], x[j + 8], x[j + 12]);
                x[j + 4] = cmul(x[j + 4], w1); x[j + 8] = cmul(x[j + 8], w2); x[j + 12] = cmul(x[j + 12], w3);
            }
            tw16<false, 1>(x[5], x[9], x[13]); tw16<false, 2>(x[6], x[10], x[14]); tw16<false, 3>(x[7], x[11], x[15]);
#pragma unroll
            for (int r = 0; r < 4; ++r) {
                bf4<false>(x[4 * r], x[4 * r + 1], x[4 * r + 2], x[4 * r + 3]);
                x[4 * r + 1] = cmul(x[4 * r + 1], w4); x[4 * r + 2] = cmul(x[4 * r + 2], w8); x[4 * r + 3] = cmul(x[4 * r + 3], w12);
            }
        } else {
#pragma unroll
            for (int r = 0; r < 4; ++r) {
                x[4 * r + 1] = cmul(x[4 * r + 1], w4); x[4 * r + 2] = cmul(x[4 * r + 2], w8); x[4 * r + 3] = cmul(x[4 * r + 3], w12);
                bf4<true>(x[4 * r], x[4 * r + 1], x[4 * r + 2], x[4 * r + 3]);
            }
            tw16<true, 1>(x[5], x[9], x[13]); tw16<true, 2>(x[6], x[10], x[14]); tw16<true, 3>(x[7], x[11], x[15]);
#pragma unroll
            for (int j = 0; j < 4; ++j) {
                x[j + 4] = cmul(x[j + 4], w1); x[j + 8] = cmul(x[j + 8], w2); x[j + 12] = cmul(x[j + 12], w3);
                bf4<true>(x[j], x[j + 4], x[j + 8], x[j + 12]);
            }
        }
#pragma unroll
        for (int r = 0; r < 16; ++r) Fp[r * PSTR] = x[r];
    }
}
template <bool INV> __device__ __forceinline__ void r4_pass(LAS cf2* F, int tid) {
#pragma unroll 2
    for (int bi = 0; bi < 8; ++bi) {
        const int b = tid + 512 * bi; const int p = fphys(4 * b);
        f32x4 u0 = *(LAS f32x4*)(F + p), u1 = *(LAS f32x4*)(F + p + 2);
        cf2 x0 = mk2(u0[0], u0[1]), x1 = mk2(u0[2], u0[3]), x2 = mk2(u1[0], u1[1]), x3 = mk2(u1[2], u1[3]);
        bf4<INV>(x0, x1, x2, x3);
        *(LAS f32x4*)(F + p) = (f32x4){x0.x, x0.y, x1.x, x1.y}; *(LAS f32x4*)(F + p + 2) = (f32x4){x2.x, x2.y, x3.x, x3.y};
    }
}
__device__ __forceinline__ void fft_fwd(LAS cf2* F, int tid) {
    r16_pass<false, 10>(F, tid); __syncthreads(); r16_pass<false, 6>(F, tid); __syncthreads(); r16_pass<false, 2>(F, tid); __syncthreads(); r4_pass<false>(F, tid);
}
__device__ __forceinline__ void fft_inv(LAS cf2* F, int tid) {
    r4_pass<true>(F, tid); __syncthreads(); r16_pass<true, 2>(F, tid); __syncthreads(); r16_pass<true, 6>(F, tid); __syncthreads(); r16_pass<true, 10>(F, tid);
}
__device__ __forceinline__ float sconv(const bf16_t* p, int n, float w0, float w1, float w2, float b) {
    const float xm = n > 0 ? bf2f(p[n - 1]) : 0.f, x0 = bf2f(p[n]), xp = n < L - 1 ? bf2f(p[n + 1]) : 0.f;
    return b + w0 * xm + w1 * x0 + w2 * xp;
}
__device__ void fft_phase(const Args& a, bf16_t* pbT, LAS unsigned char* lds) {
    const int tid = opaque_tid(), lane = tid & 63, w = tid >> 6;
    LAS cf2* F = (LAS cf2*)lds;
    LAS float* red = (LAS float*)(lds + 17408 * 8);
    LAS cf2* Fo = F + fphys(tid);
    const half_t* KT = (const half_t*)(a.ws + WS_KT);
    unsigned char* scr = a.ws + WS_ACT + PBT_BYTES + (size_t)blockIdx.x * FFTSCR_PER_BLOCK;
    cf2* ybuf = (cf2*)scr;
    float* z1buf = (float*)(scr + 2ull * L * 8);
    const float* sw = a.in[15]; const float* sb = a.in[16]; const float* skip = a.in[23];
    for (int ch = blockIdx.x; ch < 512; ch += gridDim.x) {
        const float vw0 = sw[ch], vw1 = sw[1536 + ch], vw2 = sw[3072 + ch], vb = sb[ch];
#pragma unroll 1
        for (int o = 0; o < 2; ++o) {
            const half_t* kf = KT + ((size_t)((o * 512 + ch) * 2) << 14); const half_t* kb = kf + L;
            const int xc = (o == 0 ? 512 : 1024) + ch;
            const float gw0 = sw[xc], gw1 = sw[1536 + xc], gw2 = sw[3072 + xc], gb = sb[xc];
            const float skp = skip[o * 512 + ch];
            float ss = 0.f;
#pragma unroll 4
            for (int j = 0; j < 32; ++j) { const int n = tid + 512 * j; const float f = (float)kf[n], bk = n > 0 ? (float)kb[n] : 0.f; ss += f * f + bk * bk; }
#pragma unroll
            for (int of = 32; of > 0; of >>= 1) ss += __shfl_xor(ss, of);
            __syncthreads();
            if (lane == 0) red[w] = ss;
            __syncthreads();
            float tot = 0.f;
#pragma unroll
            for (int ww = 0; ww < 8; ++ww) tot += red[ww];
            const float kscale = rsqrtf(tot + EPS) * (0.5f / (float)L);
#pragma unroll 1
            for (int br = 0; br < 2; ++br) {
                __syncthreads();
#pragma unroll 2
                for (int j = 0; j < 32; ++j) {
                    const int n = tid + 512 * j; const float f = (float)kf[n], bk = n > 0 ? (float)kb[L - n] : 0.f;
                    cf2 v;
                    if (br == 0) v = mk2((f + bk) * kscale, 0.f);
                    else { const float d = (f - bk) * kscale, rev = (float)n * (1.0f / (float)(2 * L)); v = mk2(d * __builtin_amdgcn_cosf(rev), -d * __builtin_amdgcn_sinf(rev)); }
                    Fo[544 * j] = v;
                }
                __syncthreads();
                fft_fwd(F, tid);
                __syncthreads();
                cf2 Kr[32];
#pragma unroll
                for (int j = 0; j < 32; ++j) Kr[j] = Fo[544 * j];
#pragma unroll 1
                for (int pk = 0; pk < 2; ++pk) {
                    __syncthreads();
#pragma unroll 2
                    for (int j = 0; j < 32; ++j) {
                        const int n = tid + 512 * j; float re, im = 0.f;
                        if (o == 0) {
                            re = sconv(pbT + ((size_t)((2 * pk) * 1536 + ch) << 14), n, vw0, vw1, vw2, vb);
                            if (pk == 0) im = sconv(pbT + ((size_t)(1536 + ch) << 14), n, vw0, vw1, vw2, vb);
                        } else { re = z1buf[(2 * pk) * L + n]; if (pk == 0) im = z1buf[L + n]; }
                        cf2 v = mk2(re, im);
                        if (br == 1) { const float rev = (float)n * (1.0f / (float)(2 * L)); v = cmul(v, mk2(__builtin_amdgcn_cosf(rev), -__builtin_amdgcn_sinf(rev))); }
                        Fo[544 * j] = v;
                    }
                    __syncthreads();
                    fft_fwd(F, tid);
                    __syncthreads();
#pragma unroll
                    for (int j = 0; j < 32; ++j) Fo[544 * j] = cmul(Fo[544 * j], Kr[j]);
                    __syncthreads();
                    fft_inv(F, tid);
                    __syncthreads();
#pragma unroll 1
                    for (int j = 0; j < 32; ++j) {
                        const int n = tid + 512 * j;
                        cf2 r = Fo[544 * j];
                        if (br == 0) { ybuf[pk * L + n] = r; }
                        else {
                            const float rev = (float)n * (1.0f / (float)(2 * L));
                            r = cmul(r, mk2(__builtin_amdgcn_cosf(rev), __builtin_amdgcn_sinf(rev)));
                            const cf2 y0 = ybuf[pk * L + n];
                            const float yre = y0.x + r.x, yim = y0.y + r.y;
                            const int nseq = (pk == 0) ? 2 : 1;
                            for (int q = 0; q < nseq; ++q) {
                                const int s = 2 * pk + q; const float yv = q == 0 ? yre : yim;
                                const float gate = sconv(pbT + ((size_t)(s * 1536 + xc) << 14), n, gw0, gw1, gw2, gb);
                                if (o == 0) {
                                    const float vv = sconv(pbT + ((size_t)(s * 1536 + ch) << 14), n, vw0, vw1, vw2, vb);
                                    z1buf[s * L + n] = gate * (yv + vv * skp);
                                } else {
                                    const float zz = gate * (yv + z1buf[s * L + n] * skp);
                                    pbT[((size_t)(s * 1536 + ch) << 14) + n] = f2bf(zz);
                                }
                            }
                        }
                    }
                }
            }
            __syncthreads();
        }
    }
    __syncthreads();
}

__device__ void ztrans_phase(const bf16_t* pbT, bf16_t* cat, LAS unsigned char* lds) {
    const int tid = opaque_tid();
    LAS unsigned* tl = (LAS unsigned*)lds;
    LAS bf16_t* tb = (LAS bf16_t*)lds;
    for (int tile = blockIdx.x; tile < 6144; tile += gridDim.x) {
        const int tt0 = (tile & 255) * 64, ct = (tile >> 8) & 7, s = tile >> 11;
        __syncthreads();
        { const int cc = tid >> 3, tk = (tid & 7) * 8;
          const u32x4 v = *(const u32x4*)(pbT + ((size_t)(s * 1536 + ct * 64 + cc) << 14) + tt0 + tk);
#pragma unroll
          for (int q = 0; q < 4; ++q) tl[cc * 33 + (tk >> 1) + q] = v[q]; }
        __syncthreads();
        { const int tt = tid >> 3, cg8 = (tid & 7) * 8; bf16_t e[8];
#pragma unroll
          for (int i = 0; i < 8; ++i) e[i] = tb[(cg8 + i) * 66 + tt];
          u32x4 wv; wv.x = e[0] | ((unsigned)e[1] << 16); wv.y = e[2] | ((unsigned)e[3] << 16); wv.z = e[4] | ((unsigned)e[5] << 16); wv.w = e[6] | ((unsigned)e[7] << 16);
          *(u32x4*)(cat + (size_t)(s * L + tt0 + tt) * 1024 + 512 + ct * 64 + cg8) = wv; }
    }
    __syncthreads();
}

__device__ void attn_phase(const Args& a, const bf16_t* qkv, bf16_t* ao, LAS unsigned char* lds) {
    const int tid = opaque_tid(), lane = tid & 63, w = tid >> 6, l31 = lane & 31, hh = lane >> 5;
    LAS bf16_t* Ks = (LAS bf16_t*)lds;
    LAS bf16_t* VT = (LAS bf16_t*)(lds + 384 * 72 * 2);
    const float* sink = a.in[26];
    for (int item = blockIdx.x; item < 1536; item += gridDim.x) {
        const int kvh = item & 3, qb = (item >> 2) & 127, seq = item >> 9;
        const int kb0 = qb * 128 - 128;
        __syncthreads();
        for (int idx = tid; idx < 384 * 8; idx += 512) {
            const int key = idx % 384, dc = idx / 384, kpos = kb0 + key;
            u32x4 kv = (u32x4){0u, 0u, 0u, 0u}, vv = (u32x4){0u, 0u, 0u, 0u};
            if (kpos >= 0 && kpos < L) { const bf16_t* rp = qkv + (size_t)(seq * L + kpos) * 1536 + kvh * 64 + dc * 8; kv = *(const u32x4*)(rp + 1024); vv = *(const u32x4*)(rp + 1280); }
            *(LAS u32x4*)(Ks + key * 72 + dc * 8) = kv;
#pragma unroll
            for (int i = 0; i < 8; ++i) VT[(dc * 8 + i) * 392 + key] = (bf16_t)((vv[i >> 1] >> (16 * (i & 1))) & 0xffffu);
        }
        __syncthreads();
        for (int uu = 0; uu < 2; ++uu) {
            const int u = w + 8 * uu, g = u >> 2, qs = u & 3, h = kvh * 4 + g, q0 = qb * 128 + 32 * qs;
            bf16x8 qf[4];
            const bf16_t* qp = qkv + (size_t)(seq * L + q0 + l31) * 1536 + h * 64 + 8 * hh;
#pragma unroll
            for (int ks = 0; ks < 4; ++ks) qf[ks] = *(const bf16x8*)(qp + 16 * ks);
            const float slope = exp2f(-0.5f * (float)(h + 1));
            float m = sink[h], lsum = 1.0f;
            f32x16 O0, O1;
#pragma unroll
            for (int r = 0; r < 16; ++r) { O0[r] = 0.f; O1[r] = 0.f; }
#pragma unroll 1
            for (int kt = 0; kt < 9; ++kt) {
                const int kl0 = 32 * qs + 32 * kt;
                f32x16 S;
#pragma unroll
                for (int r = 0; r < 16; ++r) S[r] = 0.f;
#pragma unroll
                for (int ks = 0; ks < 4; ++ks) { const bf16x8 af = *(const LAS bf16x8*)(Ks + (kl0 + l31) * 72 + 16 * ks + 8 * hh); S = __builtin_amdgcn_mfma_f32_32x32x16_bf16(af, qf[ks], S, 0, 0, 0); }
                float p[16]; float mt = -1e30f;
#pragma unroll
                for (int r = 0; r < 16; ++r) {
                    const int i = 8 * (r >> 2) + 4 * hh + (r & 3);
                    const int dist = 32 * kt + i - l31 - 128, kpos = q0 - 128 + 32 * kt + i;
                    const int ad = dist < 0 ? -dist : dist;
                    const bool valid = (ad <= 128) && (kpos >= 0) && (kpos < L);
                    p[r] = valid ? (S[r] * 0.125f - slope * (float)ad) : -1e30f;
                    mt = fmaxf(mt, p[r]);
                }
                mt = fmaxf(mt, __shfl_xor(mt, 32));
                const float mnew = fmaxf(m, mt), alpha = __expf(m - mnew);
                float rs = 0.f;
#pragma unroll
                for (int r = 0; r < 16; ++r) { p[r] = __expf(p[r] - mnew); rs += p[r]; }
                rs += __shfl_xor(rs, 32);
                lsum = lsum * alpha + rs; m = mnew;
#pragma unroll
                for (int r = 0; r < 16; ++r) { O0[r] *= alpha; O1[r] *= alpha; }
#pragma unroll
                for (int kk = 0; kk < 2; ++kk) {
                    u32x4 pw; pw.x = pk_bf16(p[8 * kk], p[8 * kk + 1]); pw.y = pk_bf16(p[8 * kk + 2], p[8 * kk + 3]); pw.z = pk_bf16(p[8 * kk + 4], p[8 * kk + 5]); pw.w = pk_bf16(p[8 * kk + 6], p[8 * kk + 7]);
                    const bf16x8 pf = __builtin_bit_cast(bf16x8, pw);
#pragma unroll
                    for (int dt = 0; dt < 2; ++dt) {
                        const LAS bf16_t* vp = VT + (32 * dt + l31) * 392 + kl0 + 16 * kk + 4 * hh;
                        const u32x2 lo = *(const LAS u32x2*)vp, hi = *(const LAS u32x2*)(vp + 8);
                        const bf16x8 vf = __builtin_bit_cast(bf16x8, (u32x4){lo.x, lo.y, hi.x, hi.y});
                        if (dt == 0) O0 = __builtin_amdgcn_mfma_f32_32x32x16_bf16(vf, pf, O0, 0, 0, 0);
                        else O1 = __builtin_amdgcn_mfma_f32_32x32x16_bf16(vf, pf, O1, 0, 0, 0);
                    }
                }
            }
            const float inv = 1.0f / lsum;
            bf16_t* op = ao + (size_t)(seq * L + q0 + l31) * 1024 + h * 64 + 4 * hh;
#pragma unroll
            for (int b = 0; b < 4; ++b) {
                u32x2 o0; o0.x = pk_bf16(O0[4 * b] * inv, O0[4 * b + 1] * inv); o0.y = pk_bf16(O0[4 * b + 2] * inv, O0[4 * b + 3] * inv);
                u32x2 o1; o1.x = pk_bf16(O1[4 * b] * inv, O1[4 * b + 1] * inv); o1.y = pk_bf16(O1[4 * b + 2] * inv, O1[4 * b + 3] * inv);
                *(u32x2*)(op + 8 * b) = o0; *(u32x2*)(op + 32 + 8 * b) = o1;
            }
        }
    }
    __syncthreads();
}

__global__ void __launch_bounds__(512, 2) mega(Args a) {
    extern __shared__ __attribute__((aligned(16))) unsigned char lds_raw[];
    LAS unsigned char* lds = (LAS unsigned char*)lds_raw;
    unsigned char* ws = a.ws;
    const int lo = a.ph_lo, hi = a.ph_hi;
    float* X = a.out;
    const float* mod = (const float*)(ws + WS_MOD);
    bf16_t* H = (bf16_t*)(ws + WS_H);
    bf16_t* ACT = (bf16_t*)(ws + WS_ACT);
    bf16_t* PBT = ACT;
    bf16_t* PA = (bf16_t*)(ws + WS_ACT + PBT_BYTES);
    const int G = gridDim.x, bx = blockIdx.x;
#define IN(k) (lo <= (k) && (k) < hi)
#define SEAM(k) do { if (IN(k) && IN((k) + 1)) cg::this_grid().sync(); } while (0)
    int ph = 0;
    if (IN(0)) { if (EN(0)) convert_weights(a, (LAS float*)lds); if (EN(1)) ada_phase(a, (LAS float*)lds); if (EN(2)) filter_phase(a, (LAS float*)lds); }
    SEAM(0);
    ph = 1;
#pragma unroll 1
    for (int layer = 0; layer < 2; ++layer) {
        const float* ml = mod + (size_t)layer * 3 * 9216;
        const float* ng = a.in[6] + layer * 3 * 1024;
#pragma unroll 1
        for (int sub = 0; sub < 3; ++sub) {
            const bool first = (layer == 0 && sub == 0);
            const float* xs0 = first ? a.in[0] : X; const float* xs1 = first ? a.in[1] : X + (size_t)32768 * 1024;
            const float* shp = ml + (3 * sub) * 1024; const float* scp = shp + 1024; const float* gp = shp + 2048;
            if (EN(3) && IN(ph)) norm_phase(xs0, xs1, ng + sub * 1024, shp, scp, H);
            SEAM(ph); ++ph;
            if (sub != 1) {
                const int fi = layer * 2 + (sub == 2 ? 1 : 0);
                if (EN(4) && IN(ph)) { pg8::Gemm g{H, (const bf16_t*)(ws + WS_WIN) + (size_t)fi * 5632 * 1024, T, 5632, 1024}; pg8::StaticOrder S; S.init(T, 5632, G, bx);
                    EpiSwiglu E{ACT}; pg8::gemm_phase<EpiSwiglu>(lds, g, S, E); }
                SEAM(ph); ++ph;
                if (EN(5) && IN(ph)) { pg8::Gemm g{ACT, (const bf16_t*)(ws + WS_WOUT) + (size_t)fi * 1024 * 2816, T, 1024, DFF}; pg8::StaticOrder S; S.init(T, 1024, G, bx);
                    EpiResid E{xs0, xs1, X, gp, 0.5f}; pg8::gemm_phase<EpiResid>(lds, g, S, E); }
                SEAM(ph); ++ph;
            } else if (layer == 0) {
                if (EN(6) && IN(ph)) { pg8::Gemm g{H, (const bf16_t*)(ws + WS_WABIN), T, 2560, 1024}; pg8::StaticOrder S; S.init(T, 2560, G, bx);
                    EpiProj E{PA, PBT}; pg8::gemm_phase<EpiProj>(lds, g, S, E); }
                SEAM(ph); ++ph;
                if (IN(ph)) { if (EN(7)) conva_phase(a, PA, H, lds); if (EN(8)) fft_phase(a, PBT, lds); }
                SEAM(ph); ++ph;
                if (EN(9) && IN(ph)) ztrans_phase(PBT, H, lds);
                SEAM(ph); ++ph;
                if (EN(5) && IN(ph)) { pg8::Gemm g{H, (const bf16_t*)(ws + WS_WABOUT), T, 1024, 1024}; pg8::StaticOrder S; S.init(T, 1024, G, bx);
                    EpiResid E{xs0, xs1, X, gp, 1.0f}; pg8::gemm_phase<EpiResid>(lds, g, S, E); }
                SEAM(ph); ++ph;
            } else {
                if (EN(10) && IN(ph)) { pg8::Gemm g{H, (const bf16_t*)(ws + WS_WQKV), T, 1536, 1024}; pg8::StaticOrder S; S.init(T, 1536, G, bx);
                    EpiBf16 E{ACT, 1536}; pg8::gemm_phase<EpiBf16>(lds, g, S, E); }
                SEAM(ph); ++ph;
                if (EN(11) && IN(ph)) attn_phase(a, ACT, H, lds);
                SEAM(ph); ++ph;
                if (EN(5) && IN(ph)) { pg8::Gemm g{H, (const bf16_t*)(ws + WS_WATTO), T, 1024, 1024}; pg8::StaticOrder S; S.init(T, 1024, G, bx);
                    EpiResid E{xs0, xs1, X, gp, 1.0f}; pg8::gemm_phase<EpiResid>(lds, g, S, E); }
                SEAM(ph); ++ph;
            }
        }
    }
    if (EN(12) && IN(ph)) final_norm_phase(X, a.in[9]);
#undef IN
#undef SEAM
}

extern "C" void kernel_launch(void* const* d_in, const int* in_sizes, int n_in, void* d_out, int out_size, void* d_ws, size_t ws_size, hipStream_t stream) {
    static int grid = 0;
    if (grid == 0) {
        int dev = 0, cus = 0, per_cu = 0;
        (void)hipGetDevice(&dev);
        (void)hipDeviceGetAttribute(&cus, hipDeviceAttributeMultiprocessorCount, dev);
        (void)hipFuncSetAttribute((const void*)mega, hipFuncAttributeMaxDynamicSharedMemorySize, LDS_BYTES);
        (void)hipOccupancyMaxActiveBlocksPerMultiprocessor(&per_cu, (const void*)mega, 512, LDS_BYTES);
        if (per_cu < 1) per_cu = 1;
        grid = cus * per_cu;
        if (grid > 256) grid = 256;
        if (ws_size < WS_END) { fprintf(stderr, "workspace too small: %zu < %zu\n", ws_size, (size_t)WS_END); grid = -1; }
    }
    if (grid < 0) return;
    Args a{};
    for (int i = 0; i < 28; ++i) a.in[i] = (const float*)d_in[i];
    a.out = (float*)d_out; a.ws = (unsigned char*)d_ws;
#if N_LAUNCH_MODE == 1
    a.ph_lo = 0; a.ph_hi = NPH;
    void* args[] = {&a};
    hipError_t e = hipLaunchCooperativeKernel((const void*)mega, dim3(grid), dim3(512), args, LDS_BYTES, stream);
    if (e != hipSuccess) fprintf(stderr, "cooperative launch failed: %s (grid %d)\n", hipGetErrorString(e), grid);
#else
    for (int p = 0; p < NPH; ++p) { a.ph_lo = p; a.ph_hi = p + 1; hipLaunchKernelGGL(mega, dim3(grid), dim3(512), LDS_BYTES, stream, a); }
#endif
}
```

```cpp
#include <hip/hip_runtime.h>
#include <hip/hip_cooperative_groups.h>
#include <cstdio>
namespace cg = cooperative_groups;

#ifndef PM
#define PM 0xffff
#endif
#define EN(b) ((PM >> (b)) & 1)
#ifndef RM
#define RM 0
#endif
#define REP(b) for (int rep_ = 0; rep_ < 1 + ((RM >> (b)) & 1); ++rep_)
#ifndef N_LAUNCH_MODE
#define N_LAUNCH_MODE 1
#endif

#define LAS __attribute__((address_space(3)))
typedef unsigned short bf16_t;
typedef short bf16x8 __attribute__((ext_vector_type(8)));
typedef float f32x4 __attribute__((ext_vector_type(4)));
typedef float f32x16 __attribute__((ext_vector_type(16)));
typedef unsigned u32x4 __attribute__((ext_vector_type(4)));
typedef unsigned u32x2 __attribute__((ext_vector_type(2)));
typedef __bf16 bf16x2v __attribute__((ext_vector_type(2)));
typedef float f32x2v __attribute__((ext_vector_type(2)));
typedef _Float16 half_t;

constexpr int T = 49152, D = 1024, L = 16384, DFF = 2816, NPH = 23;
constexpr float EPS = 1e-6f;
constexpr int LDS_BYTES = 147456;

constexpr size_t WS_WIN = 0;
constexpr size_t WS_WOUT = WS_WIN + 4ull * 5632 * 1024 * 2;
constexpr size_t WS_WABIN = WS_WOUT + 4ull * 1024 * 2816 * 2;
constexpr size_t WS_WABOUT = WS_WABIN + 2560ull * 1024 * 2;
constexpr size_t WS_WQKV = WS_WABOUT + 1024ull * 1024 * 2;
constexpr size_t WS_WATTO = WS_WQKV + 1536ull * 1024 * 2;
constexpr size_t WS_MOD = WS_WATTO + 1024ull * 1024 * 2;
constexpr size_t WS_BAR = WS_MOD + 221184;
constexpr size_t WS_H = WS_MOD + 262144;
constexpr size_t WS_ACT = WS_H + (size_t)T * 1024 * 2;
constexpr size_t WS_KT = WS_ACT + (size_t)T * DFF * 2;
constexpr size_t WS_END = WS_KT + 2ull * 512 * 2 * L * 2;
constexpr size_t PBT_BYTES = 3ull * 1536 * L * 2;
constexpr size_t FFTSCR_PER_BLOCK = 2ull * L * 8 + 3ull * L * 4;

__device__ __forceinline__ unsigned pk_bf16(float a, float b) { f32x2v f = {a, b}; bf16x2v r = __builtin_convertvector(f, bf16x2v); return __builtin_bit_cast(unsigned, r); }
__device__ __forceinline__ float bf_lo(unsigned v) { return __uint_as_float(v << 16); }
__device__ __forceinline__ float bf_hi(unsigned v) { return __uint_as_float(v & 0xffff0000u); }
__device__ __forceinline__ float bf2f(bf16_t v) { return __uint_as_float((unsigned)v << 16); }
__device__ __forceinline__ bf16_t f2bf(float f) { return (bf16_t)(pk_bf16(f, 0.f) & 0xffffu); }
__device__ __forceinline__ float fsigmoid(float x) { return __builtin_amdgcn_rcpf(1.0f + __expf(-x)); }
__device__ __forceinline__ float hw_sin(float x) { return __builtin_amdgcn_sinf(x * 0.15915494309189535f); }

__device__ __forceinline__ int opaque_tid() { int t = threadIdx.x; asm volatile("" : "+v"(t)); return t; }

#define XB_TMO      128
#define XB_XCNT(j)  (256  + 64 * (j))
#define XB_XSUB(j)  (1280 + 64 * (j))
#define XB_XGEN(j)  (2304 + 64 * (j))
#define XB_TOP      3328
#define XB_TOPGEN   3392
#define XCD_BAR_WORDS 3456
#define XB_SPIN_CAP (1u << 22)
__device__ __forceinline__ unsigned xb_ld(unsigned* p)              { return __hip_atomic_load(p, __ATOMIC_RELAXED, __HIP_MEMORY_SCOPE_AGENT); }
__device__ __forceinline__ unsigned xb_add(unsigned* p, unsigned v) { return __hip_atomic_fetch_add(p, v, __ATOMIC_RELAXED, __HIP_MEMORY_SCOPE_AGENT); }
__device__ __forceinline__ unsigned xb_xcc_id() { return (unsigned)__builtin_amdgcn_s_getreg((3 << 11) | 20) & 0xFu; }
#define XB_SPIN(cond, bar) do { unsigned _sp = 0; while (cond) { __builtin_amdgcn_s_sleep(1); \
    if ((++_sp & 255u) == 0u) { if (xb_ld(&(bar)[XB_TMO])) break; if (_sp > XB_SPIN_CAP) { atomicAdd(&(bar)[XB_TMO], 1u); break; } } } } while (0)
struct XcdBarrier { unsigned* bar; unsigned x; volatile LAS unsigned* st; };
__device__ __forceinline__ XcdBarrier xcd_barrier_post(unsigned* bar, volatile LAS unsigned* st) {
    XcdBarrier b; b.bar = bar; b.x = xb_xcc_id(); b.st = st;
    if (threadIdx.x == 0) (void)xb_add(&bar[XB_XCNT(b.x)], 1u);
    return b;
}
__device__ __forceinline__ void xcd_barrier_complete(unsigned* bar, unsigned x, unsigned& nloc, unsigned& nx) {
    const unsigned G = gridDim.x * gridDim.y * gridDim.z;
    unsigned sum, cnt, mine, sp = 0u;
    for (;;) {
        sum = 0u; cnt = 0u; mine = 0u;
#pragma unroll
        for (unsigned j = 0; j < 16; ++j) { const unsigned c = xb_ld(&bar[XB_XCNT(j)]); sum += c; cnt += (c > 0u) ? 1u : 0u; mine = (j == x) ? c : mine; }
        if (sum == G) break;
        __builtin_amdgcn_s_sleep(1);
        if ((++sp & 255u) == 0u) { if (xb_ld(&bar[XB_TMO])) break; if (sp > XB_SPIN_CAP) { atomicAdd(&bar[XB_TMO], 1u); break; } }
    }
    nloc = mine > 0u ? mine : 1u; nx = cnt > 0u ? cnt : 1u;
}
__device__ __forceinline__ void xcd_barrier(const XcdBarrier& b) {
    asm volatile("s_waitcnt vmcnt(0)" ::: "memory");
    __syncthreads();
    if (threadIdx.x == 0) {
        unsigned* bar = b.bar;
        __builtin_amdgcn_s_waitcnt(0);
        unsigned nloc = b.st[0], nx = b.st[1];
        if (nloc == 0u) { xcd_barrier_complete(bar, b.x, nloc, nx); b.st[0] = nloc; b.st[1] = nx; }
        const unsigned old = xb_add(&bar[XB_XSUB(b.x)], 1u);
        const unsigned gen = old / nloc;
        if (old + 1u == (gen + 1u) * nloc) {
            __builtin_amdgcn_fence(__ATOMIC_RELEASE, "agent");
            asm volatile("s_waitcnt vmcnt(0)" ::: "memory");
            const unsigned og = xb_add(&bar[XB_TOP], 1u);
            const unsigned tg = og / nx;
            if (og + 1u == (tg + 1u) * nx) xb_add(&bar[XB_TOPGEN], 1u);
            else XB_SPIN(xb_ld(&bar[XB_TOPGEN]) == tg, bar);
            __builtin_amdgcn_fence(__ATOMIC_ACQUIRE, "agent");
            xb_add(&bar[XB_XGEN(b.x)], 1u);
            asm volatile("s_waitcnt vmcnt(0)" ::: "memory");
        } else {
            XB_SPIN(xb_ld(&bar[XB_XGEN(b.x)]) == gen, bar);
            __builtin_amdgcn_fence(__ATOMIC_ACQUIRE, "agent");
            asm volatile("s_waitcnt vmcnt(0)" ::: "memory");
        }
    }
    __syncthreads();
}

struct Args { const float* in[28]; float* out; unsigned char* ws; int ph_lo, ph_hi; };

namespace pg8 {
constexpr int BM = 256, BK = 64, HALF = 128, HTB = HALF * BK * 2, STAGE_BYTES = 8 * HTB, NXCD = 8, WGM = 8;
__device__ __forceinline__ int lds_byte(int r, int c) { const int st = (r >> 4) * 2 + (c >> 5), rr = r & 15, cc = c & 31, ob = rr * 64 + cc * 2; return st * 1024 + (ob ^ (((ob >> 9) & 1) << 5)); }
__device__ __forceinline__ void stage_rc(int b, int& R, int& C) { const int st = b / 1024, sb = b % 1024, swz = sb ^ (((sb >> 9) & 1) << 5); R = (st >> 1) * 16 + swz / 64; C = (st & 1) * 32 + (swz % 64) / 2; }
__device__ __forceinline__ int perm32(int rho) { const int n = rho >> 4, i = rho & 15; return 8 * (i >> 2) + 4 * n + (i & 3); }
struct Unit { int pm, pn; };
struct Gemm { const bf16_t* A; const bf16_t* Bt; int M, N, K; };
struct StaticOrder {
    int nM, nN, nwg, G, c;
    __device__ void init(int M, int N, int G_, int c_) { nM = M / BM; nN = N / BM; nwg = nM * nN; G = G_; c = c_; }
    __device__ bool next(int i, Unit& u) const {
        const long Lx = (long)i * G + c; if (Lx >= nwg) return false;
        int wgid = (int)Lx; { const int q = nwg / NXCD, r = nwg % NXCD, xcd = wgid % NXCD, off = wgid / NXCD; wgid = (xcd < r ? xcd * (q + 1) : r * (q + 1) + (xcd - r) * q) + off; }
        const int nig = WGM * nN, gid = wgid / nig, fm = gid * WGM, gsz = (nM - fm) < WGM ? (nM - fm) : WGM;
        u.pm = fm + ((wgid % nig) % gsz); u.pn = (wgid % nig) / gsz; return true;
    }
};

template <class Epi>
__device__ __forceinline__ void gemm_phase(LAS unsigned char* lds, const Gemm g, const StaticOrder& S, const Epi& E) {
    const int tid = opaque_tid(), wid = __builtin_amdgcn_readfirstlane(tid >> 6), lane = tid & 63, wr = wid >> 2, wc = wid & 3, fr = lane & 15, fq = lane >> 4;
    const int K = g.K, nt = K / BK;
    unsigned voffA[2], voffB[2];
#pragma unroll
    for (int i = 0; i < 2; ++i) { int R, C; stage_rc(tid * 16 + i * 8192, R, C); const int Rb = Epi::PERM ? ((R & ~31) + perm32(R & 31)) : R;
        voffA[i] = (unsigned)(R * K + C) * 2u; voffB[i] = (unsigned)(Rb * K + C) * 2u; }
    const size_t kstep = (size_t)(BK * 2);
    const size_t hstep = (size_t)HALF * K * 2;
    const size_t tstep = 2 * hstep;
    const unsigned ldsw = (unsigned)wid * 1024u;
    const int aoff = lds_byte(wr * 64 + fr, fq * 8), boff = lds_byte(wc * 32 + fr, fq * 8);
#define PG8_SA(b, h) (((b) * 2 + (h)) * HTB)
#define PG8_SB(b, h) ((4 + (b) * 2 + (h)) * HTB)
#define PG8_STAGE(bufoff, gbase, voff) do { _Pragma("unroll") for (int _i = 0; _i < 2; ++_i) \
        __builtin_amdgcn_global_load_lds((const unsigned*)((const char*)(gbase) + (voff)[_i]), (LAS unsigned*)(lds + (bufoff) + ldsw + _i * 8192), 16, 0, 0); } while (0)
#define PG8_LDA(dst, b, h) do { _Pragma("unroll") for (int m = 0; m < 4; ++m) _Pragma("unroll") for (int k = 0; k < 2; ++k) dst[m][k] = *(const LAS bf16x8*)(lds + PG8_SA(b, h) + aoff + m * 2048 + k * 1024); } while (0)
#define PG8_LDB(dst, b, h) do { _Pragma("unroll") for (int n = 0; n < 2; ++n) _Pragma("unroll") for (int k = 0; k < 2; ++k) dst[n][k] = *(const LAS bf16x8*)(lds + PG8_SB(b, h) + boff + n * 2048 + k * 1024); } while (0)
#define PG8_MMA(ai, bj, At, Bt) do { __builtin_amdgcn_s_setprio(1); _Pragma("unroll") for (int m = 0; m < 4; ++m) _Pragma("unroll") for (int n = 0; n < 2; ++n) _Pragma("unroll") for (int k = 0; k < 2; ++k) \
        acc[ai][bj][m][n] = __builtin_amdgcn_mfma_f32_16x16x32_bf16(Bt[n][k], At[m][k], acc[ai][bj][m][n], 0, 0, 0); __builtin_amdgcn_s_setprio(0); } while (0)
#define PG8_WAIT_V(n) asm volatile("s_waitcnt vmcnt(" #n ")" ::: "memory")
#define PG8_WAIT_L(n) asm volatile("s_waitcnt lgkmcnt(" #n ")" ::: "memory")
#define PG8_BAR __builtin_amdgcn_s_barrier()
#define PG8_SCHED __builtin_amdgcn_sched_barrier(0)
    Unit cur, nxt; int ui = 0;
    if (!S.next(0, cur)) return;
    f32x4 acc[2][2][4][2];
#pragma unroll
    for (int a = 0; a < 2; ++a)
#pragma unroll
        for (int b = 0; b < 2; ++b)
#pragma unroll
            for (int m = 0; m < 4; ++m)
#pragma unroll
                for (int n = 0; n < 2; ++n) acc[a][b][m][n] = (f32x4){0.f, 0.f, 0.f, 0.f};
    bf16x8 At[4][2], B0[2][2], B1[2][2];
    const char* cA = (const char*)g.A + (size_t)cur.pm * tstep; const char* cB = (const char*)g.Bt + (size_t)cur.pn * tstep;
    PG8_STAGE(PG8_SB(0, 0), cB, voffB); PG8_STAGE(PG8_SA(0, 0), cA, voffA); PG8_STAGE(PG8_SB(0, 1), cB + hstep, voffB); PG8_STAGE(PG8_SA(0, 1), cA + hstep, voffA);
    if (wr == 1) PG8_BAR;
    PG8_WAIT_V(4); PG8_BAR;
    PG8_STAGE(PG8_SB(1, 0), cB + kstep, voffB); PG8_STAGE(PG8_SA(1, 0), cA + kstep, voffA); PG8_STAGE(PG8_SB(1, 1), cB + hstep + kstep, voffB);
    PG8_WAIT_V(6); PG8_BAR;
    for (;;) {
        const bool has_next = S.next(ui + 1, nxt);
        const char* nA = has_next ? (const char*)g.A + (size_t)nxt.pm * tstep : cA; const char* nB = has_next ? (const char*)g.Bt + (size_t)nxt.pn * tstep : cB;
        for (int t = 0; t < nt; t += 2) {
            const bool last = (t == nt - 2);
            const char* a1 = cA + (size_t)(t + 1) * kstep;
            const char* a2 = last ? nA : cA + (size_t)(t + 2) * kstep; const char* b2 = last ? nB : cB + (size_t)(t + 2) * kstep;
            const char* a3 = a2 + kstep; const char* b3 = b2 + kstep;
            PG8_LDB(B0, 0, 0); PG8_SCHED; PG8_LDA(At, 0, 0); PG8_STAGE(PG8_SA(1, 1), a1 + hstep, voffA);
            PG8_WAIT_L(8); PG8_BAR; PG8_WAIT_L(0); PG8_MMA(0, 0, At, B0); PG8_BAR; PG8_SCHED;
            PG8_LDB(B1, 0, 1); PG8_STAGE(PG8_SB(0, 0), b2, voffB);
            PG8_BAR; PG8_WAIT_L(0); PG8_MMA(0, 1, At, B1); PG8_BAR;
            PG8_LDA(At, 0, 1); PG8_STAGE(PG8_SA(0, 0), a2, voffA);
            PG8_BAR; PG8_WAIT_L(0); PG8_MMA(1, 0, At, B0); PG8_BAR; PG8_SCHED;
            PG8_STAGE(PG8_SB(0, 1), b2 + hstep, voffB);
            PG8_WAIT_V(6); PG8_BAR; PG8_MMA(1, 1, At, B1); PG8_BAR;
            PG8_LDB(B0, 1, 0); PG8_SCHED; PG8_LDA(At, 1, 0); PG8_STAGE(PG8_SA(0, 1), a2 + hstep, voffA);
            PG8_WAIT_L(8); PG8_BAR; PG8_WAIT_L(0); PG8_MMA(0, 0, At, B0); PG8_BAR; PG8_SCHED;
            PG8_LDB(B1, 1, 1); PG8_STAGE(PG8_SB(1, 0), b3, voffB);
            PG8_BAR; PG8_WAIT_L(0); PG8_MMA(0, 1, At, B1); PG8_BAR;
            PG8_LDA(At, 1, 1); PG8_STAGE(PG8_SA(1, 0), a3, voffA);
            PG8_BAR; PG8_WAIT_L(0); PG8_MMA(1, 0, At, B0); PG8_BAR; PG8_SCHED;
            PG8_STAGE(PG8_SB(1, 1), b3 + hstep, voffB);
            PG8_WAIT_V(6); PG8_BAR; PG8_MMA(1, 1, At, B1); PG8_BAR;
        }
        E(acc, cur, wr, wc, fr, fq);
        if (!has_next) break;
#pragma unroll
        for (int a = 0; a < 2; ++a)
#pragma unroll
            for (int b = 0; b < 2; ++b)
#pragma unroll
                for (int m = 0; m < 4; ++m)
#pragma unroll
                    for (int n = 0; n < 2; ++n) acc[a][b][m][n] = (f32x4){0.f, 0.f, 0.f, 0.f};
        cur = nxt; cA = nA; cB = nB; ++ui;
    }
    PG8_WAIT_V(0);
    if (wr == 0) PG8_BAR;
    PG8_BAR;
#undef PG8_SA
#undef PG8_SB
#undef PG8_STAGE
#undef PG8_LDA
#undef PG8_LDB
#undef PG8_MMA
#undef PG8_WAIT_V
#undef PG8_WAIT_L
#undef PG8_BAR
#undef PG8_SCHED
}
}

struct EpiSwiglu {
    static constexpr bool PERM = true;
    bf16_t* O;
    __device__ __forceinline__ void operator()(const f32x4 (&acc)[2][2][4][2], const pg8::Unit& u, int wr, int wc, int fr, int fq) const {
        const int row0 = u.pm * 256 + wr * 64 + fr, col0 = u.pn * 128 + wc * 32 + 8 * fq;
#pragma unroll
        for (int ai = 0; ai < 2; ++ai)
#pragma unroll
            for (int m = 0; m < 4; ++m) {
                bf16_t* rowp = O + (size_t)(row0 + ai * 128 + m * 16) * DFF + col0;
                float v[8];
#pragma unroll
                for (int n = 0; n < 2; ++n)
#pragma unroll
                    for (int j = 0; j < 4; ++j) { const float gg = acc[ai][0][m][n][j], uu = acc[ai][1][m][n][j]; v[n * 4 + j] = gg * fsigmoid(gg) * uu; }
                u32x4 w; w.x = pk_bf16(v[0], v[1]); w.y = pk_bf16(v[2], v[3]); w.z = pk_bf16(v[4], v[5]); w.w = pk_bf16(v[6], v[7]);
                *(u32x4*)rowp = w;
            }
    }
};
struct EpiBf16 {
    static constexpr bool PERM = true;
    bf16_t* O; int ldc;
    __device__ __forceinline__ void operator()(const f32x4 (&acc)[2][2][4][2], const pg8::Unit& u, int wr, int wc, int fr, int fq) const {
        const int row0 = u.pm * 256 + wr * 64 + fr, col0 = u.pn * 256 + wc * 32 + 8 * fq;
#pragma unroll
        for (int ai = 0; ai < 2; ++ai)
#pragma unroll
            for (int m = 0; m < 4; ++m) {
                bf16_t* rowp = O + (size_t)(row0 + ai * 128 + m * 16) * ldc + col0;
#pragma unroll
                for (int bj = 0; bj < 2; ++bj) {
                    const f32x4 v0 = acc[ai][bj][m][0], v1 = acc[ai][bj][m][1];
                    u32x4 w; w.x = pk_bf16(v0[0], v0[1]); w.y = pk_bf16(v0[2], v0[3]); w.z = pk_bf16(v1[0], v1[1]); w.w = pk_bf16(v1[2], v1[3]);
                    *(u32x4*)(rowp + bj * 128) = w;
                }
            }
    }
};
struct EpiProj {
    static constexpr bool PERM = true;
    bf16_t* Oa; bf16_t* ObT;
    __device__ __forceinline__ void operator()(const f32x4 (&acc)[2][2][4][2], const pg8::Unit& u, int wr, int wc, int fr, int fq) const {
        const int row0 = u.pm * 256 + wr * 64 + fr;
        if (u.pn < 4) {
            const int col0 = u.pn * 256 + wc * 32 + 8 * fq;
#pragma unroll
            for (int ai = 0; ai < 2; ++ai)
#pragma unroll
                for (int m = 0; m < 4; ++m) {
                    bf16_t* rowp = Oa + (size_t)(row0 + ai * 128 + m * 16) * 1024 + col0;
#pragma unroll
                    for (int bj = 0; bj < 2; ++bj) {
                        const f32x4 v0 = acc[ai][bj][m][0], v1 = acc[ai][bj][m][1];
                        u32x4 w; w.x = pk_bf16(v0[0], v0[1]); w.y = pk_bf16(v0[2], v0[3]); w.z = pk_bf16(v1[0], v1[1]); w.w = pk_bf16(v1[2], v1[3]);
                        *(u32x4*)(rowp + bj * 128) = w;
                    }
                }
        } else {
            const int seq = (u.pm * 256) >> 14;
            const int c0 = (u.pn - 4) * 256 + wc * 32 + 8 * fq;
#pragma unroll
            for (int ai = 0; ai < 2; ++ai)
#pragma unroll
                for (int m = 0; m < 4; ++m) {
                    const int nn = (row0 + ai * 128 + m * 16) & (L - 1);
#pragma unroll
                    for (int bj = 0; bj < 2; ++bj)
#pragma unroll
                        for (int n = 0; n < 2; ++n)
#pragma unroll
                            for (int j = 0; j < 4; ++j)
                                ObT[((size_t)(seq * 1536 + c0 + bj * 128 + 4 * n + j) << 14) + nn] = f2bf(acc[ai][bj][m][n][j]);
                }
        }
    }
};
struct EpiResid {
    static constexpr bool PERM = false;
    const float* xs0; const float* xs1; float* out; const float* gate; float scale;
    __device__ __forceinline__ void operator()(const f32x4 (&acc)[2][2][4][2], const pg8::Unit& u, int wr, int wc, int fr, int fq) const {
        const int row0 = u.pm * 256 + wr * 64 + fr, col0 = u.pn * 256 + wc * 32 + 4 * fq;
        const int seq = (u.pm * 256) >> 14;
        const float* srcb = (seq < 2 ? xs0 + (size_t)row0 * 1024 : xs1 + (size_t)(row0 - 32768) * 1024) + col0;
        float* dstb = out + (size_t)row0 * 1024 + col0;
        const float* gb = gate + seq * 9216 + col0;
#pragma unroll
        for (int bj = 0; bj < 2; ++bj)
#pragma unroll
            for (int n = 0; n < 2; ++n) {
                const f32x4 gv = *(const f32x4*)(gb + bj * 128 + n * 16) * scale;
#pragma unroll
                for (int ai = 0; ai < 2; ++ai) {
#pragma unroll
                    for (int m = 0; m < 4; ++m) {
                        const size_t off = (size_t)(ai * 128 + m * 16) * 1024 + bj * 128 + n * 16;
                        *(f32x4*)(dstb + off) = *(const f32x4*)(srcb + off) + gv * acc[ai][bj][m][n];
                    }
                    asm volatile("" ::: "memory");
                }
            }
    }
};

__device__ void convert_weights(const Args& a, LAS float* tile) {
    const int tid = opaque_tid();
    unsigned char* ws = a.ws;
    for (int ti = blockIdx.x; ti < 9984; ti += gridDim.x) {
        const float* src; bf16_t* dst; int K, N, mode = 0, lt;
        if (ti < 5632) { const int mi = ti / 1408; lt = ti % 1408; src = a.in[7] + (size_t)mi * 1024 * 5632; dst = (bf16_t*)(ws + WS_WIN) + (size_t)mi * 5632 * 1024; K = 1024; N = 5632; mode = 1; }
        else if (ti < 8448) { const int mi = (ti - 5632) / 704; lt = (ti - 5632) % 704; src = a.in[8] + (size_t)mi * 2816 * 1024; dst = (bf16_t*)(ws + WS_WOUT) + (size_t)mi * 1024 * 2816; K = 2816; N = 1024; }
        else if (ti < 9088) { lt = ti - 8448; src = a.in[10]; dst = (bf16_t*)(ws + WS_WABIN); K = 1024; N = 2560; }
        else if (ti < 9344) { lt = ti - 9088; src = a.in[24]; dst = (bf16_t*)(ws + WS_WABOUT); K = 1024; N = 1024; }
        else if (ti < 9728) { lt = ti - 9344; src = a.in[25]; dst = (bf16_t*)(ws + WS_WQKV); K = 1024; N = 1536; }
        else { lt = ti - 9728; src = a.in[27]; dst = (bf16_t*)(ws + WS_WATTO); K = 1024; N = 1024; }
        const int nkt = K / 64;
        const int kt = lt % nkt, ntp = lt / nkt;
        const int k0 = kt * 64, np0 = ntp * 64;
        int n0 = np0;
        if (mode == 1) { const int pn = np0 >> 8, bj = (np0 >> 7) & 1, c0 = np0 & 127; n0 = bj * DFF + 128 * pn + c0; }
        __syncthreads();
#pragma unroll
        for (int i = 0; i < 8; ++i) { const int k = (tid >> 6) + 8 * i, n = tid & 63; tile[k * 65 + n] = src[(size_t)(k0 + k) * N + n0 + n]; }
        __syncthreads();
        const int nn = tid >> 3, kk = (tid & 7) * 8;
        float v[8];
#pragma unroll
        for (int j = 0; j < 8; ++j) v[j] = tile[(kk + j) * 65 + nn];
        u32x4 w; w.x = pk_bf16(v[0], v[1]); w.y = pk_bf16(v[2], v[3]); w.z = pk_bf16(v[4], v[5]); w.w = pk_bf16(v[6], v[7]);
        *(u32x4*)(dst + (size_t)(np0 + nn) * K + k0 + kk) = w;
    }
    __syncthreads();
}

__device__ void ada_phase(const Args& a, LAS float* lf) {
    const int tid = opaque_tid(), lane = tid & 63, w = tid >> 6;
    LAS float* cs = lf; LAS float* red = lf + 3072;
    float* mod = (float*)(a.ws + WS_MOD);
    __syncthreads();
    for (int i = tid; i < 3072; i += 512) { const int s = i >> 10, k = i & 1023; const float c = s < 2 ? a.in[2][s * 1024 + k] : a.in[3][k]; cs[i] = c * fsigmoid(c); }
    __syncthreads();
    for (int item = blockIdx.x; item < 288; item += gridDim.x) {
        const int layer = item / 144, cgp = item % 144, col = cgp * 64 + lane;
        const float* W = a.in[4] + (size_t)layer * 1024 * 9216 + col;
        float a0 = 0.f, a1 = 0.f, a2 = 0.f;
#pragma unroll 8
        for (int k = w * 128; k < w * 128 + 128; ++k) { const float wv = W[(size_t)k * 9216]; a0 += cs[k] * wv; a1 += cs[1024 + k] * wv; a2 += cs[2048 + k] * wv; }
        red[(w * 3 + 0) * 64 + lane] = a0; red[(w * 3 + 1) * 64 + lane] = a1; red[(w * 3 + 2) * 64 + lane] = a2;
        __syncthreads();
        if (tid < 192) { const int s = tid >> 6; float sum = 0.f;
#pragma unroll
            for (int ww = 0; ww < 8; ++ww) sum += red[(ww * 3 + s) * 64 + lane];
            mod[(size_t)(layer * 3 + s) * 9216 + cgp * 64 + lane] = sum + a.in[5][layer * 9216 + cgp * 64 + lane]; }
        __syncthreads();
    }
}

__device__ void filter_phase(const Args& a, LAS float* lf) {
    const int tid = opaque_tid();
    LAS float* feats = lf;
    LAS float* h1 = lf + 64 * 33;
    LAS float* h2T = h1 + 64 * 65;
    const float* w1 = a.in[17]; const float* b1 = a.in[18]; const float* w2 = a.in[19]; const float* b2 = a.in[20]; const float* w3 = a.in[21]; const float* fr = a.in[22];
    half_t* KT = (half_t*)(a.ws + WS_KT);
    for (int item = blockIdx.x; item < 256; item += gridDim.x) {
        const int p0 = item * 64;
        __syncthreads();
        for (int idx = tid; idx < 64 * 33; idx += 512) {
            const int pos = idx / 33, f = idx % 33, n = p0 + pos; float v;
            if (f == 0) v = (float)n / (float)(L - 1);
            else { const int b = (f - 1) & 15; const double band = 1e-4 + (double)b * ((15.0 - 1e-4) / 15.0); double rev = (double)n * band / (double)L; rev -= floor(rev);
                   v = (f <= 16) ? __builtin_amdgcn_cosf((float)rev) : -__builtin_amdgcn_sinf((float)rev); }
            feats[idx] = v;
        }
        __syncthreads();
        { const int pos = tid >> 3, j0 = (tid & 7) * 8; float acc[8];
#pragma unroll
          for (int j = 0; j < 8; ++j) acc[j] = b1[j0 + j];
#pragma unroll 3
          for (int f = 0; f < 33; ++f) { const float x = feats[pos * 33 + f];
#pragma unroll
              for (int j = 0; j < 8; ++j) acc[j] += x * w1[f * 64 + j0 + j]; }
#pragma unroll
          for (int j = 0; j < 8; ++j) h1[pos * 65 + j0 + j] = hw_sin(fr[j0 + j] * acc[j]); }
        __syncthreads();
        { const int pos = tid >> 3, j0 = (tid & 7) * 8; float acc[8];
#pragma unroll
          for (int j = 0; j < 8; ++j) acc[j] = b2[j0 + j];
#pragma unroll 4
          for (int i = 0; i < 64; ++i) { const float x = h1[pos * 65 + i];
#pragma unroll
              for (int j = 0; j < 8; ++j) acc[j] += x * w2[i * 64 + j0 + j]; }
#pragma unroll
          for (int j = 0; j < 8; ++j) h2T[(j0 + j) * 64 + pos] = hw_sin(fr[j0 + j] * acc[j]); }
        __syncthreads();
        const int col0 = tid * 4;
        const int dir = col0 >> 10, ord = (col0 >> 9) & 1, ch0 = col0 & 511;
#pragma unroll 1
        for (int chunk = 0; chunk < 4; ++chunk) {
            float acc[16][4];
#pragma unroll
            for (int p = 0; p < 16; ++p)
#pragma unroll
                for (int c = 0; c < 4; ++c) acc[p][c] = 0.f;
#pragma unroll 2
            for (int j = 0; j < 64; ++j) {
                const f32x4 wv = *(const f32x4*)(w3 + j * 2048 + col0);
                f32x4 hv[4];
#pragma unroll
                for (int q = 0; q < 4; ++q) hv[q] = *(const LAS f32x4*)(h2T + j * 64 + chunk * 16 + q * 4);
#pragma unroll
                for (int p = 0; p < 16; ++p)
#pragma unroll
                    for (int c = 0; c < 4; ++c) acc[p][c] += hv[p >> 2][p & 3] * wv[c];
            }
#pragma unroll
            for (int c = 0; c < 4; ++c) {
                const int ch = ch0 + c;
                const float delta = 3.0701134573253945f + (float)ch * (12.280453829301578f / 511.0f);
                half_t* dstp = KT + ((size_t)((ord * 512 + ch) * 2 + dir) << 14) + p0 + chunk * 16;
                unsigned pk[8];
#pragma unroll
                for (int p = 0; p < 16; p += 2) {
                    const float t0 = (float)(p0 + chunk * 16 + p) / (float)(L - 1), t1 = (float)(p0 + chunk * 16 + p + 1) / (float)(L - 1);
                    const half_t x0 = (half_t)(acc[p][c] * __expf(-t0 * delta)), x1 = (half_t)(acc[p + 1][c] * __expf(-t1 * delta));
                    pk[p >> 1] = (unsigned)__builtin_bit_cast(unsigned short, x0) | ((unsigned)__builtin_bit_cast(unsigned short, x1) << 16);
                }
                *(u32x4*)dstp = (u32x4){pk[0], pk[1], pk[2], pk[3]};
                *(u32x4*)(dstp + 8) = (u32x4){pk[4], pk[5], pk[6], pk[7]};
            }
        }
    }
    __syncthreads();
}

__device__ void norm_phase(const float* xs0, const float* xs1, const float* g, const float* sh, const float* sc, bf16_t* h) {
    const int tid_ = opaque_tid(); const int lane = tid_ & 63, w = tid_ >> 6;
    f32x4 gg[4];
#pragma unroll
    for (int i = 0; i < 4; ++i) gg[i] = *(const f32x4*)(g + i * 256 + lane * 4);
    for (int row = blockIdx.x * 8 + w; row < T; row += gridDim.x * 8) {
        const int seq = row >> 14;
        const float* xr = seq < 2 ? xs0 + (size_t)row * 1024 : xs1 + (size_t)(row - 32768) * 1024;
        f32x4 v[4]; float ss = 0.f;
#pragma unroll
        for (int i = 0; i < 4; ++i) { v[i] = *(const f32x4*)(xr + i * 256 + lane * 4); ss += v[i][0] * v[i][0] + v[i][1] * v[i][1] + v[i][2] * v[i][2] + v[i][3] * v[i][3]; }
#pragma unroll
        for (int o = 32; o > 0; o >>= 1) ss += __shfl_xor(ss, o);
        const float rstd = rsqrtf(ss * (1.0f / 1024.0f) + EPS);
#pragma unroll
        for (int i = 0; i < 4; ++i) {
            const int col = i * 256 + lane * 4;
            const f32x4 s1 = *(const f32x4*)(sc + seq * 9216 + col), s0 = *(const f32x4*)(sh + seq * 9216 + col);
            const f32x4 y = v[i] * rstd * gg[i] * (s1 + 1.0f) + s0;
            u32x2 o; o.x = pk_bf16(y[0], y[1]); o.y = pk_bf16(y[2], y[3]);
            *(u32x2*)(h + (size_t)row * 1024 + col) = o;
        }
    }
}
__device__ void final_norm_phase(float* x, const float* g) {
    const int tid_ = opaque_tid(); const int lane = tid_ & 63, w = tid_ >> 6;
    f32x4 gg[4];
#pragma unroll
    for (int i = 0; i < 4; ++i) gg[i] = *(const f32x4*)(g + i * 256 + lane * 4);
    for (int row = blockIdx.x * 8 + w; row < T; row += gridDim.x * 8) {
        float* xr = x + (size_t)row * 1024;
        f32x4 v[4]; float ss = 0.f;
#pragma unroll
        for (int i = 0; i < 4; ++i) { v[i] = *(const f32x4*)(xr + i * 256 + lane * 4); ss += v[i][0] * v[i][0] + v[i][1] * v[i][1] + v[i][2] * v[i][2] + v[i][3] * v[i][3]; }
#pragma unroll
        for (int o = 32; o > 0; o >>= 1) ss += __shfl_xor(ss, o);
        const float rstd = rsqrtf(ss * (1.0f / 1024.0f) + EPS);
#pragma unroll
        for (int i = 0; i < 4; ++i) *(f32x4*)(xr + i * 256 + lane * 4) = v[i] * rstd * gg[i];
    }
}

__device__ void conva_phase(const Args& a, const bf16_t* pa, bf16_t* cat, LAS unsigned char* lds) {
    const int tid = opaque_tid(), lane = tid & 63, w = tid >> 6;
    LAS bf16_t* glu = (LAS bf16_t*)lds;
    LAS float* stage = (LAS float*)(lds + 94 * 512 * 2);
    const float* cw = a.in[11]; const float* cb = a.in[12]; const float* lg = a.in[13]; const float* lb = a.in[14];
    float wt[31];
#pragma unroll
    for (int j = 0; j < 31; ++j) wt[j] = cw[j * 512 + tid];
    const float bias = cb[tid];
    float lgv[8], lbv[8];
#pragma unroll
    for (int i = 0; i < 8; ++i) { lgv[i] = lg[lane + 64 * i]; lbv[i] = lb[lane + 64 * i]; }
    for (int tile = blockIdx.x; tile < 768; tile += gridDim.x) {
        const int seq = tile >> 8, t0 = (tile & 255) * 64;
        __syncthreads();
        for (int idx = tid; idx < 94 * 64; idx += 512) {
            const int r = idx >> 6, cc = idx & 63, t = t0 - 15 + r;
            u32x4 res = (u32x4){0u, 0u, 0u, 0u};
            if (t >= 0 && t < L) {
                const bf16_t* rp = pa + (size_t)(seq * L + t) * 1024 + cc * 8;
                const u32x4 x1 = *(const u32x4*)rp, x2 = *(const u32x4*)(rp + 512);
#pragma unroll
                for (int q = 0; q < 4; ++q) res[q] = pk_bf16(bf_lo(x1[q]) * fsigmoid(bf_lo(x2[q])), bf_hi(x1[q]) * fsigmoid(bf_hi(x2[q])));
            }
            *(LAS u32x4*)(glu + r * 512 + cc * 8) = res;
        }
        __syncthreads();
        for (int chunk = 0; chunk < 8; ++chunk) {
            float o[8];
#pragma unroll
            for (int tt = 0; tt < 8; ++tt) o[tt] = bias;
#pragma unroll
            for (int i = 0; i < 38; ++i) {
                const float x = bf2f(glu[(chunk * 8 + i) * 512 + tid]);
#pragma unroll
                for (int tt = 0; tt < 8; ++tt) { const int j = i - tt; if (j >= 0 && j < 31) o[tt] += wt[j] * x; }
            }
#pragma unroll
            for (int tt = 0; tt < 8; ++tt) stage[tt * 512 + tid] = o[tt];
            __syncthreads();
            {
                float v[8]; float s = 0.f;
#pragma unroll
                for (int i = 0; i < 8; ++i) { v[i] = stage[w * 512 + lane + 64 * i]; s += v[i]; }
#pragma unroll
                for (int of = 32; of > 0; of >>= 1) s += __shfl_xor(s, of);
                const float mean = s * (1.0f / 512.0f);
                float q = 0.f;
#pragma unroll
                for (int i = 0; i < 8; ++i) { const float d = v[i] - mean; q += d * d; }
#pragma unroll
                for (int of = 32; of > 0; of >>= 1) q += __shfl_xor(q, of);
                const float rstd = rsqrtf(q * (1.0f / 512.0f) + EPS);
                bf16_t* op = cat + (size_t)(seq * L + t0 + chunk * 8 + w) * 1024;
#pragma unroll
                for (int i = 0; i < 8; ++i) { const float y = (v[i] - mean) * rstd * lgv[i] + lbv[i]; op[lane + 64 * i] = f2bf(y * fsigmoid(y)); }
            }
            __syncthreads();
        }
    }
    __syncthreads();
}

typedef float cf2 __attribute__((ext_vector_type(2)));
__device__ __forceinline__ cf2 mk2(float x, float y) { cf2 r; r.x = x; r.y = y; return r; }
__device__ __forceinline__ int fphys(int i) { return i + ((i >> 6) << 2); }
__device__ __forceinline__ cf2 cmul(cf2 a, cf2 b) { return mk2(a.x * b.x - a.y * b.y, a.x * b.y + a.y * b.x); }
template <bool INV> __device__ __forceinline__ void bf4(cf2& a, cf2& b, cf2& c, cf2& d) {
    const cf2 t0 = mk2(a.x + c.x, a.y + c.y), t1 = mk2(a.x - c.x, a.y - c.y), t2 = mk2(b.x + d.x, b.y + d.y);
    const cf2 e = mk2(b.x - d.x, b.y - d.y);
    const cf2 t3 = INV ? mk2(-e.y, e.x) : mk2(e.y, -e.x);
    a = mk2(t0.x + t2.x, t0.y + t2.y); b = mk2(t1.x + t3.x, t1.y + t3.y);
    c = mk2(t0.x - t2.x, t0.y - t2.y); d = mk2(t1.x - t3.x, t1.y - t3.y);
}
template <bool INV, int K16> __device__ __forceinline__ cf2 c16() {
    constexpr float cs[10] = {1.0f, 0.92387953251128674f, 0.70710678118654752f, 0.38268343236508977f, 0.0f, -0.38268343236508977f, -0.70710678118654752f, -0.92387953251128674f, -1.0f, -0.92387953251128674f};
    constexpr float sn[10] = {0.0f, 0.38268343236508977f, 0.70710678118654752f, 0.92387953251128674f, 1.0f, 0.92387953251128674f, 0.70710678118654752f, 0.38268343236508977f, 0.0f, -0.38268343236508977f};
    return mk2(cs[K16], INV ? sn[K16] : -sn[K16]);
}
template <bool INV, int J> __device__ __forceinline__ void tw16(cf2& x1, cf2& x2, cf2& x3) {
    if (J > 0) { x1 = cmul(x1, c16<INV, J>()); x2 = cmul(x2, c16<INV, 2 * J>()); x3 = cmul(x3, c16<INV, 3 * J>()); }
}
template <bool INV, int LOGQ> __device__ __forceinline__ void r16_pass(LAS cf2* F, int tid) {
    constexpr int Q = 1 << LOGQ;
#pragma unroll 1
    for (int bi = 0; bi < 2; ++bi) {
        const int b = tid + 512 * bi, pos = b & (Q - 1), grp = b >> LOGQ, base = (grp << (LOGQ + 4)) + pos;
        cf2 x[16];
        constexpr int PSTR = (Q >= 64) ? (Q + (Q >> 4)) : Q;
        LAS cf2* Fp = F + fphys(base);
#pragma unroll
        for (int r = 0; r < 16; ++r) x[r] = Fp[r * PSTR];
        int posv = pos; asm volatile("" : "+v"(posv));
        const float rev = (float)posv * (1.0f / (float)(16 * Q));
        const float sn = __builtin_amdgcn_sinf(rev), cs = __builtin_amdgcn_cosf(rev);
        const cf2 w1 = mk2(cs, INV ? sn : -sn);
        const cf2 w2 = cmul(w1, w1), w3 = cmul(w2, w1), w4 = cmul(w2, w2), w8 = cmul(w4, w4), w12 = cmul(w8, w4);
        if (!INV) {
#pragma unroll
            for (int j = 0; j < 4; ++j) {
                bf4<false>(x[j], x[j + 4], x[j + 8], x[j + 12]);
                x[j + 4] = cmul(x[j + 4], w1); x[j + 8] = cmul(x[j + 8], w2); x[j + 12] = cmul(x[j + 12], w3);
            }
            tw16<false, 1>(x[5], x[9], x[13]); tw16<false, 2>(x[6], x[10], x[14]); tw16<false, 3>(x[7], x[11], x[15]);
#pragma unroll
            for (int r = 0; r < 4; ++r) {
                bf4<false>(x[4 * r], x[4 * r + 1], x[4 * r + 2], x[4 * r + 3]);
                x[4 * r + 1] = cmul(x[4 * r + 1], w4); x[4 * r + 2] = cmul(x[4 * r + 2], w8); x[4 * r + 3] = cmul(x[4 * r + 3], w12);
            }
        } else {
#pragma unroll
            for (int r = 0; r < 4; ++r) {
                x[4 * r + 1] = cmul(x[4 * r + 1], w4); x[4 * r + 2] = cmul(x[4 * r + 2], w8); x[4 * r + 3] = cmul(x[4 * r + 3], w12);
                bf4<true>(x[4 * r], x[4 * r + 1], x[4 * r + 2], x[4 * r + 3]);
            }
            tw16<true, 1>(x[5], x[9], x[13]); tw16<true, 2>(x[6], x[10], x[14]); tw16<true, 3>(x[7], x[11], x[15]);
#pragma unroll
            for (int j = 0; j < 4; ++j) {
                x[j + 4] = cmul(x[j + 4], w1); x[j + 8] = cmul(x[j + 8], w2); x[j + 12] = cmul(x[j + 12], w3);
                bf4<true>(x[j], x[j + 4], x[j + 8], x[j + 12]);
            }
        }
#pragma unroll
        for (int r = 0; r < 16; ++r) Fp[r * PSTR] = x[r];
    }
}
template <bool INV> __device__ __forceinline__ void r4_pass(LAS cf2* F, int tid) {
#pragma unroll 2
    for (int bi = 0; bi < 8; ++bi) {
        const int b = tid + 512 * bi; const int p = fphys(4 * b);
        f32x4 u0 = *(LAS f32x4*)(F + p), u1 = *(LAS f32x4*)(F + p + 2);
        cf2 x0 = mk2(u0[0], u0[1]), x1 = mk2(u0[2], u0[3]), x2 = mk2(u1[0], u1[1]), x3 = mk2(u1[2], u1[3]);
        bf4<INV>(x0, x1, x2, x3);
        *(LAS f32x4*)(F + p) = (f32x4){x0.x, x0.y, x1.x, x1.y}; *(LAS f32x4*)(F + p + 2) = (f32x4){x2.x, x2.y, x3.x, x3.y};
    }
}
__device__ __forceinline__ void fft_fwd(LAS cf2* F, int tid) {
    r16_pass<false, 10>(F, tid); __syncthreads(); r16_pass<false, 6>(F, tid); __syncthreads(); r16_pass<false, 2>(F, tid); __syncthreads(); r4_pass<false>(F, tid);
}
__device__ __forceinline__ void fft_inv(LAS cf2* F, int tid) {
    r4_pass<true>(F, tid); __syncthreads(); r16_pass<true, 2>(F, tid); __syncthreads(); r16_pass<true, 6>(F, tid); __syncthreads(); r16_pass<true, 10>(F, tid);
}
typedef _Float16 h8v __attribute__((ext_vector_type(8)));
__device__ __forceinline__ void sconv8(const bf16_t* row, int n0, float w0, float w1, float w2, float b, float (&out)[8]) {
    const u32x4 q = *(const u32x4*)(row + n0);
    float x[10];
    x[0] = n0 > 0 ? bf2f(row[n0 - 1]) : 0.f;
    x[9] = n0 + 8 < L ? bf2f(row[n0 + 8]) : 0.f;
#pragma unroll
    for (int i = 0; i < 4; ++i) { x[1 + 2 * i] = bf_lo(q[i]); x[2 + 2 * i] = bf_hi(q[i]); }
#pragma unroll
    for (int e = 0; e < 8; ++e) out[e] = b + w0 * x[e] + w1 * x[e + 1] + w2 * x[e + 2];
}
template <bool DRY> __device__ void fft_phase(const Args& a, bf16_t* pbT, LAS unsigned char* lds) {
    const int tid = opaque_tid(), lane = tid & 63, w = tid >> 6;
    LAS cf2* F = (LAS cf2*)lds;
    LAS float* red = (LAS float*)(lds + 17408 * 8);
    LAS cf2* Fo = F + fphys(8 * tid);
    const half_t* KT = (const half_t*)(a.ws + WS_KT);
    unsigned char* scr = a.ws + WS_ACT + PBT_BYTES + (size_t)blockIdx.x * FFTSCR_PER_BLOCK;
    cf2* ybuf = (cf2*)scr;
    float* z1buf = (float*)(scr + 2ull * L * 8);
    const float* sw = a.in[15]; const float* sb = a.in[16]; const float* skip = a.in[23];
    const cf2 tstep = mk2(0.99999998161642933f, -1.9174759731070330e-4f);
    for (int ch = blockIdx.x; ch < 512; ch += gridDim.x) {
        const float vw0 = sw[ch], vw1 = sw[1536 + ch], vw2 = sw[3072 + ch], vb = sb[ch];
#pragma unroll 1
        for (int o = 0; o < 2; ++o) {
            const half_t* kf = KT + ((size_t)((o * 512 + ch) * 2) << 14); const half_t* kb = kf + L;
            const int xc = (o == 0 ? 512 : 1024) + ch;
            const float gw0 = sw[xc], gw1 = sw[1536 + xc], gw2 = sw[3072 + xc], gb = sb[xc];
            const float skp = skip[o * 512 + ch];
            float ss = 0.f;
#pragma unroll 1
            for (int g = 0; g < 4; ++g) {
                const int n0 = 8 * (tid + 512 * g);
                const h8v f = *(const h8v*)(kf + n0), bk = *(const h8v*)(kb + n0);
#pragma unroll
                for (int e = 0; e < 8; ++e) { const float ff = (float)f[e], bb = (n0 + e > 0) ? (float)bk[e] : 0.f; ss += ff * ff + bb * bb; }
            }
#pragma unroll
            for (int of = 32; of > 0; of >>= 1) ss += __shfl_xor(ss, of);
            __syncthreads();
            if (lane == 0) red[w] = ss;
            __syncthreads();
            float tot = 0.f;
#pragma unroll
            for (int ww = 0; ww < 8; ++ww) tot += red[ww];
            const float kscale = rsqrtf(tot + EPS) * (0.5f / (float)L);
#pragma unroll 1
            for (int br = 0; br < 2; ++br) {
                __syncthreads();
#pragma unroll 1
                for (int g = 0; g < 4; ++g) {
                    const int n0 = 8 * (tid + 512 * g);
                    const h8v f = *(const h8v*)(kf + n0), bc = *(const h8v*)(kb + (L - 8 - n0));
                    const float b0 = n0 > 0 ? (float)kb[L - n0] : 0.f;
                    float d[8];
#pragma unroll
                    for (int e = 0; e < 8; ++e) { const float bk = (e == 0) ? b0 : (float)bc[8 - e]; d[e] = (br == 0 ? (float)f[e] + bk : (float)f[e] - bk) * kscale; }
                    cf2 tw = mk2(1.f, 0.f);
                    if (br == 1) { const float rev = (float)n0 * (1.0f / (float)(2 * L)); tw = mk2(__builtin_amdgcn_cosf(rev), -__builtin_amdgcn_sinf(rev)); }
#pragma unroll
                    for (int e = 0; e < 8; e += 2) {
                        const cf2 t1 = cmul(tw, tstep);
                        const cf2 v0 = (br == 0) ? mk2(d[e], 0.f) : mk2(d[e] * tw.x, d[e] * tw.y);
                        const cf2 v1 = (br == 0) ? mk2(d[e + 1], 0.f) : mk2(d[e + 1] * t1.x, d[e + 1] * t1.y);
                        *(LAS f32x4*)(Fo + 4352 * g + e) = (f32x4){v0.x, v0.y, v1.x, v1.y};
                        tw = cmul(t1, tstep);
                    }
                }
                __syncthreads();
                fft_fwd(F, tid);
                __syncthreads();
                cf2 Kr[32];
#pragma unroll
                for (int g = 0; g < 4; ++g)
#pragma unroll
                    for (int e = 0; e < 8; e += 2) { const f32x4 t = *(const LAS f32x4*)(Fo + 4352 * g + e); Kr[g * 8 + e] = mk2(t[0], t[1]); Kr[g * 8 + e + 1] = mk2(t[2], t[3]); }
#pragma unroll 1
                for (int pk = 0; pk < 2; ++pk) {
                    __syncthreads();
#pragma unroll 1
                    for (int g = 0; g < 4; ++g) {
                        const int n0 = 8 * (tid + 512 * g);
                        float re[8], im[8];
                        if (o == 0) {
                            sconv8(pbT + ((size_t)((2 * pk) * 1536 + ch) << 14), n0, vw0, vw1, vw2, vb, re);
                            if (pk == 0) sconv8(pbT + ((size_t)(1536 + ch) << 14), n0, vw0, vw1, vw2, vb, im);
                        } else {
                            const f32x4 r0 = *(const f32x4*)(z1buf + (2 * pk) * L + n0), r1 = *(const f32x4*)(z1buf + (2 * pk) * L + n0 + 4);
#pragma unroll
                            for (int e = 0; e < 4; ++e) { re[e] = r0[e]; re[4 + e] = r1[e]; }
                            if (pk == 0) { const f32x4 i0 = *(const f32x4*)(z1buf + L + n0), i1 = *(const f32x4*)(z1buf + L + n0 + 4);
#pragma unroll
                                for (int e = 0; e < 4; ++e) { im[e] = i0[e]; im[4 + e] = i1[e]; } }
                        }
                        if (pk == 1) {
#pragma unroll
                            for (int e = 0; e < 8; ++e) im[e] = 0.f;
                        }
                        cf2 tw = mk2(1.f, 0.f);
                        if (br == 1) { const float rev = (float)n0 * (1.0f / (float)(2 * L)); tw = mk2(__builtin_amdgcn_cosf(rev), -__builtin_amdgcn_sinf(rev)); }
#pragma unroll
                        for (int e = 0; e < 8; e += 2) {
                            const cf2 t1 = cmul(tw, tstep);
                            cf2 v0 = mk2(re[e], im[e]), v1 = mk2(re[e + 1], im[e + 1]);
                            if (br == 1) { v0 = cmul(v0, tw); v1 = cmul(v1, t1); }
                            *(LAS f32x4*)(Fo + 4352 * g + e) = (f32x4){v0.x, v0.y, v1.x, v1.y};
                            tw = cmul(t1, tstep);
                        }
                    }
                    __syncthreads();
                    fft_fwd(F, tid);
                    __syncthreads();
#pragma unroll
                    for (int g = 0; g < 4; ++g)
#pragma unroll
                        for (int e = 0; e < 8; e += 2) {
                            const f32x4 t = *(const LAS f32x4*)(Fo + 4352 * g + e);
                            const cf2 p0 = cmul(mk2(t[0], t[1]), Kr[g * 8 + e]), p1 = cmul(mk2(t[2], t[3]), Kr[g * 8 + e + 1]);
                            *(LAS f32x4*)(Fo + 4352 * g + e) = (f32x4){p0.x, p0.y, p1.x, p1.y};
                        }
                    __syncthreads();
                    fft_inv(F, tid);
                    __syncthreads();
#pragma unroll 1
                    for (int g = 0; g < 4; ++g) {
                        const int n0 = 8 * (tid + 512 * g);
                        cf2 r[8];
#pragma unroll
                        for (int e = 0; e < 8; e += 2) { const f32x4 t = *(const LAS f32x4*)(Fo + 4352 * g + e); r[e] = mk2(t[0], t[1]); r[e + 1] = mk2(t[2], t[3]); }
                        cf2* yb = ybuf + pk * L + n0;
                        if (br == 0) {
#pragma unroll
                            for (int e = 0; e < 8; e += 2) *(f32x4*)(yb + e) = (f32x4){r[e].x, r[e].y, r[e + 1].x, r[e + 1].y};
                        } else {
                            const float rev = (float)n0 * (1.0f / (float)(2 * L));
                            cf2 tw = mk2(__builtin_amdgcn_cosf(rev), __builtin_amdgcn_sinf(rev));
                            const cf2 tstc = mk2(tstep.x, -tstep.y);
                            float yre[8], yim[8];
#pragma unroll
                            for (int e = 0; e < 8; e += 2) {
                                const f32x4 y0 = *(const f32x4*)(yb + e);
                                const cf2 t1 = cmul(tw, tstc);
                                const cf2 a0 = cmul(r[e], tw), a1 = cmul(r[e + 1], t1);
                                yre[e] = y0[0] + a0.x; yim[e] = y0[1] + a0.y; yre[e + 1] = y0[2] + a1.x; yim[e + 1] = y0[3] + a1.y;
                                tw = cmul(t1, tstc);
                            }
                            const int nseq = (pk == 0) ? 2 : 1;
#pragma unroll 1
                            for (int q = 0; q < nseq; ++q) {
                                const int s = 2 * pk + q;
                                float gate[8];
                                sconv8(pbT + ((size_t)(s * 1536 + xc) << 14), n0, gw0, gw1, gw2, gb, gate);
                                float* zp = z1buf + s * L + n0;
                                if (o == 0) {
                                    float vv[8];
                                    sconv8(pbT + ((size_t)(s * 1536 + ch) << 14), n0, vw0, vw1, vw2, vb, vv);
                                    float z[8];
#pragma unroll
                                    for (int e = 0; e < 8; ++e) z[e] = gate[e] * ((q == 0 ? yre[e] : yim[e]) + vv[e] * skp);
                                    *(f32x4*)zp = (f32x4){z[0], z[1], z[2], z[3]}; *(f32x4*)(zp + 4) = (f32x4){z[4], z[5], z[6], z[7]};
                                } else {
                                    const f32x4 z0 = *(const f32x4*)zp, z1 = *(const f32x4*)(zp + 4);
                                    float z[8];
#pragma unroll
                                    for (int e = 0; e < 8; ++e) z[e] = gate[e] * ((q == 0 ? yre[e] : yim[e]) + (e < 4 ? z0[e & 3] : z1[e & 3]) * skp);
                                    u32x4 wv; wv.x = pk_bf16(z[0], z[1]); wv.y = pk_bf16(z[2], z[3]); wv.z = pk_bf16(z[4], z[5]); wv.w = pk_bf16(z[6], z[7]);
                                    if (!DRY) *(u32x4*)(pbT + ((size_t)(s * 1536 + ch) << 14) + n0) = wv;
                                }
                            }
                        }
                    }
                }
            }
            __syncthreads();
        }
    }
    __syncthreads();
}

__device__ void ztrans_phase(const bf16_t* pbT, bf16_t* cat, LAS unsigned char* lds) {
    const int tid = opaque_tid();
    LAS unsigned* tl = (LAS unsigned*)lds;
    LAS bf16_t* tb = (LAS bf16_t*)lds;
    for (int tile = blockIdx.x; tile < 6144; tile += gridDim.x) {
        const int tt0 = (tile & 255) * 64, ct = (tile >> 8) & 7, s = tile >> 11;
        __syncthreads();
        { const int cc = tid >> 3, tk = (tid & 7) * 8;
          const u32x4 v = *(const u32x4*)(pbT + ((size_t)(s * 1536 + ct * 64 + cc) << 14) + tt0 + tk);
#pragma unroll
          for (int q = 0; q < 4; ++q) tl[cc * 33 + (tk >> 1) + q] = v[q]; }
        __syncthreads();
        { const int tt = tid >> 3, cg8 = (tid & 7) * 8; bf16_t e[8];
#pragma unroll
          for (int i = 0; i < 8; ++i) e[i] = tb[(cg8 + i) * 66 + tt];
          u32x4 wv; wv.x = e[0] | ((unsigned)e[1] << 16); wv.y = e[2] | ((unsigned)e[3] << 16); wv.z = e[4] | ((unsigned)e[5] << 16); wv.w = e[6] | ((unsigned)e[7] << 16);
          *(u32x4*)(cat + (size_t)(s * L + tt0 + tt) * 1024 + 512 + ct * 64 + cg8) = wv; }
    }
    __syncthreads();
}

__device__ void attn_phase(const Args& a, const bf16_t* qkv, bf16_t* ao, LAS unsigned char* lds) {
    const int tid = opaque_tid(), lane = tid & 63, w = tid >> 6, l31 = lane & 31, hh = lane >> 5;
    LAS bf16_t* Ks = (LAS bf16_t*)lds;
    LAS bf16_t* VT = (LAS bf16_t*)(lds + 384 * 72 * 2);
    const float* sink = a.in[26];
    for (int item = blockIdx.x; item < 1536; item += gridDim.x) {
        const int kvh = item & 3, qb = (item >> 2) & 127, seq = item >> 9;
        const int kb0 = qb * 128 - 128;
        __syncthreads();
        for (int idx = tid; idx < 384 * 8; idx += 512) {
            const int key = idx % 384, dc = idx / 384, kpos = kb0 + key;
            u32x4 kv = (u32x4){0u, 0u, 0u, 0u}, vv = (u32x4){0u, 0u, 0u, 0u};
            if (kpos >= 0 && kpos < L) { const bf16_t* rp = qkv + (size_t)(seq * L + kpos) * 1536 + kvh * 64 + dc * 8; kv = *(const u32x4*)(rp + 1024); vv = *(const u32x4*)(rp + 1280); }
            *(LAS u32x4*)(Ks + key * 72 + dc * 8) = kv;
#pragma unroll
            for (int i = 0; i < 8; ++i) VT[(dc * 8 + i) * 392 + key] = (bf16_t)((vv[i >> 1] >> (16 * (i & 1))) & 0xffffu);
        }
        __syncthreads();
        for (int uu = 0; uu < 2; ++uu) {
            const int u = w + 8 * uu, g = u >> 2, qs = u & 3, h = kvh * 4 + g, q0 = qb * 128 + 32 * qs;
            bf16x8 qf[4];
            const bf16_t* qp = qkv + (size_t)(seq * L + q0 + l31) * 1536 + h * 64 + 8 * hh;
#pragma unroll
            for (int ks = 0; ks < 4; ++ks) qf[ks] = *(const bf16x8*)(qp + 16 * ks);
            const float slope = exp2f(-0.5f * (float)(h + 1));
            float m = sink[h], lsum = 1.0f;
            f32x16 O0, O1;
#pragma unroll
            for (int r = 0; r < 16; ++r) { O0[r] = 0.f; O1[r] = 0.f; }
#pragma unroll 1
            for (int kt = 0; kt < 9; ++kt) {
                const int kl0 = 32 * qs + 32 * kt;
                f32x16 S;
#pragma unroll
                for (int r = 0; r < 16; ++r) S[r] = 0.f;
#pragma unroll
                for (int ks = 0; ks < 4; ++ks) { const bf16x8 af = *(const LAS bf16x8*)(Ks + (kl0 + l31) * 72 + 16 * ks + 8 * hh); S = __builtin_amdgcn_mfma_f32_32x32x16_bf16(af, qf[ks], S, 0, 0, 0); }
                float p[16]; float mt = -1e30f;
#pragma unroll
                for (int r = 0; r < 16; ++r) {
                    const int i = 8 * (r >> 2) + 4 * hh + (r & 3);
                    const int dist = 32 * kt + i - l31 - 128, kpos = q0 - 128 + 32 * kt + i;
                    const int ad = dist < 0 ? -dist : dist;
                    const bool valid = (ad <= 128) && (kpos >= 0) && (kpos < L);
                    p[r] = valid ? (S[r] * 0.125f - slope * (float)ad) : -1e30f;
                    mt = fmaxf(mt, p[r]);
                }
                mt = fmaxf(mt, __shfl_xor(mt, 32));
                const float mnew = fmaxf(m, mt), alpha = __expf(m - mnew);
                float rs = 0.f;
#pragma unroll
                for (int r = 0; r < 16; ++r) { p[r] = __expf(p[r] - mnew); rs += p[r]; }
                rs += __shfl_xor(rs, 32);
                lsum = lsum * alpha + rs; m = mnew;
#pragma unroll
                for (int r = 0; r < 16; ++r) { O0[r] *= alpha; O1[r] *= alpha; }
#pragma unroll
                for (int kk = 0; kk < 2; ++kk) {
                    u32x4 pw; pw.x = pk_bf16(p[8 * kk], p[8 * kk + 1]); pw.y = pk_bf16(p[8 * kk + 2], p[8 * kk + 3]); pw.z = pk_bf16(p[8 * kk + 4], p[8 * kk + 5]); pw.w = pk_bf16(p[8 * kk + 6], p[8 * kk + 7]);
                    const bf16x8 pf = __builtin_bit_cast(bf16x8, pw);
#pragma unroll
                    for (int dt = 0; dt < 2; ++dt) {
                        const LAS bf16_t* vp = VT + (32 * dt + l31) * 392 + kl0 + 16 * kk + 4 * hh;
                        const u32x2 lo = *(const LAS u32x2*)vp, hi = *(const LAS u32x2*)(vp + 8);
                        const bf16x8 vf = __builtin_bit_cast(bf16x8, (u32x4){lo.x, lo.y, hi.x, hi.y});
                        if (dt == 0) O0 = __builtin_amdgcn_mfma_f32_32x32x16_bf16(vf, pf, O0, 0, 0, 0);
                        else O1 = __builtin_amdgcn_mfma_f32_32x32x16_bf16(vf, pf, O1, 0, 0, 0);
                    }
                }
            }
            const float inv = 1.0f / lsum;
            bf16_t* op = ao + (size_t)(seq * L + q0 + l31) * 1024 + h * 64 + 4 * hh;
#pragma unroll
            for (int b = 0; b < 4; ++b) {
                u32x2 o0; o0.x = pk_bf16(O0[4 * b] * inv, O0[4 * b + 1] * inv); o0.y = pk_bf16(O0[4 * b + 2] * inv, O0[4 * b + 3] * inv);
                u32x2 o1; o1.x = pk_bf16(O1[4 * b] * inv, O1[4 * b + 1] * inv); o1.y = pk_bf16(O1[4 * b + 2] * inv, O1[4 * b + 3] * inv);
                *(u32x2*)(op + 8 * b) = o0; *(u32x2*)(op + 32 + 8 * b) = o1;
            }
        }
    }
    __syncthreads();
}

__global__ void __launch_bounds__(512, 2) mega(Args a) {
    extern __shared__ __attribute__((aligned(16))) unsigned char lds_raw[];
    LAS unsigned char* lds = (LAS unsigned char*)lds_raw;
    unsigned char* ws = a.ws;
    const int lo = a.ph_lo, hi = a.ph_hi;
    float* X = a.out;
    const float* mod = (const float*)(ws + WS_MOD);
    bf16_t* H = (bf16_t*)(ws + WS_H);
    bf16_t* ACT = (bf16_t*)(ws + WS_ACT);
    bf16_t* PBT = ACT;
    bf16_t* PA = (bf16_t*)(ws + WS_ACT + PBT_BYTES);
    const int G = gridDim.x, bx = blockIdx.x;
    volatile LAS unsigned* bst = (volatile LAS unsigned*)(lds + LDS_BYTES - 16);
    if (threadIdx.x < 4) bst[threadIdx.x] = 0u;
    __syncthreads();
    const XcdBarrier xbar = xcd_barrier_post((unsigned*)(ws + WS_BAR), bst);
#define GSYNC() xcd_barrier(xbar)
#define IN(k) (lo <= (k) && (k) < hi)
#define SEAM(k) do { if (IN(k) && IN((k) + 1)) { GSYNC(); if ((RM >> 15) & 1) GSYNC(); } } while (0)
    int ph = 0;
    if (IN(0)) REP(0) { if (EN(0)) convert_weights(a, (LAS float*)lds); if (EN(1)) ada_phase(a, (LAS float*)lds); if (EN(2)) filter_phase(a, (LAS float*)lds); }
    if (IN(0) && IN(1)) cg::this_grid().sync();
    ph = 1;
#pragma unroll 1
    for (int layer = 0; layer < 2; ++layer) {
        const float* ml = mod + (size_t)layer * 3 * 9216;
        const float* ng = a.in[6] + layer * 3 * 1024;
#pragma unroll 1
        for (int sub = 0; sub < 3; ++sub) {
            const bool first = (layer == 0 && sub == 0);
            const float* xs0 = first ? a.in[0] : X; const float* xs1 = first ? a.in[1] : X + (size_t)32768 * 1024;
            const float* shp = ml + (3 * sub) * 1024; const float* scp = shp + 1024; const float* gp = shp + 2048;
            if (EN(3) && IN(ph)) REP(3) norm_phase(xs0, xs1, ng + sub * 1024, shp, scp, H);
            SEAM(ph); ++ph;
            if (sub != 1) {
                const int fi = layer * 2 + (sub == 2 ? 1 : 0);
                if (EN(4) && IN(ph)) REP(4) { pg8::Gemm g{H, (const bf16_t*)(ws + WS_WIN) + (size_t)fi * 5632 * 1024, T, 5632, 1024}; pg8::StaticOrder S; S.init(T, 5632, G, bx);
                    EpiSwiglu E{ACT}; pg8::gemm_phase<EpiSwiglu>(lds, g, S, E); }
                SEAM(ph); ++ph;
                if (EN(5) && IN(ph)) { pg8::Gemm g{ACT, (const bf16_t*)(ws + WS_WOUT) + (size_t)fi * 1024 * 2816, T, 1024, DFF}; pg8::StaticOrder S; S.init(T, 1024, G, bx);
                    EpiResid E{xs0, xs1, X, gp, 0.5f}; pg8::gemm_phase<EpiResid>(lds, g, S, E); }
                SEAM(ph); ++ph;
            } else if (layer == 0) {
                if (EN(6) && IN(ph)) REP(6) { pg8::Gemm g{H, (const bf16_t*)(ws + WS_WABIN), T, 2560, 1024}; pg8::StaticOrder S; S.init(T, 2560, G, bx);
                    EpiProj E{PA, PBT}; pg8::gemm_phase<EpiProj>(lds, g, S, E); }
                SEAM(ph); ++ph;
                if (IN(ph)) { if (EN(7)) REP(7) conva_phase(a, PA, H, lds); GSYNC(); if ((RM >> 8) & 1) fft_phase<true>(a, PBT, lds); if (EN(8)) fft_phase<false>(a, PBT, lds); }
                SEAM(ph); ++ph;
                if (EN(9) && IN(ph)) REP(9) ztrans_phase(PBT, H, lds);
                SEAM(ph); ++ph;
                if (EN(5) && IN(ph)) { pg8::Gemm g{H, (const bf16_t*)(ws + WS_WABOUT), T, 1024, 1024}; pg8::StaticOrder S; S.init(T, 1024, G, bx);
                    EpiResid E{xs0, xs1, X, gp, 1.0f}; pg8::gemm_phase<EpiResid>(lds, g, S, E); }
                SEAM(ph); ++ph;
            } else {
                if (EN(10) && IN(ph)) REP(10) { pg8::Gemm g{H, (const bf16_t*)(ws + WS_WQKV), T, 1536, 1024}; pg8::StaticOrder S; S.init(T, 1536, G, bx);
                    EpiBf16 E{ACT, 1536}; pg8::gemm_phase<EpiBf16>(lds, g, S, E); }
                SEAM(ph); ++ph;
                if (EN(11) && IN(ph)) REP(11) attn_phase(a, ACT, H, lds);
                SEAM(ph); ++ph;
                if (EN(5) && IN(ph)) { pg8::Gemm g{H, (const bf16_t*)(ws + WS_WATTO), T, 1024, 1024}; pg8::StaticOrder S; S.init(T, 1024, G, bx);
                    EpiResid E{xs0, xs1, X, gp, 1.0f}; pg8::gemm_phase<EpiResid>(lds, g, S, E); }
                SEAM(ph); ++ph;
            }
        }
    }
    if (EN(12) && IN(ph)) final_norm_phase(X, a.in[9]);
#undef IN
#undef SEAM
}

extern "C" void kernel_launch(void* const* d_in, const int* in_sizes, int n_in, void* d_out, int out_size, void* d_ws, size_t ws_size, hipStream_t stream) {
    static int grid = 0;
    if (grid == 0) {
        int dev = 0, cus = 0, per_cu = 0;
        (void)hipGetDevice(&dev);
        (void)hipDeviceGetAttribute(&cus, hipDeviceAttributeMultiprocessorCount, dev);
        (void)hipFuncSetAttribute((const void*)mega, hipFuncAttributeMaxDynamicSharedMemorySize, LDS_BYTES);
        (void)hipOccupancyMaxActiveBlocksPerMultiprocessor(&per_cu, (const void*)mega, 512, LDS_BYTES);
        if (per_cu < 1) per_cu = 1;
        grid = cus * per_cu;
        if (grid > 256) grid = 256;
        if (ws_size < WS_END) { fprintf(stderr, "workspace too small: %zu < %zu\n", ws_size, (size_t)WS_END); grid = -1; }
    }
    if (grid < 0) return;
    Args a{};
    for (int i = 0; i < 28; ++i) a.in[i] = (const float*)d_in[i];
    a.out = (float*)d_out; a.ws = (unsigned char*)d_ws;
    (void)hipMemsetAsync((unsigned char*)d_ws + WS_BAR, 0, XCD_BAR_WORDS * 4, stream);
#if N_LAUNCH_MODE == 1
    a.ph_lo = 0; a.ph_hi = NPH;
    void* args[] = {&a};
    hipError_t e = hipLaunchCooperativeKernel((const void*)mega, dim3(grid), dim3(512), args, LDS_BYTES, stream);
    if (e != hipSuccess) fprintf(stderr, "cooperative launch failed: %s (grid %d)\n", hipGetErrorString(e), grid);
#else
    for (int p = 0; p < NPH; ++p) { a.ph_lo = p; a.ph_hi = p + 1; hipLaunchKernelGGL(mega, dim3(grid), dim3(512), LDS_BYTES, stream, a); }
#endif
}
```

```cpp
#include <hip/hip_runtime.h>
#include <hip/hip_cooperative_groups.h>
#include <cstdio>
namespace cg = cooperative_groups;

#ifndef PM
#define PM 0xffff
#endif
#define EN(b) ((PM >> (b)) & 1)
#ifndef RM
#define RM 0
#endif
#define REP(b) for (int rep_ = 0; rep_ < 1 + ((RM >> (b)) & 1); ++rep_)
#ifndef N_LAUNCH_MODE
#define N_LAUNCH_MODE 1
#endif

#define LAS __attribute__((address_space(3)))
typedef unsigned short bf16_t;
typedef short bf16x8 __attribute__((ext_vector_type(8)));
typedef float f32x4 __attribute__((ext_vector_type(4)));
typedef float f32x16 __attribute__((ext_vector_type(16)));
typedef unsigned u32x4 __attribute__((ext_vector_type(4)));
typedef unsigned u32x2 __attribute__((ext_vector_type(2)));
typedef __bf16 bf16x2v __attribute__((ext_vector_type(2)));
typedef float f32x2v __attribute__((ext_vector_type(2)));
typedef _Float16 half_t;

constexpr int T = 49152, D = 1024, L = 16384, DFF = 2816, NPH = 23;
constexpr float EPS = 1e-6f;
constexpr int LDS_BYTES = 147456;

constexpr size_t WS_WIN = 0;
constexpr size_t WS_WOUT = WS_WIN + 4ull * 5632 * 1024 * 2;
constexpr size_t WS_WABIN = WS_WOUT + 4ull * 1024 * 2816 * 2;
constexpr size_t WS_WABOUT = WS_WABIN + 2560ull * 1024 * 2;
constexpr size_t WS_WQKV = WS_WABOUT + 1024ull * 1024 * 2;
constexpr size_t WS_WATTO = WS_WQKV + 1536ull * 1024 * 2;
constexpr size_t WS_MOD = WS_WATTO + 1024ull * 1024 * 2;
constexpr size_t WS_BAR = WS_MOD + 221184;
constexpr size_t WS_H = WS_MOD + 262144;
constexpr size_t WS_ACT = WS_H + (size_t)T * 1024 * 2;
constexpr size_t WS_KT = WS_ACT + (size_t)T * DFF * 2;
constexpr size_t WS_END = WS_KT + 2ull * 512 * 2 * L * 2;
constexpr size_t PBT_BYTES = 3ull * 1536 * L * 2;
constexpr size_t FFTSCR_PER_BLOCK = 2ull * L * 8 + 3ull * L * 4;

__device__ __forceinline__ unsigned pk_bf16(float a, float b) { f32x2v f = {a, b}; bf16x2v r = __builtin_convertvector(f, bf16x2v); return __builtin_bit_cast(unsigned, r); }
__device__ __forceinline__ float bf_lo(unsigned v) { return __uint_as_float(v << 16); }
__device__ __forceinline__ float bf_hi(unsigned v) { return __uint_as_float(v & 0xffff0000u); }
__device__ __forceinline__ float bf2f(bf16_t v) { return __uint_as_float((unsigned)v << 16); }
__device__ __forceinline__ bf16_t f2bf(float f) { return (bf16_t)(pk_bf16(f, 0.f) & 0xffffu); }
__device__ __forceinline__ float fsigmoid(float x) { return __builtin_amdgcn_rcpf(1.0f + __expf(-x)); }
__device__ __forceinline__ float hw_sin(float x) { return __builtin_amdgcn_sinf(x * 0.15915494309189535f); }

__device__ __forceinline__ int opaque_tid() { int t = threadIdx.x; asm volatile("" : "+v"(t)); return t; }

#define XB_TMO      128
#define XB_XCNT(j)  (256  + 64 * (j))
#define XB_XSUB(j)  (1280 + 64 * (j))
#define XB_XGEN(j)  (2304 + 64 * (j))
#define XB_TOP      3328
#define XB_TOPGEN   3392
#define XCD_BAR_WORDS 3456
#define XB_SPIN_CAP (1u << 22)
__device__ __forceinline__ unsigned xb_ld(unsigned* p)              { return __hip_atomic_load(p, __ATOMIC_RELAXED, __HIP_MEMORY_SCOPE_AGENT); }
__device__ __forceinline__ unsigned xb_add(unsigned* p, unsigned v) { return __hip_atomic_fetch_add(p, v, __ATOMIC_RELAXED, __HIP_MEMORY_SCOPE_AGENT); }
__device__ __forceinline__ unsigned xb_xcc_id() { return (unsigned)__builtin_amdgcn_s_getreg((3 << 11) | 20) & 0xFu; }
#define XB_SPIN(cond, bar) do { unsigned _sp = 0; while (cond) { __builtin_amdgcn_s_sleep(1); \
    if ((++_sp & 255u) == 0u) { if (xb_ld(&(bar)[XB_TMO])) break; if (_sp > XB_SPIN_CAP) { atomicAdd(&(bar)[XB_TMO], 1u); break; } } } } while (0)
struct XcdBarrier { unsigned* bar; unsigned x; volatile LAS unsigned* st; };
__device__ __forceinline__ XcdBarrier xcd_barrier_post(unsigned* bar, volatile LAS unsigned* st) {
    XcdBarrier b; b.bar = bar; b.x = xb_xcc_id(); b.st = st;
    if (threadIdx.x == 0) (void)xb_add(&bar[XB_XCNT(b.x)], 1u);
    return b;
}
__device__ __forceinline__ void xcd_barrier_complete(unsigned* bar, unsigned x, unsigned& nloc, unsigned& nx) {
    const unsigned G = gridDim.x * gridDim.y * gridDim.z;
    unsigned sum, cnt, mine, sp = 0u;
    for (;;) {
        sum = 0u; cnt = 0u; mine = 0u;
#pragma unroll
        for (unsigned j = 0; j < 16; ++j) { const unsigned c = xb_ld(&bar[XB_XCNT(j)]); sum += c; cnt += (c > 0u) ? 1u : 0u; mine = (j == x) ? c : mine; }
        if (sum == G) break;
        __builtin_amdgcn_s_sleep(1);
        if ((++sp & 255u) == 0u) { if (xb_ld(&bar[XB_TMO])) break; if (sp > XB_SPIN_CAP) { atomicAdd(&bar[XB_TMO], 1u); break; } }
    }
    nloc = mine > 0u ? mine : 1u; nx = cnt > 0u ? cnt : 1u;
}
__device__ __forceinline__ void xcd_barrier(const XcdBarrier& b) {
    asm volatile("s_waitcnt vmcnt(0)" ::: "memory");
    __syncthreads();
    if (threadIdx.x == 0) {
        unsigned* bar = b.bar;
        __builtin_amdgcn_s_waitcnt(0);
        unsigned nloc = b.st[0], nx = b.st[1];
        if (nloc == 0u) { xcd_barrier_complete(bar, b.x, nloc, nx); b.st[0] = nloc; b.st[1] = nx; }
        const unsigned old = xb_add(&bar[XB_XSUB(b.x)], 1u);
        const unsigned gen = old / nloc;
        if (old + 1u == (gen + 1u) * nloc) {
            __builtin_amdgcn_fence(__ATOMIC_RELEASE, "agent");
            asm volatile("s_waitcnt vmcnt(0)" ::: "memory");
            const unsigned og = xb_add(&bar[XB_TOP], 1u);
            const unsigned tg = og / nx;
            if (og + 1u == (tg + 1u) * nx) xb_add(&bar[XB_TOPGEN], 1u);
            else XB_SPIN(xb_ld(&bar[XB_TOPGEN]) == tg, bar);
            __builtin_amdgcn_fence(__ATOMIC_ACQUIRE, "agent");
            xb_add(&bar[XB_XGEN(b.x)], 1u);
            asm volatile("s_waitcnt vmcnt(0)" ::: "memory");
        } else {
            XB_SPIN(xb_ld(&bar[XB_XGEN(b.x)]) == gen, bar);
            __builtin_amdgcn_fence(__ATOMIC_ACQUIRE, "agent");
            asm volatile("s_waitcnt vmcnt(0)" ::: "memory");
        }
    }
    __syncthreads();
}

struct Args { const float* in[28]; float* out; unsigned char* ws; int ph_lo, ph_hi; };

namespace pg8 {
constexpr int BM = 256, BK = 64, HALF = 128, HTB = HALF * BK * 2, STAGE_BYTES = 8 * HTB, NXCD = 8, WGM = 8;
__device__ __forceinline__ int lds_byte(int r, int c) { const int st = (r >> 4) * 2 + (c >> 5), rr = r & 15, cc = c & 31, ob = rr * 64 + cc * 2; return st * 1024 + (ob ^ (((ob >> 9) & 1) << 5)); }
__device__ __forceinline__ void stage_rc(int b, int& R, int& C) { const int st = b / 1024, sb = b % 1024, swz = sb ^ (((sb >> 9) & 1) << 5); R = (st >> 1) * 16 + swz / 64; C = (st & 1) * 32 + (swz % 64) / 2; }
__device__ __forceinline__ int perm32(int rho) { const int n = rho >> 4, i = rho & 15; return 8 * (i >> 2) + 4 * n + (i & 3); }
struct Unit { int pm, pn; };
struct Gemm { const bf16_t* A; const bf16_t* Bt; int M, N, K; };
struct StaticOrder {
    int nM, nN, nwg, G, c;
    __device__ void init(int M, int N, int G_, int c_) { nM = M / BM; nN = N / BM; nwg = nM * nN; G = G_; c = c_; }
    __device__ bool next(int i, Unit& u) const {
        const long Lx = (long)i * G + c; if (Lx >= nwg) return false;
        int wgid = (int)Lx; { const int q = nwg / NXCD, r = nwg % NXCD, xcd = wgid % NXCD, off = wgid / NXCD; wgid = (xcd < r ? xcd * (q + 1) : r * (q + 1) + (xcd - r) * q) + off; }
        const int nig = WGM * nN, gid = wgid / nig, fm = gid * WGM, gsz = (nM - fm) < WGM ? (nM - fm) : WGM;
        u.pm = fm + ((wgid % nig) % gsz); u.pn = (wgid % nig) / gsz; return true;
    }
};

template <class Epi>
__device__ __forceinline__ void gemm_phase(LAS unsigned char* lds, const Gemm g, const StaticOrder& S, const Epi& E) {
    const int tid = opaque_tid(), wid = __builtin_amdgcn_readfirstlane(tid >> 6), lane = tid & 63, wr = wid >> 2, wc = wid & 3, fr = lane & 15, fq = lane >> 4;
    const int K = g.K, nt = K / BK;
    unsigned voffA[2], voffB[2];
#pragma unroll
    for (int i = 0; i < 2; ++i) { int R, C; stage_rc(tid * 16 + i * 8192, R, C); const int Rb = Epi::PERM ? ((R & ~31) + perm32(R & 31)) : R;
        voffA[i] = (unsigned)(R * K + C) * 2u; voffB[i] = (unsigned)(Rb * K + C) * 2u; }
    const size_t kstep = (size_t)(BK * 2);
    const size_t hstep = (size_t)HALF * K * 2;
    const size_t tstep = 2 * hstep;
    const unsigned ldsw = (unsigned)wid * 1024u;
    const int aoff = lds_byte(wr * 64 + fr, fq * 8), boff = lds_byte(wc * 32 + fr, fq * 8);
#define PG8_SA(b, h) (((b) * 2 + (h)) * HTB)
#define PG8_SB(b, h) ((4 + (b) * 2 + (h)) * HTB)
#define PG8_STAGE(bufoff, gbase, voff) do { _Pragma("unroll") for (int _i = 0; _i < 2; ++_i) \
        __builtin_amdgcn_global_load_lds((const unsigned*)((const char*)(gbase) + (voff)[_i]), (LAS unsigned*)(lds + (bufoff) + ldsw + _i * 8192), 16, 0, 0); } while (0)
#define PG8_LDA(dst, b, h) do { _Pragma("unroll") for (int m = 0; m < 4; ++m) _Pragma("unroll") for (int k = 0; k < 2; ++k) dst[m][k] = *(const LAS bf16x8*)(lds + PG8_SA(b, h) + aoff + m * 2048 + k * 1024); } while (0)
#define PG8_LDB(dst, b, h) do { _Pragma("unroll") for (int n = 0; n < 2; ++n) _Pragma("unroll") for (int k = 0; k < 2; ++k) dst[n][k] = *(const LAS bf16x8*)(lds + PG8_SB(b, h) + boff + n * 2048 + k * 1024); } while (0)
#define PG8_MMA(ai, bj, At, Bt) do { __builtin_amdgcn_s_setprio(1); _Pragma("unroll") for (int m = 0; m < 4; ++m) _Pragma("unroll") for (int n = 0; n < 2; ++n) _Pragma("unroll") for (int k = 0; k < 2; ++k) \
        acc[ai][bj][m][n] = __builtin_amdgcn_mfma_f32_16x16x32_bf16(Bt[n][k], At[m][k], acc[ai][bj][m][n], 0, 0, 0); __builtin_amdgcn_s_setprio(0); } while (0)
#define PG8_WAIT_V(n) asm volatile("s_waitcnt vmcnt(" #n ")" ::: "memory")
#define PG8_WAIT_L(n) asm volatile("s_waitcnt lgkmcnt(" #n ")" ::: "memory")
#define PG8_BAR __builtin_amdgcn_s_barrier()
#define PG8_SCHED __builtin_amdgcn_sched_barrier(0)
    Unit cur, nxt; int ui = 0;
    if (!S.next(0, cur)) return;
    f32x4 acc[2][2][4][2];
#pragma unroll
    for (int a = 0; a < 2; ++a)
#pragma unroll
        for (int b = 0; b < 2; ++b)
#pragma unroll
            for (int m = 0; m < 4; ++m)
#pragma unroll
                for (int n = 0; n < 2; ++n) acc[a][b][m][n] = (f32x4){0.f, 0.f, 0.f, 0.f};
    bf16x8 At[4][2], B0[2][2], B1[2][2];
    const char* cA = (const char*)g.A + (size_t)cur.pm * tstep; const char* cB = (const char*)g.Bt + (size_t)cur.pn * tstep;
    PG8_STAGE(PG8_SB(0, 0), cB, voffB); PG8_STAGE(PG8_SA(0, 0), cA, voffA); PG8_STAGE(PG8_SB(0, 1), cB + hstep, voffB); PG8_STAGE(PG8_SA(0, 1), cA + hstep, voffA);
    if (wr == 1) PG8_BAR;
    PG8_WAIT_V(4); PG8_BAR;
    PG8_STAGE(PG8_SB(1, 0), cB + kstep, voffB); PG8_STAGE(PG8_SA(1, 0), cA + kstep, voffA); PG8_STAGE(PG8_SB(1, 1), cB + hstep + kstep, voffB);
    PG8_WAIT_V(6); PG8_BAR;
    for (;;) {
        const bool has_next = S.next(ui + 1, nxt);
        const char* nA = has_next ? (const char*)g.A + (size_t)nxt.pm * tstep : cA; const char* nB = has_next ? (const char*)g.Bt + (size_t)nxt.pn * tstep : cB;
        for (int t = 0; t < nt; t += 2) {
            const bool last = (t == nt - 2);
            const char* a1 = cA + (size_t)(t + 1) * kstep;
            const char* a2 = last ? nA : cA + (size_t)(t + 2) * kstep; const char* b2 = last ? nB : cB + (size_t)(t + 2) * kstep;
            const char* a3 = a2 + kstep; const char* b3 = b2 + kstep;
            PG8_LDB(B0, 0, 0); PG8_SCHED; PG8_LDA(At, 0, 0); PG8_STAGE(PG8_SA(1, 1), a1 + hstep, voffA);
            PG8_WAIT_L(8); PG8_BAR; PG8_WAIT_L(0); PG8_MMA(0, 0, At, B0); PG8_BAR; PG8_SCHED;
            PG8_LDB(B1, 0, 1); PG8_STAGE(PG8_SB(0, 0), b2, voffB);
            PG8_BAR; PG8_WAIT_L(0); PG8_MMA(0, 1, At, B1); PG8_BAR;
            PG8_LDA(At, 0, 1); PG8_STAGE(PG8_SA(0, 0), a2, voffA);
            PG8_BAR; PG8_WAIT_L(0); PG8_MMA(1, 0, At, B0); PG8_BAR; PG8_SCHED;
            PG8_STAGE(PG8_SB(0, 1), b2 + hstep, voffB);
            PG8_WAIT_V(6); PG8_BAR; PG8_MMA(1, 1, At, B1); PG8_BAR;
            PG8_LDB(B0, 1, 0); PG8_SCHED; PG8_LDA(At, 1, 0); PG8_STAGE(PG8_SA(0, 1), a2 + hstep, voffA);
            PG8_WAIT_L(8); PG8_BAR; PG8_WAIT_L(0); PG8_MMA(0, 0, At, B0); PG8_BAR; PG8_SCHED;
            PG8_LDB(B1, 1, 1); PG8_STAGE(PG8_SB(1, 0), b3, voffB);
            PG8_BAR; PG8_WAIT_L(0); PG8_MMA(0, 1, At, B1); PG8_BAR;
            PG8_LDA(At, 1, 1); PG8_STAGE(PG8_SA(1, 0), a3, voffA);
            PG8_BAR; PG8_WAIT_L(0); PG8_MMA(1, 0, At, B0); PG8_BAR; PG8_SCHED;
            PG8_STAGE(PG8_SB(1, 1), b3 + hstep, voffB);
            PG8_WAIT_V(6); PG8_BAR; PG8_MMA(1, 1, At, B1); PG8_BAR;
        }
        E(acc, cur, wr, wc, fr, fq);
        if (!has_next) break;
#pragma unroll
        for (int a = 0; a < 2; ++a)
#pragma unroll
            for (int b = 0; b < 2; ++b)
#pragma unroll
                for (int m = 0; m < 4; ++m)
#pragma unroll
                    for (int n = 0; n < 2; ++n) acc[a][b][m][n] = (f32x4){0.f, 0.f, 0.f, 0.f};
        cur = nxt; cA = nA; cB = nB; ++ui;
    }
    PG8_WAIT_V(0);
    if (wr == 0) PG8_BAR;
    PG8_BAR;
#undef PG8_SA
#undef PG8_SB
#undef PG8_STAGE
#undef PG8_LDA
#undef PG8_LDB
#undef PG8_MMA
#undef PG8_WAIT_V
#undef PG8_WAIT_L
#undef PG8_BAR
#undef PG8_SCHED
}
}

struct EpiSwiglu {
    static constexpr bool PERM = true;
    bf16_t* O;
    __device__ __forceinline__ void operator()(const f32x4 (&acc)[2][2][4][2], const pg8::Unit& u, int wr, int wc, int fr, int fq) const {
        const int row0 = u.pm * 256 + wr * 64 + fr, col0 = u.pn * 128 + wc * 32 + 8 * fq;
#pragma unroll
        for (int ai = 0; ai < 2; ++ai)
#pragma unroll
            for (int m = 0; m < 4; ++m) {
                bf16_t* rowp = O + (size_t)(row0 + ai * 128 + m * 16) * DFF + col0;
                float v[8];
#pragma unroll
                for (int n = 0; n < 2; ++n)
#pragma unroll
                    for (int j = 0; j < 4; ++j) { const float gg = acc[ai][0][m][n][j], uu = acc[ai][1][m][n][j]; v[n * 4 + j] = gg * fsigmoid(gg) * uu; }
                u32x4 w; w.x = pk_bf16(v[0], v[1]); w.y = pk_bf16(v[2], v[3]); w.z = pk_bf16(v[4], v[5]); w.w = pk_bf16(v[6], v[7]);
                *(u32x4*)rowp = w;
            }
    }
};
struct EpiBf16 {
    static constexpr bool PERM = true;
    bf16_t* O; int ldc;
    __device__ __forceinline__ void operator()(const f32x4 (&acc)[2][2][4][2], const pg8::Unit& u, int wr, int wc, int fr, int fq) const {
        const int row0 = u.pm * 256 + wr * 64 + fr, col0 = u.pn * 256 + wc * 32 + 8 * fq;
#pragma unroll
        for (int ai = 0; ai < 2; ++ai)
#pragma unroll
            for (int m = 0; m < 4; ++m) {
                bf16_t* rowp = O + (size_t)(row0 + ai * 128 + m * 16) * ldc + col0;
#pragma unroll
                for (int bj = 0; bj < 2; ++bj) {
                    const f32x4 v0 = acc[ai][bj][m][0], v1 = acc[ai][bj][m][1];
                    u32x4 w; w.x = pk_bf16(v0[0], v0[1]); w.y = pk_bf16(v0[2], v0[3]); w.z = pk_bf16(v1[0], v1[1]); w.w = pk_bf16(v1[2], v1[3]);
                    *(u32x4*)(rowp + bj * 128) = w;
                }
            }
    }
};
struct EpiProj {
    static constexpr bool PERM = true;
    bf16_t* Oa; bf16_t* ObT;
    __device__ __forceinline__ void operator()(const f32x4 (&acc)[2][2][4][2], const pg8::Unit& u, int wr, int wc, int fr, int fq) const {
        const int row0 = u.pm * 256 + wr * 64 + fr;
        if (u.pn < 4) {
            const int col0 = u.pn * 256 + wc * 32 + 8 * fq;
#pragma unroll
            for (int ai = 0; ai < 2; ++ai)
#pragma unroll
                for (int m = 0; m < 4; ++m) {
                    bf16_t* rowp = Oa + (size_t)(row0 + ai * 128 + m * 16) * 1024 + col0;
#pragma unroll
                    for (int bj = 0; bj < 2; ++bj) {
                        const f32x4 v0 = acc[ai][bj][m][0], v1 = acc[ai][bj][m][1];
                        u32x4 w; w.x = pk_bf16(v0[0], v0[1]); w.y = pk_bf16(v0[2], v0[3]); w.z = pk_bf16(v1[0], v1[1]); w.w = pk_bf16(v1[2], v1[3]);
                        *(u32x4*)(rowp + bj * 128) = w;
                    }
                }
        } else {
            const int seq = (u.pm * 256) >> 14;
            const int c0 = (u.pn - 4) * 256 + wc * 32 + 8 * fq;
#pragma unroll
            for (int ai = 0; ai < 2; ++ai)
#pragma unroll
                for (int m = 0; m < 4; ++m) {
                    const int nn = (row0 + ai * 128 + m * 16) & (L - 1);
#pragma unroll
                    for (int bj = 0; bj < 2; ++bj)
#pragma unroll
                        for (int n = 0; n < 2; ++n)
#pragma unroll
                            for (int j = 0; j < 4; ++j)
                                ObT[((size_t)(seq * 1536 + c0 + bj * 128 + 4 * n + j) << 14) + nn] = f2bf(acc[ai][bj][m][n][j]);
                }
        }
    }
};
struct EpiResid {
    static constexpr bool PERM = false;
    const float* xs0; const float* xs1; float* out; const float* gate; float scale;
    __device__ __forceinline__ void operator()(const f32x4 (&acc)[2][2][4][2], const pg8::Unit& u, int wr, int wc, int fr, int fq) const {
        const int row0 = u.pm * 256 + wr * 64 + fr, col0 = u.pn * 256 + wc * 32 + 4 * fq;
        const int seq = (u.pm * 256) >> 14;
        const float* srcb = (seq < 2 ? xs0 + (size_t)row0 * 1024 : xs1 + (size_t)(row0 - 32768) * 1024) + col0;
        float* dstb = out + (size_t)row0 * 1024 + col0;
        const float* gb = gate + seq * 9216 + col0;
#pragma unroll
        for (int bj = 0; bj < 2; ++bj)
#pragma unroll
            for (int n = 0; n < 2; ++n) {
                const f32x4 gv = *(const f32x4*)(gb + bj * 128 + n * 16) * scale;
#pragma unroll
                for (int ai = 0; ai < 2; ++ai) {
#pragma unroll
                    for (int m = 0; m < 4; ++m) {
                        const size_t off = (size_t)(ai * 128 + m * 16) * 1024 + bj * 128 + n * 16;
                        *(f32x4*)(dstb + off) = *(const f32x4*)(srcb + off) + gv * acc[ai][bj][m][n];
                    }
                    asm volatile("" ::: "memory");
                }
            }
    }
};

__device__ void convert_weights(const Args& a, LAS float* tile) {
    const int tid = opaque_tid();
    unsigned char* ws = a.ws;
    for (int ti = blockIdx.x; ti < 9984; ti += gridDim.x) {
        const float* src; bf16_t* dst; int K, N, mode = 0, lt;
        if (ti < 5632) { const int mi = ti / 1408; lt = ti % 1408; src = a.in[7] + (size_t)mi * 1024 * 5632; dst = (bf16_t*)(ws + WS_WIN) + (size_t)mi * 5632 * 1024; K = 1024; N = 5632; mode = 1; }
        else if (ti < 8448) { const int mi = (ti - 5632) / 704; lt = (ti - 5632) % 704; src = a.in[8] + (size_t)mi * 2816 * 1024; dst = (bf16_t*)(ws + WS_WOUT) + (size_t)mi * 1024 * 2816; K = 2816; N = 1024; }
        else if (ti < 9088) { lt = ti - 8448; src = a.in[10]; dst = (bf16_t*)(ws + WS_WABIN); K = 1024; N = 2560; }
        else if (ti < 9344) { lt = ti - 9088; src = a.in[24]; dst = (bf16_t*)(ws + WS_WABOUT); K = 1024; N = 1024; }
        else if (ti < 9728) { lt = ti - 9344; src = a.in[25]; dst = (bf16_t*)(ws + WS_WQKV); K = 1024; N = 1536; }
        else { lt = ti - 9728; src = a.in[27]; dst = (bf16_t*)(ws + WS_WATTO); K = 1024; N = 1024; }
        const int nkt = K / 64;
        const int kt = lt % nkt, ntp = lt / nkt;
        const int k0 = kt * 64, np0 = ntp * 64;
        int n0 = np0;
        if (mode == 1) { const int pn = np0 >> 8, bj = (np0 >> 7) & 1, c0 = np0 & 127; n0 = bj * DFF + 128 * pn + c0; }
        __syncthreads();
#pragma unroll
        for (int i = 0; i < 8; ++i) { const int k = (tid >> 6) + 8 * i, n = tid & 63; tile[k * 65 + n] = src[(size_t)(k0 + k) * N + n0 + n]; }
        __syncthreads();
        const int nn = tid >> 3, kk = (tid & 7) * 8;
        float v[8];
#pragma unroll
        for (int j = 0; j < 8; ++j) v[j] = tile[(kk + j) * 65 + nn];
        u32x4 w; w.x = pk_bf16(v[0], v[1]); w.y = pk_bf16(v[2], v[3]); w.z = pk_bf16(v[4], v[5]); w.w = pk_bf16(v[6], v[7]);
        *(u32x4*)(dst + (size_t)(np0 + nn) * K + k0 + kk) = w;
    }
    __syncthreads();
}

__device__ void ada_phase(const Args& a, LAS float* lf) {
    const int tid = opaque_tid(), lane = tid & 63, w = tid >> 6;
    LAS float* cs = lf; LAS float* red = lf + 3072;
    float* mod = (float*)(a.ws + WS_MOD);
    __syncthreads();
    for (int i = tid; i < 3072; i += 512) { const int s = i >> 10, k = i & 1023; const float c = s < 2 ? a.in[2][s * 1024 + k] : a.in[3][k]; cs[i] = c * fsigmoid(c); }
    __syncthreads();
    for (int item = blockIdx.x; item < 288; item += gridDim.x) {
        const int layer = item / 144, cgp = item % 144, col = cgp * 64 + lane;
        const float* W = a.in[4] + (size_t)layer * 1024 * 9216 + col;
        float a0 = 0.f, a1 = 0.f, a2 = 0.f;
#pragma unroll 8
        for (int k = w * 128; k < w * 128 + 128; ++k) { const float wv = W[(size_t)k * 9216]; a0 += cs[k] * wv; a1 += cs[1024 + k] * wv; a2 += cs[2048 + k] * wv; }
        red[(w * 3 + 0) * 64 + lane] = a0; red[(w * 3 + 1) * 64 + lane] = a1; red[(w * 3 + 2) * 64 + lane] = a2;
        __syncthreads();
        if (tid < 192) { const int s = tid >> 6; float sum = 0.f;
#pragma unroll
            for (int ww = 0; ww < 8; ++ww) sum += red[(ww * 3 + s) * 64 + lane];
            mod[(size_t)(layer * 3 + s) * 9216 + cgp * 64 + lane] = sum + a.in[5][layer * 9216 + cgp * 64 + lane]; }
        __syncthreads();
    }
}

__device__ void filter_phase(const Args& a, LAS float* lf) {
    const int tid = opaque_tid();
    LAS float* feats = lf;
    LAS float* h1 = lf + 64 * 33;
    LAS float* h2T = h1 + 64 * 65;
    const float* w1 = a.in[17]; const float* b1 = a.in[18]; const float* w2 = a.in[19]; const float* b2 = a.in[20]; const float* w3 = a.in[21]; const float* fr = a.in[22];
    half_t* KT = (half_t*)(a.ws + WS_KT);
    for (int item = blockIdx.x; item < 256; item += gridDim.x) {
        const int p0 = item * 64;
        __syncthreads();
        for (int idx = tid; idx < 64 * 33; idx += 512) {
            const int pos = idx / 33, f = idx % 33, n = p0 + pos; float v;
            if (f == 0) v = (float)n / (float)(L - 1);
            else { const int b = (f - 1) & 15; const double band = 1e-4 + (double)b * ((15.0 - 1e-4) / 15.0); double rev = (double)n * band / (double)L; rev -= floor(rev);
                   v = (f <= 16) ? __builtin_amdgcn_cosf((float)rev) : -__builtin_amdgcn_sinf((float)rev); }
            feats[idx] = v;
        }
        __syncthreads();
        { const int pos = tid >> 3, j0 = (tid & 7) * 8; float acc[8];
#pragma unroll
          for (int j = 0; j < 8; ++j) acc[j] = b1[j0 + j];
#pragma unroll 3
          for (int f = 0; f < 33; ++f) { const float x = feats[pos * 33 + f];
#pragma unroll
              for (int j = 0; j < 8; ++j) acc[j] += x * w1[f * 64 + j0 + j]; }
#pragma unroll
          for (int j = 0; j < 8; ++j) h1[pos * 65 + j0 + j] = hw_sin(fr[j0 + j] * acc[j]); }
        __syncthreads();
        { const int pos = tid >> 3, j0 = (tid & 7) * 8; float acc[8];
#pragma unroll
          for (int j = 0; j < 8; ++j) acc[j] = b2[j0 + j];
#pragma unroll 4
          for (int i = 0; i < 64; ++i) { const float x = h1[pos * 65 + i];
#pragma unroll
              for (int j = 0; j < 8; ++j) acc[j] += x * w2[i * 64 + j0 + j]; }
#pragma unroll
          for (int j = 0; j < 8; ++j) h2T[(j0 + j) * 64 + pos] = hw_sin(fr[j0 + j] * acc[j]); }
        __syncthreads();
        const int col0 = tid * 4;
        const int dir = col0 >> 10, ord = (col0 >> 9) & 1, ch0 = col0 & 511;
#pragma unroll 1
        for (int chunk = 0; chunk < 4; ++chunk) {
            float acc[16][4];
#pragma unroll
            for (int p = 0; p < 16; ++p)
#pragma unroll
                for (int c = 0; c < 4; ++c) acc[p][c] = 0.f;
#pragma unroll 2
            for (int j = 0; j < 64; ++j) {
                const f32x4 wv = *(const f32x4*)(w3 + j * 2048 + col0);
                f32x4 hv[4];
#pragma unroll
                for (int q = 0; q < 4; ++q) hv[q] = *(const LAS f32x4*)(h2T + j * 64 + chunk * 16 + q * 4);
#pragma unroll
                for (int p = 0; p < 16; ++p)
#pragma unroll
                    for (int c = 0; c < 4; ++c) acc[p][c] += hv[p >> 2][p & 3] * wv[c];
            }
#pragma unroll
            for (int c = 0; c < 4; ++c) {
                const int ch = ch0 + c;
                const float delta = 3.0701134573253945f + (float)ch * (12.280453829301578f / 511.0f);
                half_t* dstp = KT + ((size_t)((ord * 512 + ch) * 2 + dir) << 14) + p0 + chunk * 16;
                unsigned pk[8];
#pragma unroll
                for (int p = 0; p < 16; p += 2) {
                    const float t0 = (float)(p0 + chunk * 16 + p) / (float)(L - 1), t1 = (float)(p0 + chunk * 16 + p + 1) / (float)(L - 1);
                    const half_t x0 = (half_t)(acc[p][c] * __expf(-t0 * delta)), x1 = (half_t)(acc[p + 1][c] * __expf(-t1 * delta));
                    pk[p >> 1] = (unsigned)__builtin_bit_cast(unsigned short, x0) | ((unsigned)__builtin_bit_cast(unsigned short, x1) << 16);
                }
                *(u32x4*)dstp = (u32x4){pk[0], pk[1], pk[2], pk[3]};
                *(u32x4*)(dstp + 8) = (u32x4){pk[4], pk[5], pk[6], pk[7]};
            }
        }
    }
    __syncthreads();
}

__device__ void norm_phase(const float* xs0, const float* xs1, const float* g, const float* sh, const float* sc, bf16_t* h) {
    const int tid_ = opaque_tid(); const int lane = tid_ & 63, w = tid_ >> 6;
    f32x4 gg[4];
#pragma unroll
    for (int i = 0; i < 4; ++i) gg[i] = *(const f32x4*)(g + i * 256 + lane * 4);
    for (int row = blockIdx.x * 8 + w; row < T; row += gridDim.x * 8) {
        const int seq = row >> 14;
        const float* xr = seq < 2 ? xs0 + (size_t)row * 1024 : xs1 + (size_t)(row - 32768) * 1024;
        f32x4 v[4]; float ss = 0.f;
#pragma unroll
        for (int i = 0; i < 4; ++i) { v[i] = *(const f32x4*)(xr + i * 256 + lane * 4); ss += v[i][0] * v[i][0] + v[i][1] * v[i][1] + v[i][2] * v[i][2] + v[i][3] * v[i][3]; }
#pragma unroll
        for (int o = 32; o > 0; o >>= 1) ss += __shfl_xor(ss, o);
        const float rstd = rsqrtf(ss * (1.0f / 1024.0f) + EPS);
#pragma unroll
        for (int i = 0; i < 4; ++i) {
            const int col = i * 256 + lane * 4;
            const f32x4 s1 = *(const f32x4*)(sc + seq * 9216 + col), s0 = *(const f32x4*)(sh + seq * 9216 + col);
            const f32x4 y = v[i] * rstd * gg[i] * (s1 + 1.0f) + s0;
            u32x2 o; o.x = pk_bf16(y[0], y[1]); o.y = pk_bf16(y[2], y[3]);
            *(u32x2*)(h + (size_t)row * 1024 + col) = o;
        }
    }
}
__device__ void final_norm_phase(float* x, const float* g) {
    const int tid_ = opaque_tid(); const int lane = tid_ & 63, w = tid_ >> 6;
    f32x4 gg[4];
#pragma unroll
    for (int i = 0; i < 4; ++i) gg[i] = *(const f32x4*)(g + i * 256 + lane * 4);
    for (int row = blockIdx.x * 8 + w; row < T; row += gridDim.x * 8) {
        float* xr = x + (size_t)row * 1024;
        f32x4 v[4]; float ss = 0.f;
#pragma unroll
        for (int i = 0; i < 4; ++i) { v[i] = *(const f32x4*)(xr + i * 256 + lane * 4); ss += v[i][0] * v[i][0] + v[i][1] * v[i][1] + v[i][2] * v[i][2] + v[i][3] * v[i][3]; }
#pragma unroll
        for (int o = 32; o > 0; o >>= 1) ss += __shfl_xor(ss, o);
        const float rstd = rsqrtf(ss * (1.0f / 1024.0f) + EPS);
#pragma unroll
        for (int i = 0; i < 4; ++i) *(f32x4*)(xr + i * 256 + lane * 4) = v[i] * rstd * gg[i];
    }
}

__device__ void conva_phase(const Args& a, const bf16_t* pa, bf16_t* cat, LAS unsigned char* lds) {
    const int tid = opaque_tid(), lane = tid & 63, w = tid >> 6;
    LAS bf16_t* glu = (LAS bf16_t*)lds;
    LAS float* stage = (LAS float*)(lds + 94 * 512 * 2);
    const float* cw = a.in[11]; const float* cb = a.in[12]; const float* lg = a.in[13]; const float* lb = a.in[14];
    float wt[31];
#pragma unroll
    for (int j = 0; j < 31; ++j) wt[j] = cw[j * 512 + tid];
    const float bias = cb[tid];
    float lgv[8], lbv[8];
#pragma unroll
    for (int i = 0; i < 8; ++i) { lgv[i] = lg[lane + 64 * i]; lbv[i] = lb[lane + 64 * i]; }
    for (int tile = blockIdx.x; tile < 768; tile += gridDim.x) {
        const int seq = tile >> 8, t0 = (tile & 255) * 64;
        __syncthreads();
        for (int idx = tid; idx < 94 * 64; idx += 512) {
            const int r = idx >> 6, cc = idx & 63, t = t0 - 15 + r;
            u32x4 res = (u32x4){0u, 0u, 0u, 0u};
            if (t >= 0 && t < L) {
                const bf16_t* rp = pa + (size_t)(seq * L + t) * 1024 + cc * 8;
                const u32x4 x1 = *(const u32x4*)rp, x2 = *(const u32x4*)(rp + 512);
#pragma unroll
                for (int q = 0; q < 4; ++q) res[q] = pk_bf16(bf_lo(x1[q]) * fsigmoid(bf_lo(x2[q])), bf_hi(x1[q]) * fsigmoid(bf_hi(x2[q])));
            }
            *(LAS u32x4*)(glu + r * 512 + cc * 8) = res;
        }
        __syncthreads();
        for (int chunk = 0; chunk < 8; ++chunk) {
            float o[8];
#pragma unroll
            for (int tt = 0; tt < 8; ++tt) o[tt] = bias;
#pragma unroll
            for (int i = 0; i < 38; ++i) {
                const float x = bf2f(glu[(chunk * 8 + i) * 512 + tid]);
#pragma unroll
                for (int tt = 0; tt < 8; ++tt) { const int j = i - tt; if (j >= 0 && j < 31) o[tt] += wt[j] * x; }
            }
#pragma unroll
            for (int tt = 0; tt < 8; ++tt) stage[tt * 512 + tid] = o[tt];
            __syncthreads();
            {
                float v[8]; float s = 0.f;
#pragma unroll
                for (int i = 0; i < 8; ++i) { v[i] = stage[w * 512 + lane + 64 * i]; s += v[i]; }
#pragma unroll
                for (int of = 32; of > 0; of >>= 1) s += __shfl_xor(s, of);
                const float mean = s * (1.0f / 512.0f);
                float q = 0.f;
#pragma unroll
                for (int i = 0; i < 8; ++i) { const float d = v[i] - mean; q += d * d; }
#pragma unroll
                for (int of = 32; of > 0; of >>= 1) q += __shfl_xor(q, of);
                const float rstd = rsqrtf(q * (1.0f / 512.0f) + EPS);
                bf16_t* op = cat + (size_t)(seq * L + t0 + chunk * 8 + w) * 1024;
#pragma unroll
                for (int i = 0; i < 8; ++i) { const float y = (v[i] - mean) * rstd * lgv[i] + lbv[i]; op[lane + 64 * i] = f2bf(y * fsigmoid(y)); }
            }
            __syncthreads();
        }
    }
    __syncthreads();
}

typedef float v2 __attribute__((ext_vector_type(2)));
__device__ __forceinline__ int fphys(int i) { return i + ((i >> 6) << 2); }
struct C2 { v2 r, i; };
__device__ __forceinline__ C2 cmul2(const C2& a, const C2& b) { C2 o; o.r = a.r * b.r - a.i * b.i; o.i = a.r * b.i + a.i * b.r; return o; }
__device__ __forceinline__ C2 cmulc(const C2& a, float cr, float ci) { C2 o; o.r = a.r * cr - a.i * ci; o.i = a.r * ci + a.i * cr; return o; }
template <bool INV> __device__ __forceinline__ void bf4(C2& a, C2& b, C2& c, C2& d) {
    C2 t0, t1, t2, e, t3;
    t0.r = a.r + c.r; t0.i = a.i + c.i; t1.r = a.r - c.r; t1.i = a.i - c.i; t2.r = b.r + d.r; t2.i = b.i + d.i; e.r = b.r - d.r; e.i = b.i - d.i;
    if (INV) { t3.r = -e.i; t3.i = e.r; } else { t3.r = e.i; t3.i = -e.r; }
    a.r = t0.r + t2.r; a.i = t0.i + t2.i; b.r = t1.r + t3.r; b.i = t1.i + t3.i; c.r = t0.r - t2.r; c.i = t0.i - t2.i; d.r = t1.r - t3.r; d.i = t1.i - t3.i;
}
template <bool INV, int K16> __device__ __forceinline__ C2 mulc16(const C2& a) {
    constexpr float cs[10] = {1.0f, 0.92387953251128674f, 0.70710678118654752f, 0.38268343236508977f, 0.0f, -0.38268343236508977f, -0.70710678118654752f, -0.92387953251128674f, -1.0f, -0.92387953251128674f};
    constexpr float sn[10] = {0.0f, 0.38268343236508977f, 0.70710678118654752f, 0.92387953251128674f, 1.0f, 0.92387953251128674f, 0.70710678118654752f, 0.38268343236508977f, 0.0f, -0.38268343236508977f};
    if (K16 == 4) { C2 o; if (INV) { o.r = -a.i; o.i = a.r; } else { o.r = a.i; o.i = -a.r; } return o; }
    return cmulc(a, cs[K16], INV ? sn[K16] : -sn[K16]);
}
template <bool INV, int LOGQ> __device__ __forceinline__ void r16_pass(LAS float* Fre, LAS float* Fim, int tid) {
    constexpr int Q = 1 << LOGQ;
    constexpr int PSTR = (Q >= 64) ? (Q + (Q >> 4)) : Q;
    const int b0 = 2 * tid, pos0 = b0 & (Q - 1), grp = b0 >> LOGQ, base = (grp << (LOGQ + 4)) + pos0;
    const int p = fphys(base);
    C2 x[16];
#pragma unroll
    for (int r = 0; r < 16; ++r) { x[r].r = *(const LAS v2*)(Fre + p + r * PSTR); x[r].i = *(const LAS v2*)(Fim + p + r * PSTR); }
    int posv = pos0; asm volatile("" : "+v"(posv));
    const float rev0 = (float)posv * (1.0f / (float)(16 * Q)), rev1 = (float)(posv + 1) * (1.0f / (float)(16 * Q));
    C2 w1; w1.r = (v2){__builtin_amdgcn_cosf(rev0), __builtin_amdgcn_cosf(rev1)};
    { const v2 sn = (v2){__builtin_amdgcn_sinf(rev0), __builtin_amdgcn_sinf(rev1)}; w1.i = INV ? sn : -sn; }
    const C2 w2 = cmul2(w1, w1), w3 = cmul2(w2, w1), w4 = cmul2(w2, w2), w8 = cmul2(w4, w4), w12 = cmul2(w8, w4);
    if (!INV) {
#pragma unroll
        for (int j = 0; j < 4; ++j) {
            bf4<false>(x[j], x[j + 4], x[j + 8], x[j + 12]);
            x[j + 4] = cmul2(x[j + 4], w1); x[j + 8] = cmul2(x[j + 8], w2); x[j + 12] = cmul2(x[j + 12], w3);
        }
        x[5] = mulc16<false, 1>(x[5]); x[9] = mulc16<false, 2>(x[9]); x[13] = mulc16<false, 3>(x[13]);
        x[6] = mulc16<false, 2>(x[6]); x[10] = mulc16<false, 4>(x[10]); x[14] = mulc16<false, 6>(x[14]);
        x[7] = mulc16<false, 3>(x[7]); x[11] = mulc16<false, 6>(x[11]); x[15] = mulc16<false, 9>(x[15]);
#pragma unroll
        for (int r = 0; r < 4; ++r) {
            bf4<false>(x[4 * r], x[4 * r + 1], x[4 * r + 2], x[4 * r + 3]);
            x[4 * r + 1] = cmul2(x[4 * r + 1], w4); x[4 * r + 2] = cmul2(x[4 * r + 2], w8); x[4 * r + 3] = cmul2(x[4 * r + 3], w12);
        }
    } else {
#pragma unroll
        for (int r = 0; r < 4; ++r) {
            x[4 * r + 1] = cmul2(x[4 * r + 1], w4); x[4 * r + 2] = cmul2(x[4 * r + 2], w8); x[4 * r + 3] = cmul2(x[4 * r + 3], w12);
            bf4<true>(x[4 * r], x[4 * r + 1], x[4 * r + 2], x[4 * r + 3]);
        }
        x[5] = mulc16<true, 1>(x[5]); x[9] = mulc16<true, 2>(x[9]); x[13] = mulc16<true, 3>(x[13]);
        x[6] = mulc16<true, 2>(x[6]); x[10] = mulc16<true, 4>(x[10]); x[14] = mulc16<true, 6>(x[14]);
        x[7] = mulc16<true, 3>(x[7]); x[11] = mulc16<true, 6>(x[11]); x[15] = mulc16<true, 9>(x[15]);
#pragma unroll
        for (int j = 0; j < 4; ++j) {
            x[j + 4] = cmul2(x[j + 4], w1); x[j + 8] = cmul2(x[j + 8], w2); x[j + 12] = cmul2(x[j + 12], w3);
            bf4<true>(x[j], x[j + 4], x[j + 8], x[j + 12]);
        }
    }
#pragma unroll
    for (int r = 0; r < 16; ++r) { *(LAS v2*)(Fre + p + r * PSTR) = x[r].r; *(LAS v2*)(Fim + p + r * PSTR) = x[r].i; }
}
template <bool INV> __device__ __forceinline__ void r4_pass(LAS float* Fre, LAS float* Fim, int tid) {
#pragma unroll 2
    for (int bi = 0; bi < 4; ++bi) {
        const int p = fphys(8 * (tid + 512 * bi));
        const f32x4 ra = *(const LAS f32x4*)(Fre + p), rb = *(const LAS f32x4*)(Fre + p + 4), ia = *(const LAS f32x4*)(Fim + p), ib = *(const LAS f32x4*)(Fim + p + 4);
        C2 x0, x1, x2, x3;
        x0.r = (v2){ra[0], rb[0]}; x1.r = (v2){ra[1], rb[1]}; x2.r = (v2){ra[2], rb[2]}; x3.r = (v2){ra[3], rb[3]};
        x0.i = (v2){ia[0], ib[0]}; x1.i = (v2){ia[1], ib[1]}; x2.i = (v2){ia[2], ib[2]}; x3.i = (v2){ia[3], ib[3]};
        bf4<INV>(x0, x1, x2, x3);
        *(LAS f32x4*)(Fre + p) = (f32x4){x0.r[0], x1.r[0], x2.r[0], x3.r[0]}; *(LAS f32x4*)(Fre + p + 4) = (f32x4){x0.r[1], x1.r[1], x2.r[1], x3.r[1]};
        *(LAS f32x4*)(Fim + p) = (f32x4){x0.i[0], x1.i[0], x2.i[0], x3.i[0]}; *(LAS f32x4*)(Fim + p + 4) = (f32x4){x0.i[1], x1.i[1], x2.i[1], x3.i[1]};
    }
}
__device__ __forceinline__ void fft_fwd(LAS float* Fre, LAS float* Fim, int tid) {
    r16_pass<false, 10>(Fre, Fim, tid); __syncthreads(); r16_pass<false, 6>(Fre, Fim, tid); __syncthreads(); r16_pass<false, 2>(Fre, Fim, tid); __syncthreads(); r4_pass<false>(Fre, Fim, tid);
}
__device__ __forceinline__ void fft_inv(LAS float* Fre, LAS float* Fim, int tid) {
    r4_pass<true>(Fre, Fim, tid); __syncthreads(); r16_pass<true, 2>(Fre, Fim, tid); __syncthreads(); r16_pass<true, 6>(Fre, Fim, tid); __syncthreads(); r16_pass<true, 10>(Fre, Fim, tid);
}
typedef _Float16 h8v __attribute__((ext_vector_type(8)));
__device__ __forceinline__ void sconv8(const bf16_t* row, int n0, float w0, float w1, float w2, float b, float (&out)[8]) {
    const u32x4 q = *(const u32x4*)(row + n0);
    float x[10];
    x[0] = n0 > 0 ? bf2f(row[n0 - 1]) : 0.f;
    x[9] = n0 + 8 < L ? bf2f(row[n0 + 8]) : 0.f;
#pragma unroll
    for (int i = 0; i < 4; ++i) { x[1 + 2 * i] = bf_lo(q[i]); x[2 + 2 * i] = bf_hi(q[i]); }
#pragma unroll
    for (int e = 0; e < 8; ++e) out[e] = b + w0 * x[e] + w1 * x[e + 1] + w2 * x[e + 2];
}
template <bool CONJ> __device__ __forceinline__ void tw8(int n0, float (&tr)[8], float (&ti)[8]) {
    const float rev = (float)n0 * (1.0f / (float)(2 * L));
    const float sr = 0.99999998161642933f, si = CONJ ? 1.9174759731070330e-4f : -1.9174759731070330e-4f;
    tr[0] = __builtin_amdgcn_cosf(rev); ti[0] = CONJ ? __builtin_amdgcn_sinf(rev) : -__builtin_amdgcn_sinf(rev);
#pragma unroll
    for (int e = 1; e < 8; ++e) { tr[e] = tr[e - 1] * sr - ti[e - 1] * si; ti[e] = tr[e - 1] * si + ti[e - 1] * sr; }
}
__device__ __forceinline__ void st8(LAS float* p, const float (&v)[8]) { *(LAS f32x4*)p = (f32x4){v[0], v[1], v[2], v[3]}; *(LAS f32x4*)(p + 4) = (f32x4){v[4], v[5], v[6], v[7]}; }
__device__ __forceinline__ void ld8(const LAS float* p, float (&v)[8]) { const f32x4 a = *(const LAS f32x4*)p, b = *(const LAS f32x4*)(p + 4);
#pragma unroll
    for (int e = 0; e < 4; ++e) { v[e] = a[e]; v[4 + e] = b[e]; } }
template <bool DRY> __device__ void fft_phase(const Args& a, bf16_t* pbT, LAS unsigned char* lds) {
    const int tid = opaque_tid(), lane = tid & 63, w = tid >> 6;
    LAS float* Fre = (LAS float*)lds; LAS float* Fim = Fre + 17408;
    LAS float* red = (LAS float*)(lds + 17408 * 8);
    const int po = fphys(8 * tid);
    const half_t* KT = (const half_t*)(a.ws + WS_KT);
    unsigned char* scr = a.ws + WS_ACT + PBT_BYTES + (size_t)blockIdx.x * FFTSCR_PER_BLOCK;
    float* ybuf = (float*)scr;
    float* z1buf = (float*)(scr + 2ull * L * 8);
    const float* sw = a.in[15]; const float* sb = a.in[16]; const float* skip = a.in[23];
    for (int ch = blockIdx.x; ch < 512; ch += gridDim.x) {
        const float vw0 = sw[ch], vw1 = sw[1536 + ch], vw2 = sw[3072 + ch], vb = sb[ch];
#pragma unroll 1
        for (int o = 0; o < 2; ++o) {
            const half_t* kf = KT + ((size_t)((o * 512 + ch) * 2) << 14); const half_t* kb = kf + L;
            const int xc = (o == 0 ? 512 : 1024) + ch;
            const float gw0 = sw[xc], gw1 = sw[1536 + xc], gw2 = sw[3072 + xc], gb = sb[xc];
            const float skp = skip[o * 512 + ch];
            float ss = 0.f;
#pragma unroll 1
            for (int g = 0; g < 4; ++g) {
                const int n0 = 8 * (tid + 512 * g);
                const h8v f = *(const h8v*)(kf + n0), bk = *(const h8v*)(kb + n0);
#pragma unroll
                for (int e = 0; e < 8; ++e) { const float ff = (float)f[e], bb = (n0 + e > 0) ? (float)bk[e] : 0.f; ss += ff * ff + bb * bb; }
            }
#pragma unroll
            for (int of = 32; of > 0; of >>= 1) ss += __shfl_xor(ss, of);
            __syncthreads();
            if (lane == 0) red[w] = ss;
            __syncthreads();
            float tot = 0.f;
#pragma unroll
            for (int ww = 0; ww < 8; ++ww) tot += red[ww];
            const float kscale = rsqrtf(tot + EPS) * (0.5f / (float)L);
#pragma unroll 1
            for (int br = 0; br < 2; ++br) {
                __syncthreads();
#pragma unroll 1
                for (int g = 0; g < 4; ++g) {
                    const int n0 = 8 * (tid + 512 * g);
                    const h8v f = *(const h8v*)(kf + n0), bc = *(const h8v*)(kb + (L - 8 - n0));
                    const float b0 = n0 > 0 ? (float)kb[L - n0] : 0.f;
                    float d[8], vr[8], vi[8];
#pragma unroll
                    for (int e = 0; e < 8; ++e) { const float bk = (e == 0) ? b0 : (float)bc[8 - e]; d[e] = (br == 0 ? (float)f[e] + bk : (float)f[e] - bk) * kscale; }
                    if (br == 0) {
#pragma unroll
                        for (int e = 0; e < 8; ++e) { vr[e] = d[e]; vi[e] = 0.f; }
                    } else {
                        float tr[8], ti[8]; tw8<false>(n0, tr, ti);
#pragma unroll
                        for (int e = 0; e < 8; ++e) { vr[e] = d[e] * tr[e]; vi[e] = d[e] * ti[e]; }
                    }
                    st8(Fre + po + 4352 * g, vr); st8(Fim + po + 4352 * g, vi);
                }
                __syncthreads();
                fft_fwd(Fre, Fim, tid);
                __syncthreads();
                float KrR[32], KrI[32];
#pragma unroll
                for (int g = 0; g < 4; ++g) {
                    const f32x4 r0 = *(const LAS f32x4*)(Fre + po + 4352 * g), r1 = *(const LAS f32x4*)(Fre + po + 4352 * g + 4), i0 = *(const LAS f32x4*)(Fim + po + 4352 * g), i1 = *(const LAS f32x4*)(Fim + po + 4352 * g + 4);
#pragma unroll
                    for (int e = 0; e < 4; ++e) { KrR[g * 8 + e] = r0[e]; KrR[g * 8 + 4 + e] = r1[e]; KrI[g * 8 + e] = i0[e]; KrI[g * 8 + 4 + e] = i1[e]; }
                }
#pragma unroll 1
                for (int pk = 0; pk < 2; ++pk) {
                    __syncthreads();
#pragma unroll 1
                    for (int g = 0; g < 4; ++g) {
                        const int n0 = 8 * (tid + 512 * g);
                        float re[8], im[8];
                        if (o == 0) {
                            sconv8(pbT + ((size_t)((2 * pk) * 1536 + ch) << 14), n0, vw0, vw1, vw2, vb, re);
                            if (pk == 0) sconv8(pbT + ((size_t)(1536 + ch) << 14), n0, vw0, vw1, vw2, vb, im);
                        } else {
                            const f32x4 r0 = *(const f32x4*)(z1buf + (2 * pk) * L + n0), r1 = *(const f32x4*)(z1buf + (2 * pk) * L + n0 + 4);
#pragma unroll
                            for (int e = 0; e < 4; ++e) { re[e] = r0[e]; re[4 + e] = r1[e]; }
                            if (pk == 0) { const f32x4 i0 = *(const f32x4*)(z1buf + L + n0), i1 = *(const f32x4*)(z1buf + L + n0 + 4);
#pragma unroll
                                for (int e = 0; e < 4; ++e) { im[e] = i0[e]; im[4 + e] = i1[e]; } }
                        }
                        if (pk == 1) {
#pragma unroll
                            for (int e = 0; e < 8; ++e) im[e] = 0.f;
                        }
                        if (br == 1) {
                            float tr[8], ti[8]; tw8<false>(n0, tr, ti);
#pragma unroll
                            for (int e = 0; e < 8; ++e) { const float xr = re[e] * tr[e] - im[e] * ti[e], xi = re[e] * ti[e] + im[e] * tr[e]; re[e] = xr; im[e] = xi; }
                        }
                        st8(Fre + po + 4352 * g, re); st8(Fim + po + 4352 * g, im);
                    }
                    __syncthreads();
                    fft_fwd(Fre, Fim, tid);
                    __syncthreads();
#pragma unroll
                    for (int g = 0; g < 4; ++g) {
                        float xr[8], xi[8], yr[8], yi[8];
                        ld8(Fre + po + 4352 * g, xr); ld8(Fim + po + 4352 * g, xi);
#pragma unroll
                        for (int e = 0; e < 8; ++e) { yr[e] = xr[e] * KrR[g * 8 + e] - xi[e] * KrI[g * 8 + e]; yi[e] = xr[e] * KrI[g * 8 + e] + xi[e] * KrR[g * 8 + e]; }
                        st8(Fre + po + 4352 * g, yr); st8(Fim + po + 4352 * g, yi);
                    }
                    __syncthreads();
                    fft_inv(Fre, Fim, tid);
                    __syncthreads();
#pragma unroll 1
                    for (int g = 0; g < 4; ++g) {
                        const int n0 = 8 * (tid + 512 * g);
                        float rr[8], ri[8];
                        ld8(Fre + po + 4352 * g, rr); ld8(Fim + po + 4352 * g, ri);
                        float* ybr = ybuf + (size_t)pk * 2 * L + n0; float* ybi = ybr + L;
                        if (br == 0) {
                            *(f32x4*)ybr = (f32x4){rr[0], rr[1], rr[2], rr[3]}; *(f32x4*)(ybr + 4) = (f32x4){rr[4], rr[5], rr[6], rr[7]};
                            *(f32x4*)ybi = (f32x4){ri[0], ri[1], ri[2], ri[3]}; *(f32x4*)(ybi + 4) = (f32x4){ri[4], ri[5], ri[6], ri[7]};
                        } else {
                            const f32x4 yr0 = *(const f32x4*)ybr, yr1 = *(const f32x4*)(ybr + 4), yi0 = *(const f32x4*)ybi, yi1 = *(const f32x4*)(ybi + 4);
                            float tr[8], ti[8]; tw8<true>(n0, tr, ti);
                            float yre[8], yim[8];
#pragma unroll
                            for (int e = 0; e < 8; ++e) {
                                yre[e] = (e < 4 ? yr0[e & 3] : yr1[e & 3]) + rr[e] * tr[e] - ri[e] * ti[e];
                                yim[e] = (e < 4 ? yi0[e & 3] : yi1[e & 3]) + rr[e] * ti[e] + ri[e] * tr[e];
                            }
                            const int nseq = (pk == 0) ? 2 : 1;
#pragma unroll 1
                            for (int q = 0; q < nseq; ++q) {
                                const int s = 2 * pk + q;
                                float gate[8];
                                sconv8(pbT + ((size_t)(s * 1536 + xc) << 14), n0, gw0, gw1, gw2, gb, gate);
                                float* zp = z1buf + s * L + n0;
                                if (o == 0) {
                                    float vv[8];
                                    sconv8(pbT + ((size_t)(s * 1536 + ch) << 14), n0, vw0, vw1, vw2, vb, vv);
                                    float z[8];
#pragma unroll
                                    for (int e = 0; e < 8; ++e) z[e] = gate[e] * ((q == 0 ? yre[e] : yim[e]) + vv[e] * skp);
                                    *(f32x4*)zp = (f32x4){z[0], z[1], z[2], z[3]}; *(f32x4*)(zp + 4) = (f32x4){z[4], z[5], z[6], z[7]};
                                } else {
                                    const f32x4 z0 = *(const f32x4*)zp, z1 = *(const f32x4*)(zp + 4);
                                    float z[8];
#pragma unroll
                                    for (int e = 0; e < 8; ++e) z[e] = gate[e] * ((q == 0 ? yre[e] : yim[e]) + (e < 4 ? z0[e & 3] : z1[e & 3]) * skp);
                                    u32x4 wv; wv.x = pk_bf16(z[0], z[1]); wv.y = pk_bf16(z[2], z[3]); wv.z = pk_bf16(z[4], z[5]); wv.w = pk_bf16(z[6], z[7]);
                                    if (!DRY) *(u32x4*)(pbT + ((size_t)(s * 1536 + ch) << 14) + n0) = wv;
                                }
                            }
                        }
                    }
                }
            }
            __syncthreads();
        }
    }
    __syncthreads();
}

__device__ void ztrans_phase(const bf16_t* pbT, bf16_t* cat, LAS unsigned char* lds) {
    const int tid = opaque_tid();
    LAS unsigned* tl = (LAS unsigned*)lds;
    LAS bf16_t* tb = (LAS bf16_t*)lds;
    for (int tile = blockIdx.x; tile < 6144; tile += gridDim.x) {
        const int tt0 = (tile & 255) * 64, ct = (tile >> 8) & 7, s = tile >> 11;
        __syncthreads();
        { const int cc = tid >> 3, tk = (tid & 7) * 8;
          const u32x4 v = *(const u32x4*)(pbT + ((size_t)(s * 1536 + ct * 64 + cc) << 14) + tt0 + tk);
#pragma unroll
          for (int q = 0; q < 4; ++q) tl[cc * 33 + (tk >> 1) + q] = v[q]; }
        __syncthreads();
        { const int tt = tid >> 3, cg8 = (tid & 7) * 8; bf16_t e[8];
#pragma unroll
          for (int i = 0; i < 8; ++i) e[i] = tb[(cg8 + i) * 66 + tt];
          u32x4 wv; wv.x = e[0] | ((unsigned)e[1] << 16); wv.y = e[2] | ((unsigned)e[3] << 16); wv.z = e[4] | ((unsigned)e[5] << 16); wv.w = e[6] | ((unsigned)e[7] << 16);
          *(u32x4*)(cat + (size_t)(s * L + tt0 + tt) * 1024 + 512 + ct * 64 + cg8) = wv; }
    }
    __syncthreads();
}

__device__ void attn_phase(const Args& a, const bf16_t* qkv, bf16_t* ao, LAS unsigned char* lds) {
    const int tid = opaque_tid(), lane = tid & 63, w = tid >> 6, l31 = lane & 31, hh = lane >> 5;
    LAS bf16_t* Ks = (LAS bf16_t*)lds;
    LAS bf16_t* VT = (LAS bf16_t*)(lds + 384 * 72 * 2);
    const float* sink = a.in[26];
    for (int item = blockIdx.x; item < 1536; item += gridDim.x) {
        const int kvh = item & 3, qb = (item >> 2) & 127, seq = item >> 9;
        const int kb0 = qb * 128 - 128;
        __syncthreads();
        for (int idx = tid; idx < 384 * 8; idx += 512) {
            const int key = idx % 384, dc = idx / 384, kpos = kb0 + key;
            u32x4 kv = (u32x4){0u, 0u, 0u, 0u}, vv = (u32x4){0u, 0u, 0u, 0u};
            if (kpos >= 0 && kpos < L) { const bf16_t* rp = qkv + (size_t)(seq * L + kpos) * 1536 + kvh * 64 + dc * 8; kv = *(const u32x4*)(rp + 1024); vv = *(const u32x4*)(rp + 1280); }
            *(LAS u32x4*)(Ks + key * 72 + dc * 8) = kv;
#pragma unroll
            for (int i = 0; i < 8; ++i) VT[(dc * 8 + i) * 392 + key] = (bf16_t)((vv[i >> 1] >> (16 * (i & 1))) & 0xffffu);
        }
        __syncthreads();
        for (int uu = 0; uu < 2; ++uu) {
            const int u = w + 8 * uu, g = u >> 2, qs = u & 3, h = kvh * 4 + g, q0 = qb * 128 + 32 * qs;
            bf16x8 qf[4];
            const bf16_t* qp = qkv + (size_t)(seq * L + q0 + l31) * 1536 + h * 64 + 8 * hh;
#pragma unroll
            for (int ks = 0; ks < 4; ++ks) qf[ks] = *(const bf16x8*)(qp + 16 * ks);
            const float slope = exp2f(-0.5f * (float)(h + 1));
            float m = sink[h], lsum = 1.0f;
            f32x16 O0, O1;
#pragma unroll
            for (int r = 0; r < 16; ++r) { O0[r] = 0.f; O1[r] = 0.f; }
#pragma unroll 1
            for (int kt = 0; kt < 9; ++kt) {
                const int kl0 = 32 * qs + 32 * kt;
                f32x16 S;
#pragma unroll
                for (int r = 0; r < 16; ++r) S[r] = 0.f;
#pragma unroll
                for (int ks = 0; ks < 4; ++ks) { const bf16x8 af = *(const LAS bf16x8*)(Ks + (kl0 + l31) * 72 + 16 * ks + 8 * hh); S = __builtin_amdgcn_mfma_f32_32x32x16_bf16(af, qf[ks], S, 0, 0, 0); }
                float p[16]; float mt = -1e30f;
#pragma unroll
                for (int r = 0; r < 16; ++r) {
                    const int i = 8 * (r >> 2) + 4 * hh + (r & 3);
                    const int dist = 32 * kt + i - l31 - 128, kpos = q0 - 128 + 32 * kt + i;
                    const int ad = dist < 0 ? -dist : dist;
                    const bool valid = (ad <= 128) && (kpos >= 0) && (kpos < L);
                    p[r] = valid ? (S[r] * 0.125f - slope * (float)ad) : -1e30f;
                    mt = fmaxf(mt, p[r]);
                }
                mt = fmaxf(mt, __shfl_xor(mt, 32));
                const float mnew = fmaxf(m, mt), alpha = __expf(m - mnew);
                float rs = 0.f;
#pragma unroll
                for (int r = 0; r < 16; ++r) { p[r] = __expf(p[r] - mnew); rs += p[r]; }
                rs += __shfl_xor(rs, 32);
                lsum = lsum * alpha + rs; m = mnew;
#pragma unroll
                for (int r = 0; r < 16; ++r) { O0[r] *= alpha; O1[r] *= alpha; }
#pragma unroll
                for (int kk = 0; kk < 2; ++kk) {
                    u32x4 pw; pw.x = pk_bf16(p[8 * kk], p[8 * kk + 1]); pw.y = pk_bf16(p[8 * kk + 2], p[8 * kk + 3]); pw.z = pk_bf16(p[8 * kk + 4], p[8 * kk + 5]); pw.w = pk_bf16(p[8 * kk + 6], p[8 * kk + 7]);
                    const bf16x8 pf = __builtin_bit_cast(bf16x8, pw);
#pragma unroll
                    for (int dt = 0; dt < 2; ++dt) {
                        const LAS bf16_t* vp = VT + (32 * dt + l31) * 392 + kl0 + 16 * kk + 4 * hh;
                        const u32x2 lo = *(const LAS u32x2*)vp, hi = *(const LAS u32x2*)(vp + 8);
                        const bf16x8 vf = __builtin_bit_cast(bf16x8, (u32x4){lo.x, lo.y, hi.x, hi.y});
                        if (dt == 0) O0 = __builtin_amdgcn_mfma_f32_32x32x16_bf16(vf, pf, O0, 0, 0, 0);
                        else O1 = __builtin_amdgcn_mfma_f32_32x32x16_bf16(vf, pf, O1, 0, 0, 0);
                    }
                }
            }
            const float inv = 1.0f / lsum;
            bf16_t* op = ao + (size_t)(seq * L + q0 + l31) * 1024 + h * 64 + 4 * hh;
#pragma unroll
            for (int b = 0; b < 4; ++b) {
                u32x2 o0; o0.x = pk_bf16(O0[4 * b] * inv, O0[4 * b + 1] * inv); o0.y = pk_bf16(O0[4 * b + 2] * inv, O0[4 * b + 3] * inv);
                u32x2 o1; o1.x = pk_bf16(O1[4 * b] * inv, O1[4 * b + 1] * inv); o1.y = pk_bf16(O1[4 * b + 2] * inv, O1[4 * b + 3] * inv);
                *(u32x2*)(op + 8 * b) = o0; *(u32x2*)(op + 32 + 8 * b) = o1;
            }
        }
    }
    __syncthreads();
}

__global__ void __launch_bounds__(512, 2) mega(Args a) {
    extern __shared__ __attribute__((aligned(16))) unsigned char lds_raw[];
    LAS unsigned char* lds = (LAS unsigned char*)lds_raw;
    unsigned char* ws = a.ws;
    const int lo = a.ph_lo, hi = a.ph_hi;
    float* X = a.out;
    const float* mod = (const float*)(ws + WS_MOD);
    bf16_t* H = (bf16_t*)(ws + WS_H);
    bf16_t* ACT = (bf16_t*)(ws + WS_ACT);
    bf16_t* PBT = ACT;
    bf16_t* PA = (bf16_t*)(ws + WS_ACT + PBT_BYTES);
    const int G = gridDim.x, bx = blockIdx.x;
    volatile LAS unsigned* bst = (volatile LAS unsigned*)(lds + LDS_BYTES - 16);
    if (threadIdx.x < 4) bst[threadIdx.x] = 0u;
    __syncthreads();
    const XcdBarrier xbar = xcd_barrier_post((unsigned*)(ws + WS_BAR), bst);
#define GSYNC() xcd_barrier(xbar)
#define IN(k) (lo <= (k) && (k) < hi)
#define SEAM(k) do { if (IN(k) && IN((k) + 1)) { GSYNC(); if ((RM >> 15) & 1) GSYNC(); } } while (0)
    int ph = 0;
    if (IN(0)) REP(0) { if (EN(0)) convert_weights(a, (LAS float*)lds); if (EN(1)) ada_phase(a, (LAS float*)lds); if (EN(2)) filter_phase(a, (LAS float*)lds); }
    if (IN(0) && IN(1)) cg::this_grid().sync();
    ph = 1;
#pragma unroll 1
    for (int layer = 0; layer < 2; ++layer) {
        const float* ml = mod + (size_t)layer * 3 * 9216;
        const float* ng = a.in[6] + layer * 3 * 1024;
#pragma unroll 1
        for (int sub = 0; sub < 3; ++sub) {
            const bool first = (layer == 0 && sub == 0);
            const float* xs0 = first ? a.in[0] : X; const float* xs1 = first ? a.in[1] : X + (size_t)32768 * 1024;
            const float* shp = ml + (3 * sub) * 1024; const float* scp = shp + 1024; const float* gp = shp + 2048;
            if (EN(3) && IN(ph)) REP(3) norm_phase(xs0, xs1, ng + sub * 1024, shp, scp, H);
            SEAM(ph); ++ph;
            if (sub != 1) {
                const int fi = layer * 2 + (sub == 2 ? 1 : 0);
                if (EN(4) && IN(ph)) REP(4) { pg8::Gemm g{H, (const bf16_t*)(ws + WS_WIN) + (size_t)fi * 5632 * 1024, T, 5632, 1024}; pg8::StaticOrder S; S.init(T, 5632, G, bx);
                    EpiSwiglu E{ACT}; pg8::gemm_phase<EpiSwiglu>(lds, g, S, E); }
                SEAM(ph); ++ph;
                if (EN(5) && IN(ph)) { pg8::Gemm g{ACT, (const bf16_t*)(ws + WS_WOUT) + (size_t)fi * 1024 * 2816, T, 1024, DFF}; pg8::StaticOrder S; S.init(T, 1024, G, bx);
                    EpiResid E{xs0, xs1, X, gp, 0.5f}; pg8::gemm_phase<EpiResid>(lds, g, S, E); }
                SEAM(ph); ++ph;
            } else if (layer == 0) {
                if (EN(6) && IN(ph)) REP(6) { pg8::Gemm g{H, (const bf16_t*)(ws + WS_WABIN), T, 2560, 1024}; pg8::StaticOrder S; S.init(T, 2560, G, bx);
                    EpiProj E{PA, PBT}; pg8::gemm_phase<EpiProj>(lds, g, S, E); }
                SEAM(ph); ++ph;
                if (IN(ph)) { if (EN(7)) REP(7) conva_phase(a, PA, H, lds); GSYNC(); if ((RM >> 8) & 1) fft_phase<true>(a, PBT, lds); if (EN(8)) fft_phase<false>(a, PBT, lds); }
                SEAM(ph); ++ph;
                if (EN(9) && IN(ph)) REP(9) ztrans_phase(PBT, H, lds);
                SEAM(ph); ++ph;
                if (EN(5) && IN(ph)) { pg8::Gemm g{H, (const bf16_t*)(ws + WS_WABOUT), T, 1024, 1024}; pg8::StaticOrder S; S.init(T, 1024, G, bx);
                    EpiResid E{xs0, xs1, X, gp, 1.0f}; pg8::gemm_phase<EpiResid>(lds, g, S, E); }
                SEAM(ph); ++ph;
            } else {
                if (EN(10) && IN(ph)) REP(10) { pg8::Gemm g{H, (const bf16_t*)(ws + WS_WQKV), T, 1536, 1024}; pg8::StaticOrder S; S.init(T, 1536, G, bx);
                    EpiBf16 E{ACT, 1536}; pg8::gemm_phase<EpiBf16>(lds, g, S, E); }
                SEAM(ph); ++ph;
                if (EN(11) && IN(ph)) REP(11) attn_phase(a, ACT, H, lds);
                SEAM(ph); ++ph;
                if (EN(5) && IN(ph)) { pg8::Gemm g{H, (const bf16_t*)(ws + WS_WATTO), T, 1024, 1024}; pg8::StaticOrder S; S.init(T, 1024, G, bx);
                    EpiResid E{xs0, xs1, X, gp, 1.0f}; pg8::gemm_phase<EpiResid>(lds, g, S, E); }
                SEAM(ph); ++ph;
            }
        }
    }
    if (EN(12) && IN(ph)) final_norm_phase(X, a.in[9]);
#undef IN
#undef SEAM
}

extern "C" void kernel_launch(void* const* d_in, const int* in_sizes, int n_in, void* d_out, int out_size, void* d_ws, size_t ws_size, hipStream_t stream) {
    static int grid = 0;
    if (grid == 0) {
        int dev = 0, cus = 0, per_cu = 0;
        (void)hipGetDevice(&dev);
        (void)hipDeviceGetAttribute(&cus, hipDeviceAttributeMultiprocessorCount, dev);
        (void)hipFuncSetAttribute((const void*)mega, hipFuncAttributeMaxDynamicSharedMemorySize, LDS_BYTES);
        (void)hipOccupancyMaxActiveBlocksPerMultiprocessor(&per_cu, (const void*)mega, 512, LDS_BYTES);
        if (per_cu < 1) per_cu = 1;
        grid = cus * per_cu;
        if (grid > 256) grid = 256;
        if (ws_size < WS_END) { fprintf(stderr, "workspace too small: %zu < %zu\n", ws_size, (size_t)WS_END); grid = -1; }
    }
    if (grid < 0) return;
    Args a{};
    for (int i = 0; i < 28; ++i) a.in[i] = (const float*)d_in[i];
    a.out = (float*)d_out; a.ws = (unsigned char*)d_ws;
    (void)hipMemsetAsync((unsigned char*)d_ws + WS_BAR, 0, XCD_BAR_WORDS * 4, stream);
#if N_LAUNCH_MODE == 1
    a.ph_lo = 0; a.ph_hi = NPH;
    void* args[] = {&a};
    hipError_t e = hipLaunchCooperativeKernel((const void*)mega, dim3(grid), dim3(512), args, LDS_BYTES, stream);
    if (e != hipSuccess) fprintf(stderr, "cooperative launch failed: %s (grid %d)\n", hipGetErrorString(e), grid);
#else
    for (int p = 0; p < NPH; ++p) { a.ph_lo = p; a.ph_hi = p + 1; hipLaunchKernelGGL(mega, dim3(grid), dim3(512), LDS_BYTES, stream, a); }
#endif
}
```

```cpp
#include <hip/hip_runtime.h>
#include <hip/hip_cooperative_groups.h>
#include <cstdio>
namespace cg = cooperative_groups;

#ifndef PM
#define PM 0xffff
#endif
#define EN(b) ((PM >> (b)) & 1)
#ifndef RM
#define RM 0
#endif
#define REP(b) for (int rep_ = 0; rep_ < 1 + ((RM >> (b)) & 1); ++rep_)
#ifndef N_LAUNCH_MODE
#define N_LAUNCH_MODE 1
#endif

#define LAS __attribute__((address_space(3)))
typedef unsigned short bf16_t;
typedef short bf16x8 __attribute__((ext_vector_type(8)));
typedef float f32x4 __attribute__((ext_vector_type(4)));
typedef float f32x16 __attribute__((ext_vector_type(16)));
typedef unsigned u32x4 __attribute__((ext_vector_type(4)));
typedef unsigned u32x2 __attribute__((ext_vector_type(2)));
typedef __bf16 bf16x2v __attribute__((ext_vector_type(2)));
typedef float f32x2v __attribute__((ext_vector_type(2)));
typedef _Float16 half_t;

constexpr int T = 49152, D = 1024, L = 16384, DFF = 2816, NPH = 23;
constexpr float EPS = 1e-6f;
constexpr int LDS_BYTES = 147456;

constexpr size_t WS_WIN = 0;
constexpr size_t WS_WOUT = WS_WIN + 4ull * 5632 * 1024 * 2;
constexpr size_t WS_WABIN = WS_WOUT + 4ull * 1024 * 2816 * 2;
constexpr size_t WS_WABOUT = WS_WABIN + 2560ull * 1024 * 2;
constexpr size_t WS_WQKV = WS_WABOUT + 1024ull * 1024 * 2;
constexpr size_t WS_WATTO = WS_WQKV + 1536ull * 1024 * 2;
constexpr size_t WS_MOD = WS_WATTO + 1024ull * 1024 * 2;
constexpr size_t WS_BAR = WS_MOD + 221184;
constexpr size_t WS_H = WS_MOD + 262144;
constexpr size_t WS_ACT = WS_H + (size_t)T * 1024 * 2;
constexpr size_t WS_KT = WS_ACT + (size_t)T * DFF * 2;
constexpr size_t WS_END = WS_KT + 2ull * 512 * 2 * L * 2;
constexpr size_t PBT_BYTES = 3ull * 1536 * L * 2;
constexpr size_t FFTSCR_PER_BLOCK = 2ull * L * 8 + 3ull * L * 4;

__device__ __forceinline__ unsigned pk_bf16(float a, float b) { f32x2v f = {a, b}; bf16x2v r = __builtin_convertvector(f, bf16x2v); return __builtin_bit_cast(unsigned, r); }
__device__ __forceinline__ float bf_lo(unsigned v) { return __uint_as_float(v << 16); }
__device__ __forceinline__ float bf_hi(unsigned v) { return __uint_as_float(v & 0xffff0000u); }
__device__ __forceinline__ float bf2f(bf16_t v) { return __uint_as_float((unsigned)v << 16); }
__device__ __forceinline__ bf16_t f2bf(float f) { return (bf16_t)(pk_bf16(f, 0.f) & 0xffffu); }
__device__ __forceinline__ float fsigmoid(float x) { return __builtin_amdgcn_rcpf(1.0f + __expf(-x)); }
__device__ __forceinline__ float hw_sin(float x) { return __builtin_amdgcn_sinf(x * 0.15915494309189535f); }

__device__ __forceinline__ int opaque_tid() { int t = threadIdx.x; asm volatile("" : "+v"(t)); return t; }

#define XB_TMO      128
#define XB_XCNT(j)  (256  + 64 * (j))
#define XB_XSUB(j)  (1280 + 64 * (j))
#define XB_XGEN(j)  (2304 + 64 * (j))
#define XB_TOP      3328
#define XB_TOPGEN   3392
#define XCD_BAR_WORDS 3456
#define XB_SPIN_CAP (1u << 22)
__device__ __forceinline__ unsigned xb_ld(unsigned* p)              { return __hip_atomic_load(p, __ATOMIC_RELAXED, __HIP_MEMORY_SCOPE_AGENT); }
__device__ __forceinline__ unsigned xb_add(unsigned* p, unsigned v) { return __hip_atomic_fetch_add(p, v, __ATOMIC_RELAXED, __HIP_MEMORY_SCOPE_AGENT); }
__device__ __forceinline__ unsigned xb_xcc_id() { return (unsigned)__builtin_amdgcn_s_getreg((3 << 11) | 20) & 0xFu; }
#define XB_SPIN(cond, bar) do { unsigned _sp = 0; while (cond) { __builtin_amdgcn_s_sleep(1); \
    if ((++_sp & 255u) == 0u) { if (xb_ld(&(bar)[XB_TMO])) break; if (_sp > XB_SPIN_CAP) { atomicAdd(&(bar)[XB_TMO], 1u); break; } } } } while (0)
struct XcdBarrier { unsigned* bar; unsigned x; volatile LAS unsigned* st; };
__device__ __forceinline__ XcdBarrier xcd_barrier_post(unsigned* bar, volatile LAS unsigned* st) {
    XcdBarrier b; b.bar = bar; b.x = xb_xcc_id(); b.st = st;
    if (threadIdx.x == 0) (void)xb_add(&bar[XB_XCNT(b.x)], 1u);
    return b;
}
__device__ __forceinline__ void xcd_barrier_complete(unsigned* bar, unsigned x, unsigned& nloc, unsigned& nx) {
    const unsigned G = gridDim.x * gridDim.y * gridDim.z;
    unsigned sum, cnt, mine, sp = 0u;
    for (;;) {
        sum = 0u; cnt = 0u; mine = 0u;
#pragma unroll
        for (unsigned j = 0; j < 16; ++j) { const unsigned c = xb_ld(&bar[XB_XCNT(j)]); sum += c; cnt += (c > 0u) ? 1u : 0u; mine = (j == x) ? c : mine; }
        if (sum == G) break;
        __builtin_amdgcn_s_sleep(1);
        if ((++sp & 255u) == 0u) { if (xb_ld(&bar[XB_TMO])) break; if (sp > XB_SPIN_CAP) { atomicAdd(&bar[XB_TMO], 1u); break; } }
    }
    nloc = mine > 0u ? mine : 1u; nx = cnt > 0u ? cnt : 1u;
}
__device__ __forceinline__ void xcd_barrier(const XcdBarrier& b) {
    asm volatile("s_waitcnt vmcnt(0)" ::: "memory");
    __syncthreads();
    if (threadIdx.x == 0) {
        unsigned* bar = b.bar;
        __builtin_amdgcn_s_waitcnt(0);
        unsigned nloc = b.st[0], nx = b.st[1];
        if (nloc == 0u) { xcd_barrier_complete(bar, b.x, nloc, nx); b.st[0] = nloc; b.st[1] = nx; }
        const unsigned old = xb_add(&bar[XB_XSUB(b.x)], 1u);
        const unsigned gen = old / nloc;
        if (old + 1u == (gen + 1u) * nloc) {
            __builtin_amdgcn_fence(__ATOMIC_RELEASE, "agent");
            asm volatile("s_waitcnt vmcnt(0)" ::: "memory");
            const unsigned og = xb_add(&bar[XB_TOP], 1u);
            const unsigned tg = og / nx;
            if (og + 1u == (tg + 1u) * nx) xb_add(&bar[XB_TOPGEN], 1u);
            else XB_SPIN(xb_ld(&bar[XB_TOPGEN]) == tg, bar);
            __builtin_amdgcn_fence(__ATOMIC_ACQUIRE, "agent");
            xb_add(&bar[XB_XGEN(b.x)], 1u);
            asm volatile("s_waitcnt vmcnt(0)" ::: "memory");
        } else {
            XB_SPIN(xb_ld(&bar[XB_XGEN(b.x)]) == gen, bar);
            __builtin_amdgcn_fence(__ATOMIC_ACQUIRE, "agent");
            asm volatile("s_waitcnt vmcnt(0)" ::: "memory");
        }
    }
    __syncthreads();
}

struct Args { const float* in[28]; float* out; unsigned char* ws; int ph_lo, ph_hi; };

namespace pg8 {
constexpr int BM = 256, BK = 64, HALF = 128, HTB = HALF * BK * 2, STAGE_BYTES = 8 * HTB, NXCD = 8, WGM = 8;
__device__ __forceinline__ int lds_byte(int r, int c) { const int st = (r >> 4) * 2 + (c >> 5), rr = r & 15, cc = c & 31, ob = rr * 64 + cc * 2; return st * 1024 + (ob ^ (((ob >> 9) & 1) << 5)); }
__device__ __forceinline__ void stage_rc(int b, int& R, int& C) { const int st = b / 1024, sb = b % 1024, swz = sb ^ (((sb >> 9) & 1) << 5); R = (st >> 1) * 16 + swz / 64; C = (st & 1) * 32 + (swz % 64) / 2; }
__device__ __forceinline__ int perm32(int rho) { const int n = rho >> 4, i = rho & 15; return 8 * (i >> 2) + 4 * n + (i & 3); }
struct Unit { int pm, pn; };
struct Gemm { const bf16_t* A; const bf16_t* Bt; int M, N, K; };
struct StaticOrder {
    int nM, nN, nwg, G, c;
    __device__ void init(int M, int N, int G_, int c_) { nM = M / BM; nN = N / BM; nwg = nM * nN; G = G_; c = c_; }
    __device__ bool next(int i, Unit& u) const {
        const long Lx = (long)i * G + c; if (Lx >= nwg) return false;
        int wgid = (int)Lx; { const int q = nwg / NXCD, r = nwg % NXCD, xcd = wgid % NXCD, off = wgid / NXCD; wgid = (xcd < r ? xcd * (q + 1) : r * (q + 1) + (xcd - r) * q) + off; }
        const int nig = WGM * nN, gid = wgid / nig, fm = gid * WGM, gsz = (nM - fm) < WGM ? (nM - fm) : WGM;
        u.pm = fm + ((wgid % nig) % gsz); u.pn = (wgid % nig) / gsz; return true;
    }
};

template <class Epi>
__device__ __forceinline__ void gemm_phase(LAS unsigned char* lds, const Gemm g, const StaticOrder& S, const Epi& E) {
    const int tid = opaque_tid(), wid = __builtin_amdgcn_readfirstlane(tid >> 6), lane = tid & 63, wr = wid >> 2, wc = wid & 3, fr = lane & 15, fq = lane >> 4;
    const int K = g.K, nt = K / BK;
    unsigned voffA[2], voffB[2];
#pragma unroll
    for (int i = 0; i < 2; ++i) { int R, C; stage_rc(tid * 16 + i * 8192, R, C); const int Rb = Epi::PERM ? ((R & ~31) + perm32(R & 31)) : R;
        voffA[i] = (unsigned)(R * K + C) * 2u; voffB[i] = (unsigned)(Rb * K + C) * 2u; }
    const size_t kstep = (size_t)(BK * 2);
    const size_t hstep = (size_t)HALF * K * 2;
    const size_t tstep = 2 * hstep;
    const unsigned ldsw = (unsigned)wid * 1024u;
    const int aoff = lds_byte(wr * 64 + fr, fq * 8), boff = lds_byte(wc * 32 + fr, fq * 8);
#define PG8_SA(b, h) (((b) * 2 + (h)) * HTB)
#define PG8_SB(b, h) ((4 + (b) * 2 + (h)) * HTB)
#define PG8_STAGE(bufoff, gbase, voff) do { _Pragma("unroll") for (int _i = 0; _i < 2; ++_i) \
        __builtin_amdgcn_global_load_lds((const unsigned*)((const char*)(gbase) + (voff)[_i]), (LAS unsigned*)(lds + (bufoff) + ldsw + _i * 8192), 16, 0, 0); } while (0)
#define PG8_LDA(dst, b, h) do { _Pragma("unroll") for (int m = 0; m < 4; ++m) _Pragma("unroll") for (int k = 0; k < 2; ++k) dst[m][k] = *(const LAS bf16x8*)(lds + PG8_SA(b, h) + aoff + m * 2048 + k * 1024); } while (0)
#define PG8_LDB(dst, b, h) do { _Pragma("unroll") for (int n = 0; n < 2; ++n) _Pragma("unroll") for (int k = 0; k < 2; ++k) dst[n][k] = *(const LAS bf16x8*)(lds + PG8_SB(b, h) + boff + n * 2048 + k * 1024); } while (0)
#define PG8_MMA(ai, bj, At, Bt) do { __builtin_amdgcn_s_setprio(1); _Pragma("unroll") for (int m = 0; m < 4; ++m) _Pragma("unroll") for (int n = 0; n < 2; ++n) _Pragma("unroll") for (int k = 0; k < 2; ++k) \
        acc[ai][bj][m][n] = __builtin_amdgcn_mfma_f32_16x16x32_bf16(Bt[n][k], At[m][k], acc[ai][bj][m][n], 0, 0, 0); __builtin_amdgcn_s_setprio(0); } while (0)
#define PG8_WAIT_V(n) asm volatile("s_waitcnt vmcnt(" #n ")" ::: "memory")
#define PG8_WAIT_L(n) asm volatile("s_waitcnt lgkmcnt(" #n ")" ::: "memory")
#define PG8_BAR __builtin_amdgcn_s_barrier()
#define PG8_SCHED __builtin_amdgcn_sched_barrier(0)
    Unit cur, nxt; int ui = 0;
    if (!S.next(0, cur)) return;
    f32x4 acc[2][2][4][2];
#pragma unroll
    for (int a = 0; a < 2; ++a)
#pragma unroll
        for (int b = 0; b < 2; ++b)
#pragma unroll
            for (int m = 0; m < 4; ++m)
#pragma unroll
                for (int n = 0; n < 2; ++n) acc[a][b][m][n] = (f32x4){0.f, 0.f, 0.f, 0.f};
    bf16x8 At[4][2], B0[2][2], B1[2][2];
    const char* cA = (const char*)g.A + (size_t)cur.pm * tstep; const char* cB = (const char*)g.Bt + (size_t)cur.pn * tstep;
    PG8_STAGE(PG8_SB(0, 0), cB, voffB); PG8_STAGE(PG8_SA(0, 0), cA, voffA); PG8_STAGE(PG8_SB(0, 1), cB + hstep, voffB); PG8_STAGE(PG8_SA(0, 1), cA + hstep, voffA);
    if (wr == 1) PG8_BAR;
    PG8_WAIT_V(4); PG8_BAR;
    PG8_STAGE(PG8_SB(1, 0), cB + kstep, voffB); PG8_STAGE(PG8_SA(1, 0), cA + kstep, voffA); PG8_STAGE(PG8_SB(1, 1), cB + hstep + kstep, voffB);
    PG8_WAIT_V(6); PG8_BAR;
    for (;;) {
        const bool has_next = S.next(ui + 1, nxt);
        const char* nA = has_next ? (const char*)g.A + (size_t)nxt.pm * tstep : cA; const char* nB = has_next ? (const char*)g.Bt + (size_t)nxt.pn * tstep : cB;
        for (int t = 0; t < nt; t += 2) {
            const bool last = (t == nt - 2);
            const char* a1 = cA + (size_t)(t + 1) * kstep;
            const char* a2 = last ? nA : cA + (size_t)(t + 2) * kstep; const char* b2 = last ? nB : cB + (size_t)(t + 2) * kstep;
            const char* a3 = a2 + kstep; const char* b3 = b2 + kstep;
            PG8_LDB(B0, 0, 0); PG8_SCHED; PG8_LDA(At, 0, 0); PG8_STAGE(PG8_SA(1, 1), a1 + hstep, voffA);
            PG8_WAIT_L(8); PG8_BAR; PG8_WAIT_L(0); PG8_MMA(0, 0, At, B0); PG8_BAR; PG8_SCHED;
            PG8_LDB(B1, 0, 1); PG8_STAGE(PG8_SB(0, 0), b2, voffB);
            PG8_BAR; PG8_WAIT_L(0); PG8_MMA(0, 1, At, B1); PG8_BAR;
            PG8_LDA(At, 0, 1); PG8_STAGE(PG8_SA(0, 0), a2, voffA);
            PG8_BAR; PG8_WAIT_L(0); PG8_MMA(1, 0, At, B0); PG8_BAR; PG8_SCHED;
            PG8_STAGE(PG8_SB(0, 1), b2 + hstep, voffB);
            PG8_WAIT_V(6); PG8_BAR; PG8_MMA(1, 1, At, B1); PG8_BAR;
            PG8_LDB(B0, 1, 0); PG8_SCHED; PG8_LDA(At, 1, 0); PG8_STAGE(PG8_SA(0, 1), a2 + hstep, voffA);
            PG8_WAIT_L(8); PG8_BAR; PG8_WAIT_L(0); PG8_MMA(0, 0, At, B0); PG8_BAR; PG8_SCHED;
            PG8_LDB(B1, 1, 1); PG8_STAGE(PG8_SB(1, 0), b3, voffB);
            PG8_BAR; PG8_WAIT_L(0); PG8_MMA(0, 1, At, B1); PG8_BAR;
            PG8_LDA(At, 1, 1); PG8_STAGE(PG8_SA(1, 0), a3, voffA);
            PG8_BAR; PG8_WAIT_L(0); PG8_MMA(1, 0, At, B0); PG8_BAR; PG8_SCHED;
            PG8_STAGE(PG8_SB(1, 1), b3 + hstep, voffB);
            PG8_WAIT_V(6); PG8_BAR; PG8_MMA(1, 1, At, B1); PG8_BAR;
        }
        E(acc, cur, wr, wc, fr, fq);
        if (!has_next) break;
#pragma unroll
        for (int a = 0; a < 2; ++a)
#pragma unroll
            for (int b = 0; b < 2; ++b)
#pragma unroll
                for (int m = 0; m < 4; ++m)
#pragma unroll
                    for (int n = 0; n < 2; ++n) acc[a][b][m][n] = (f32x4){0.f, 0.f, 0.f, 0.f};
        cur = nxt; cA = nA; cB = nB; ++ui;
    }
    PG8_WAIT_V(0);
    if (wr == 0) PG8_BAR;
    PG8_BAR;
#undef PG8_SA
#undef PG8_SB
#undef PG8_STAGE
#undef PG8_LDA
#undef PG8_LDB
#undef PG8_MMA
#undef PG8_WAIT_V
#undef PG8_WAIT_L
#undef PG8_BAR
#undef PG8_SCHED
}
}

struct EpiSwiglu {
    static constexpr bool PERM = true;
    bf16_t* O;
    __device__ __forceinline__ void operator()(const f32x4 (&acc)[2][2][4][2], const pg8::Unit& u, int wr, int wc, int fr, int fq) const {
        const int row0 = u.pm * 256 + wr * 64 + fr, col0 = u.pn * 128 + wc * 32 + 8 * fq;
#pragma unroll
        for (int ai = 0; ai < 2; ++ai)
#pragma unroll
            for (int m = 0; m < 4; ++m) {
                bf16_t* rowp = O + (size_t)(row0 + ai * 128 + m * 16) * DFF + col0;
                float v[8];
#pragma unroll
                for (int n = 0; n < 2; ++n)
#pragma unroll
                    for (int j = 0; j < 4; ++j) { const float gg = acc[ai][0][m][n][j], uu = acc[ai][1][m][n][j]; v[n * 4 + j] = gg * fsigmoid(gg) * uu; }
                u32x4 w; w.x = pk_bf16(v[0], v[1]); w.y = pk_bf16(v[2], v[3]); w.z = pk_bf16(v[4], v[5]); w.w = pk_bf16(v[6], v[7]);
                *(u32x4*)rowp = w;
            }
    }
};
struct EpiBf16 {
    static constexpr bool PERM = true;
    bf16_t* O; int ldc;
    __device__ __forceinline__ void operator()(const f32x4 (&acc)[2][2][4][2], const pg8::Unit& u, int wr, int wc, int fr, int fq) const {
        const int row0 = u.pm * 256 + wr * 64 + fr, col0 = u.pn * 256 + wc * 32 + 8 * fq;
#pragma unroll
        for (int ai = 0; ai < 2; ++ai)
#pragma unroll
            for (int m = 0; m < 4; ++m) {
                bf16_t* rowp = O + (size_t)(row0 + ai * 128 + m * 16) * ldc + col0;
#pragma unroll
                for (int bj = 0; bj < 2; ++bj) {
                    const f32x4 v0 = acc[ai][bj][m][0], v1 = acc[ai][bj][m][1];
                    u32x4 w; w.x = pk_bf16(v0[0], v0[1]); w.y = pk_bf16(v0[2], v0[3]); w.z = pk_bf16(v1[0], v1[1]); w.w = pk_bf16(v1[2], v1[3]);
                    *(u32x4*)(rowp + bj * 128) = w;
                }
            }
    }
};
struct EpiProj {
    static constexpr bool PERM = true;
    bf16_t* Oa; bf16_t* ObT;
    __device__ __forceinline__ void operator()(const f32x4 (&acc)[2][2][4][2], const pg8::Unit& u, int wr, int wc, int fr, int fq) const {
        const int row0 = u.pm * 256 + wr * 64 + fr;
        if (u.pn < 4) {
            const int col0 = u.pn * 256 + wc * 32 + 8 * fq;
#pragma unroll
            for (int ai = 0; ai < 2; ++ai)
#pragma unroll
                for (int m = 0; m < 4; ++m) {
                    bf16_t* rowp = Oa + (size_t)(row0 + ai * 128 + m * 16) * 1024 + col0;
#pragma unroll
                    for (int bj = 0; bj < 2; ++bj) {
                        const f32x4 v0 = acc[ai][bj][m][0], v1 = acc[ai][bj][m][1];
                        u32x4 w; w.x = pk_bf16(v0[0], v0[1]); w.y = pk_bf16(v0[2], v0[3]); w.z = pk_bf16(v1[0], v1[1]); w.w = pk_bf16(v1[2], v1[3]);
                        *(u32x4*)(rowp + bj * 128) = w;
                    }
                }
        } else {
            const int seq = (u.pm * 256) >> 14;
            const int c0 = (u.pn - 4) * 256 + wc * 32 + 8 * fq;
#pragma unroll
            for (int ai = 0; ai < 2; ++ai)
#pragma unroll
                for (int m = 0; m < 4; ++m) {
                    const int nn = (row0 + ai * 128 + m * 16) & (L - 1);
#pragma unroll
                    for (int bj = 0; bj < 2; ++bj)
#pragma unroll
                        for (int n = 0; n < 2; ++n)
#pragma unroll
                            for (int j = 0; j < 4; ++j)
                                ObT[((size_t)(seq * 1536 + c0 + bj * 128 + 4 * n + j) << 14) + nn] = f2bf(acc[ai][bj][m][n][j]);
                }
        }
    }
};
template <bool SRC_F32> struct EpiResid {
    static constexpr bool PERM = true;
    const float* xs0; const float* xs1; const bf16_t* xbs; bf16_t* xbo; const float* gate; float scale;
    __device__ __forceinline__ void operator()(const f32x4 (&acc)[2][2][4][2], const pg8::Unit& u, int wr, int wc, int fr, int fq) const {
        const int row0 = u.pm * 256 + wr * 64 + fr, col0 = u.pn * 256 + wc * 32 + 8 * fq;
        const int seq = (u.pm * 256) >> 14;
        const float* gb = gate + seq * 9216 + col0;
        const float* sf = (seq < 2 ? xs0 + (size_t)row0 * 1024 : xs1 + (size_t)(row0 - 32768) * 1024) + col0;
        const size_t ob = (size_t)row0 * 1024 + col0;
#pragma unroll
        for (int bj = 0; bj < 2; ++bj) {
            const f32x4 g0 = *(const f32x4*)(gb + bj * 128) * scale, g1 = *(const f32x4*)(gb + bj * 128 + 4) * scale;
#pragma unroll
            for (int ai = 0; ai < 2; ++ai)
#pragma unroll
                for (int m = 0; m < 4; ++m) {
                    const size_t off = (size_t)(ai * 128 + m * 16) * 1024 + bj * 128;
                    f32x4 x0, x1;
                    if (SRC_F32) { x0 = *(const f32x4*)(sf + off); x1 = *(const f32x4*)(sf + off + 4); }
                    else { const u32x4 q = *(const u32x4*)(xbs + ob + off); x0 = (f32x4){bf_lo(q.x), bf_hi(q.x), bf_lo(q.y), bf_hi(q.y)}; x1 = (f32x4){bf_lo(q.z), bf_hi(q.z), bf_lo(q.w), bf_hi(q.w)}; }
                    const f32x4 y0 = x0 + g0 * acc[ai][bj][m][0], y1 = x1 + g1 * acc[ai][bj][m][1];
                    u32x4 w; w.x = pk_bf16(y0[0], y0[1]); w.y = pk_bf16(y0[2], y0[3]); w.z = pk_bf16(y1[0], y1[1]); w.w = pk_bf16(y1[2], y1[3]);
                    *(u32x4*)(xbo + ob + off) = w;
                }
        }
    }
};

__device__ void convert_weights(const Args& a, LAS float* tile) {
    const int tid = opaque_tid();
    unsigned char* ws = a.ws;
    for (int ti = blockIdx.x; ti < 9984; ti += gridDim.x) {
        const float* src; bf16_t* dst; int K, N, mode = 0, lt;
        if (ti < 5632) { const int mi = ti / 1408; lt = ti % 1408; src = a.in[7] + (size_t)mi * 1024 * 5632; dst = (bf16_t*)(ws + WS_WIN) + (size_t)mi * 5632 * 1024; K = 1024; N = 5632; mode = 1; }
        else if (ti < 8448) { const int mi = (ti - 5632) / 704; lt = (ti - 5632) % 704; src = a.in[8] + (size_t)mi * 2816 * 1024; dst = (bf16_t*)(ws + WS_WOUT) + (size_t)mi * 1024 * 2816; K = 2816; N = 1024; }
        else if (ti < 9088) { lt = ti - 8448; src = a.in[10]; dst = (bf16_t*)(ws + WS_WABIN); K = 1024; N = 2560; }
        else if (ti < 9344) { lt = ti - 9088; src = a.in[24]; dst = (bf16_t*)(ws + WS_WABOUT); K = 1024; N = 1024; }
        else if (ti < 9728) { lt = ti - 9344; src = a.in[25]; dst = (bf16_t*)(ws + WS_WQKV); K = 1024; N = 1536; }
        else { lt = ti - 9728; src = a.in[27]; dst = (bf16_t*)(ws + WS_WATTO); K = 1024; N = 1024; }
        const int nkt = K / 64;
        const int kt = lt % nkt, ntp = lt / nkt;
        const int k0 = kt * 64, np0 = ntp * 64;
        int n0 = np0;
        if (mode == 1) { const int pn = np0 >> 8, bj = (np0 >> 7) & 1, c0 = np0 & 127; n0 = bj * DFF + 128 * pn + c0; }
        __syncthreads();
#pragma unroll
        for (int i = 0; i < 8; ++i) { const int k = (tid >> 6) + 8 * i, n = tid & 63; tile[k * 65 + n] = src[(size_t)(k0 + k) * N + n0 + n]; }
        __syncthreads();
        const int nn = tid >> 3, kk = (tid & 7) * 8;
        float v[8];
#pragma unroll
        for (int j = 0; j < 8; ++j) v[j] = tile[(kk + j) * 65 + nn];
        u32x4 w; w.x = pk_bf16(v[0], v[1]); w.y = pk_bf16(v[2], v[3]); w.z = pk_bf16(v[4], v[5]); w.w = pk_bf16(v[6], v[7]);
        *(u32x4*)(dst + (size_t)(np0 + nn) * K + k0 + kk) = w;
    }
    __syncthreads();
}

__device__ void ada_phase(const Args& a, LAS float* lf) {
    const int tid = opaque_tid(), lane = tid & 63, w = tid >> 6;
    LAS float* cs = lf; LAS float* red = lf + 3072;
    float* mod = (float*)(a.ws + WS_MOD);
    __syncthreads();
    for (int i = tid; i < 3072; i += 512) { const int s = i >> 10, k = i & 1023; const float c = s < 2 ? a.in[2][s * 1024 + k] : a.in[3][k]; cs[i] = c * fsigmoid(c); }
    __syncthreads();
    for (int item = blockIdx.x; item < 288; item += gridDim.x) {
        const int layer = item / 144, cgp = item % 144, col = cgp * 64 + lane;
        const float* W = a.in[4] + (size_t)layer * 1024 * 9216 + col;
        float a0 = 0.f, a1 = 0.f, a2 = 0.f;
#pragma unroll 8
        for (int k = w * 128; k < w * 128 + 128; ++k) { const float wv = W[(size_t)k * 9216]; a0 += cs[k] * wv; a1 += cs[1024 + k] * wv; a2 += cs[2048 + k] * wv; }
        red[(w * 3 + 0) * 64 + lane] = a0; red[(w * 3 + 1) * 64 + lane] = a1; red[(w * 3 + 2) * 64 + lane] = a2;
        __syncthreads();
        if (tid < 192) { const int s = tid >> 6; float sum = 0.f;
#pragma unroll
            for (int ww = 0; ww < 8; ++ww) sum += red[(ww * 3 + s) * 64 + lane];
            mod[(size_t)(layer * 3 + s) * 9216 + cgp * 64 + lane] = sum + a.in[5][layer * 9216 + cgp * 64 + lane]; }
        __syncthreads();
    }
}

__device__ void filter_phase(const Args& a, LAS float* lf) {
    const int tid = opaque_tid();
    LAS float* feats = lf;
    LAS float* h1 = lf + 64 * 33;
    LAS float* h2T = h1 + 64 * 65;
    const float* w1 = a.in[17]; const float* b1 = a.in[18]; const float* w2 = a.in[19]; const float* b2 = a.in[20]; const float* w3 = a.in[21]; const float* fr = a.in[22];
    half_t* KT = (half_t*)(a.ws + WS_KT);
    for (int item = blockIdx.x; item < 256; item += gridDim.x) {
        const int p0 = item * 64;
        __syncthreads();
        for (int idx = tid; idx < 64 * 33; idx += 512) {
            const int pos = idx / 33, f = idx % 33, n = p0 + pos; float v;
            if (f == 0) v = (float)n / (float)(L - 1);
            else { const int b = (f - 1) & 15; const double band = 1e-4 + (double)b * ((15.0 - 1e-4) / 15.0); double rev = (double)n * band / (double)L; rev -= floor(rev);
                   v = (f <= 16) ? __builtin_amdgcn_cosf((float)rev) : -__builtin_amdgcn_sinf((float)rev); }
            feats[idx] = v;
        }
        __syncthreads();
        { const int pos = tid >> 3, j0 = (tid & 7) * 8; float acc[8];
#pragma unroll
          for (int j = 0; j < 8; ++j) acc[j] = b1[j0 + j];
#pragma unroll 3
          for (int f = 0; f < 33; ++f) { const float x = feats[pos * 33 + f];
#pragma unroll
              for (int j = 0; j < 8; ++j) acc[j] += x * w1[f * 64 + j0 + j]; }
#pragma unroll
          for (int j = 0; j < 8; ++j) h1[pos * 65 + j0 + j] = hw_sin(fr[j0 + j] * acc[j]); }
        __syncthreads();
        { const int pos = tid >> 3, j0 = (tid & 7) * 8; float acc[8];
#pragma unroll
          for (int j = 0; j < 8; ++j) acc[j] = b2[j0 + j];
#pragma unroll 4
          for (int i = 0; i < 64; ++i) { const float x = h1[pos * 65 + i];
#pragma unroll
              for (int j = 0; j < 8; ++j) acc[j] += x * w2[i * 64 + j0 + j]; }
#pragma unroll
          for (int j = 0; j < 8; ++j) h2T[(j0 + j) * 64 + pos] = hw_sin(fr[j0 + j] * acc[j]); }
        __syncthreads();
        const int col0 = tid * 4;
        const int dir = col0 >> 10, ord = (col0 >> 9) & 1, ch0 = col0 & 511;
#pragma unroll 1
        for (int chunk = 0; chunk < 4; ++chunk) {
            float acc[16][4];
#pragma unroll
            for (int p = 0; p < 16; ++p)
#pragma unroll
                for (int c = 0; c < 4; ++c) acc[p][c] = 0.f;
#pragma unroll 2
            for (int j = 0; j < 64; ++j) {
                const f32x4 wv = *(const f32x4*)(w3 + j * 2048 + col0);
                f32x4 hv[4];
#pragma unroll
                for (int q = 0; q < 4; ++q) hv[q] = *(const LAS f32x4*)(h2T + j * 64 + chunk * 16 + q * 4);
#pragma unroll
                for (int p = 0; p < 16; ++p)
#pragma unroll
                    for (int c = 0; c < 4; ++c) acc[p][c] += hv[p >> 2][p & 3] * wv[c];
            }
#pragma unroll
            for (int c = 0; c < 4; ++c) {
                const int ch = ch0 + c;
                const float delta = 3.0701134573253945f + (float)ch * (12.280453829301578f / 511.0f);
                half_t* dstp = KT + ((size_t)((ord * 512 + ch) * 2 + dir) << 14) + p0 + chunk * 16;
                unsigned pk[8];
#pragma unroll
                for (int p = 0; p < 16; p += 2) {
                    const float t0 = (float)(p0 + chunk * 16 + p) / (float)(L - 1), t1 = (float)(p0 + chunk * 16 + p + 1) / (float)(L - 1);
                    const half_t x0 = (half_t)(acc[p][c] * __expf(-t0 * delta)), x1 = (half_t)(acc[p + 1][c] * __expf(-t1 * delta));
                    pk[p >> 1] = (unsigned)__builtin_bit_cast(unsigned short, x0) | ((unsigned)__builtin_bit_cast(unsigned short, x1) << 16);
                }
                *(u32x4*)dstp = (u32x4){pk[0], pk[1], pk[2], pk[3]};
                *(u32x4*)(dstp + 8) = (u32x4){pk[4], pk[5], pk[6], pk[7]};
            }
        }
    }
    __syncthreads();
}

template <bool SRC_F32> __device__ void norm_phase(const float* xs0, const float* xs1, const bf16_t* xb, const float* g, const float* sh, const float* sc, bf16_t* h) {
    const int tid_ = opaque_tid(); const int lane = tid_ & 63, w = tid_ >> 6;
    f32x4 gg[2][2];
#pragma unroll
    for (int i = 0; i < 2; ++i) { gg[i][0] = *(const f32x4*)(g + i * 512 + lane * 8); gg[i][1] = *(const f32x4*)(g + i * 512 + lane * 8 + 4); }
    for (int row = blockIdx.x * 8 + w; row < T; row += gridDim.x * 8) {
        const int seq = row >> 14;
        f32x4 v[2][2]; float ss = 0.f;
        if (SRC_F32) {
            const float* xr = seq < 2 ? xs0 + (size_t)row * 1024 : xs1 + (size_t)(row - 32768) * 1024;
#pragma unroll
            for (int i = 0; i < 2; ++i) { v[i][0] = *(const f32x4*)(xr + i * 512 + lane * 8); v[i][1] = *(const f32x4*)(xr + i * 512 + lane * 8 + 4); }
        } else {
#pragma unroll
            for (int i = 0; i < 2; ++i) { const u32x4 q = *(const u32x4*)(xb + (size_t)row * 1024 + i * 512 + lane * 8);
                v[i][0] = (f32x4){bf_lo(q.x), bf_hi(q.x), bf_lo(q.y), bf_hi(q.y)}; v[i][1] = (f32x4){bf_lo(q.z), bf_hi(q.z), bf_lo(q.w), bf_hi(q.w)}; }
        }
#pragma unroll
        for (int i = 0; i < 2; ++i)
#pragma unroll
            for (int k = 0; k < 2; ++k) ss += v[i][k][0] * v[i][k][0] + v[i][k][1] * v[i][k][1] + v[i][k][2] * v[i][k][2] + v[i][k][3] * v[i][k][3];
#pragma unroll
        for (int o = 32; o > 0; o >>= 1) ss += __shfl_xor(ss, o);
        const float rstd = rsqrtf(ss * (1.0f / 1024.0f) + EPS);
#pragma unroll
        for (int i = 0; i < 2; ++i) {
            const int col = i * 512 + lane * 8;
            f32x4 y[2];
#pragma unroll
            for (int k = 0; k < 2; ++k) { const f32x4 s1 = *(const f32x4*)(sc + seq * 9216 + col + 4 * k), s0 = *(const f32x4*)(sh + seq * 9216 + col + 4 * k); y[k] = v[i][k] * rstd * gg[i][k] * (s1 + 1.0f) + s0; }
            u32x4 o; o.x = pk_bf16(y[0][0], y[0][1]); o.y = pk_bf16(y[0][2], y[0][3]); o.z = pk_bf16(y[1][0], y[1][1]); o.w = pk_bf16(y[1][2], y[1][3]);
            *(u32x4*)(h + (size_t)row * 1024 + col) = o;
        }
    }
}
__device__ void final_norm_phase(const bf16_t* xb, float* out, const float* g) {
    const int tid_ = opaque_tid(); const int lane = tid_ & 63, w = tid_ >> 6;
    f32x4 gg[2][2];
#pragma unroll
    for (int i = 0; i < 2; ++i) { gg[i][0] = *(const f32x4*)(g + i * 512 + lane * 8); gg[i][1] = *(const f32x4*)(g + i * 512 + lane * 8 + 4); }
    for (int row = blockIdx.x * 8 + w; row < T; row += gridDim.x * 8) {
        f32x4 v[2][2]; float ss = 0.f;
#pragma unroll
        for (int i = 0; i < 2; ++i) { const u32x4 q = *(const u32x4*)(xb + (size_t)row * 1024 + i * 512 + lane * 8);
            v[i][0] = (f32x4){bf_lo(q.x), bf_hi(q.x), bf_lo(q.y), bf_hi(q.y)}; v[i][1] = (f32x4){bf_lo(q.z), bf_hi(q.z), bf_lo(q.w), bf_hi(q.w)}; }
#pragma unroll
        for (int i = 0; i < 2; ++i)
#pragma unroll
            for (int k = 0; k < 2; ++k) ss += v[i][k][0] * v[i][k][0] + v[i][k][1] * v[i][k][1] + v[i][k][2] * v[i][k][2] + v[i][k][3] * v[i][k][3];
#pragma unroll
        for (int o = 32; o > 0; o >>= 1) ss += __shfl_xor(ss, o);
        const float rstd = rsqrtf(ss * (1.0f / 1024.0f) + EPS);
#pragma unroll
        for (int i = 0; i < 2; ++i)
#pragma unroll
            for (int k = 0; k < 2; ++k) *(f32x4*)(out + (size_t)row * 1024 + i * 512 + lane * 8 + 4 * k) = v[i][k] * rstd * gg[i][k];
    }
}

__device__ void conva_phase(const Args& a, const bf16_t* pa, bf16_t* cat, LAS unsigned char* lds) {
    const int tid = opaque_tid(), lane = tid & 63, w = tid >> 6;
    LAS bf16_t* glu = (LAS bf16_t*)lds;
    LAS float* stage = (LAS float*)(lds + 94 * 512 * 2);
    const float* cw = a.in[11]; const float* cb = a.in[12]; const float* lg = a.in[13]; const float* lb = a.in[14];
    float wt[31];
#pragma unroll
    for (int j = 0; j < 31; ++j) wt[j] = cw[j * 512 + tid];
    const float bias = cb[tid];
    float lgv[8], lbv[8];
#pragma unroll
    for (int i = 0; i < 8; ++i) { lgv[i] = lg[lane + 64 * i]; lbv[i] = lb[lane + 64 * i]; }
    for (int tile = blockIdx.x; tile < 768; tile += gridDim.x) {
        const int seq = tile >> 8, t0 = (tile & 255) * 64;
        __syncthreads();
        for (int idx = tid; idx < 94 * 64; idx += 512) {
            const int r = idx >> 6, cc = idx & 63, t = t0 - 15 + r;
            u32x4 res = (u32x4){0u, 0u, 0u, 0u};
            if (t >= 0 && t < L) {
                const bf16_t* rp = pa + (size_t)(seq * L + t) * 1024 + cc * 8;
                const u32x4 x1 = *(const u32x4*)rp, x2 = *(const u32x4*)(rp + 512);
#pragma unroll
                for (int q = 0; q < 4; ++q) res[q] = pk_bf16(bf_lo(x1[q]) * fsigmoid(bf_lo(x2[q])), bf_hi(x1[q]) * fsigmoid(bf_hi(x2[q])));
            }
            *(LAS u32x4*)(glu + r * 512 + cc * 8) = res;
        }
        __syncthreads();
        for (int chunk = 0; chunk < 8; ++chunk) {
            float o[8];
#pragma unroll
            for (int tt = 0; tt < 8; ++tt) o[tt] = bias;
#pragma unroll
            for (int i = 0; i < 38; ++i) {
                const float x = bf2f(glu[(chunk * 8 + i) * 512 + tid]);
#pragma unroll
                for (int tt = 0; tt < 8; ++tt) { const int j = i - tt; if (j >= 0 && j < 31) o[tt] += wt[j] * x; }
            }
#pragma unroll
            for (int tt = 0; tt < 8; ++tt) stage[tt * 512 + tid] = o[tt];
            __syncthreads();
            {
                float v[8]; float s = 0.f;
#pragma unroll
                for (int i = 0; i < 8; ++i) { v[i] = stage[w * 512 + lane + 64 * i]; s += v[i]; }
#pragma unroll
                for (int of = 32; of > 0; of >>= 1) s += __shfl_xor(s, of);
                const float mean = s * (1.0f / 512.0f);
                float q = 0.f;
#pragma unroll
                for (int i = 0; i < 8; ++i) { const float d = v[i] - mean; q += d * d; }
#pragma unroll
                for (int of = 32; of > 0; of >>= 1) q += __shfl_xor(q, of);
                const float rstd = rsqrtf(q * (1.0f / 512.0f) + EPS);
                bf16_t* op = cat + (size_t)(seq * L + t0 + chunk * 8 + w) * 1024;
#pragma unroll
                for (int i = 0; i < 8; ++i) { const float y = (v[i] - mean) * rstd * lgv[i] + lbv[i]; op[lane + 64 * i] = f2bf(y * fsigmoid(y)); }
            }
            __syncthreads();
        }
    }
    __syncthreads();
}

typedef float v2 __attribute__((ext_vector_type(2)));
__device__ __forceinline__ int fphys(int i) { return i + ((i >> 6) << 2); }
struct C2 { v2 r, i; };
__device__ __forceinline__ C2 cmul2(const C2& a, const C2& b) { C2 o; o.r = a.r * b.r - a.i * b.i; o.i = a.r * b.i + a.i * b.r; return o; }
__device__ __forceinline__ C2 cmulc(const C2& a, float cr, float ci) { C2 o; o.r = a.r * cr - a.i * ci; o.i = a.r * ci + a.i * cr; return o; }
template <bool INV> __device__ __forceinline__ void bf4(C2& a, C2& b, C2& c, C2& d) {
    C2 t0, t1, t2, e, t3;
    t0.r = a.r + c.r; t0.i = a.i + c.i; t1.r = a.r - c.r; t1.i = a.i - c.i; t2.r = b.r + d.r; t2.i = b.i + d.i; e.r = b.r - d.r; e.i = b.i - d.i;
    if (INV) { t3.r = -e.i; t3.i = e.r; } else { t3.r = e.i; t3.i = -e.r; }
    a.r = t0.r + t2.r; a.i = t0.i + t2.i; b.r = t1.r + t3.r; b.i = t1.i + t3.i; c.r = t0.r - t2.r; c.i = t0.i - t2.i; d.r = t1.r - t3.r; d.i = t1.i - t3.i;
}
template <bool INV, int K16> __device__ __forceinline__ C2 mulc16(const C2& a) {
    constexpr float cs[10] = {1.0f, 0.92387953251128674f, 0.70710678118654752f, 0.38268343236508977f, 0.0f, -0.38268343236508977f, -0.70710678118654752f, -0.92387953251128674f, -1.0f, -0.92387953251128674f};
    constexpr float sn[10] = {0.0f, 0.38268343236508977f, 0.70710678118654752f, 0.92387953251128674f, 1.0f, 0.92387953251128674f, 0.70710678118654752f, 0.38268343236508977f, 0.0f, -0.38268343236508977f};
    if (K16 == 4) { C2 o; if (INV) { o.r = -a.i; o.i = a.r; } else { o.r = a.i; o.i = -a.r; } return o; }
    return cmulc(a, cs[K16], INV ? sn[K16] : -sn[K16]);
}
template <bool INV, int LOGQ> __device__ __forceinline__ void r16_pass(LAS float* Fre, LAS float* Fim, int tid) {
    constexpr int Q = 1 << LOGQ;
    constexpr int PSTR = (Q >= 64) ? (Q + (Q >> 4)) : Q;
    const int b0 = 2 * tid, pos0 = b0 & (Q - 1), grp = b0 >> LOGQ, base = (grp << (LOGQ + 4)) + pos0;
    const int p = fphys(base);
    C2 x[16];
#pragma unroll
    for (int r = 0; r < 16; ++r) { x[r].r = *(const LAS v2*)(Fre + p + r * PSTR); x[r].i = *(const LAS v2*)(Fim + p + r * PSTR); }
    int posv = pos0; asm volatile("" : "+v"(posv));
    const float rev0 = (float)posv * (1.0f / (float)(16 * Q)), rev1 = (float)(posv + 1) * (1.0f / (float)(16 * Q));
    C2 w1; w1.r = (v2){__builtin_amdgcn_cosf(rev0), __builtin_amdgcn_cosf(rev1)};
    { const v2 sn = (v2){__builtin_amdgcn_sinf(rev0), __builtin_amdgcn_sinf(rev1)}; w1.i = INV ? sn : -sn; }
    const C2 w2 = cmul2(w1, w1), w3 = cmul2(w2, w1), w4 = cmul2(w2, w2), w8 = cmul2(w4, w4), w12 = cmul2(w8, w4);
    if (!INV) {
#pragma unroll
        for (int j = 0; j < 4; ++j) {
            bf4<false>(x[j], x[j + 4], x[j + 8], x[j + 12]);
            x[j + 4] = cmul2(x[j + 4], w1); x[j + 8] = cmul2(x[j + 8], w2); x[j + 12] = cmul2(x[j + 12], w3);
        }
        x[5] = mulc16<false, 1>(x[5]); x[9] = mulc16<false, 2>(x[9]); x[13] = mulc16<false, 3>(x[13]);
        x[6] = mulc16<false, 2>(x[6]); x[10] = mulc16<false, 4>(x[10]); x[14] = mulc16<false, 6>(x[14]);
        x[7] = mulc16<false, 3>(x[7]); x[11] = mulc16<false, 6>(x[11]); x[15] = mulc16<false, 9>(x[15]);
#pragma unroll
        for (int r = 0; r < 4; ++r) {
            bf4<false>(x[4 * r], x[4 * r + 1], x[4 * r + 2], x[4 * r + 3]);
            x[4 * r + 1] = cmul2(x[4 * r + 1], w4); x[4 * r + 2] = cmul2(x[4 * r + 2], w8); x[4 * r + 3] = cmul2(x[4 * r + 3], w12);
        }
    } else {
#pragma unroll
        for (int r = 0; r < 4; ++r) {
            x[4 * r + 1] = cmul2(x[4 * r + 1], w4); x[4 * r + 2] = cmul2(x[4 * r + 2], w8); x[4 * r + 3] = cmul2(x[4 * r + 3], w12);
            bf4<true>(x[4 * r], x[4 * r + 1], x[4 * r + 2], x[4 * r + 3]);
        }
        x[5] = mulc16<true, 1>(x[5]); x[9] = mulc16<true, 2>(x[9]); x[13] = mulc16<true, 3>(x[13]);
        x[6] = mulc16<true, 2>(x[6]); x[10] = mulc16<true, 4>(x[10]); x[14] = mulc16<true, 6>(x[14]);
        x[7] = mulc16<true, 3>(x[7]); x[11] = mulc16<true, 6>(x[11]); x[15] = mulc16<true, 9>(x[15]);
#pragma unroll
        for (int j = 0; j < 4; ++j) {
            x[j + 4] = cmul2(x[j + 4], w1); x[j + 8] = cmul2(x[j + 8], w2); x[j + 12] = cmul2(x[j + 12], w3);
            bf4<true>(x[j], x[j + 4], x[j + 8], x[j + 12]);
        }
    }
#pragma unroll
    for (int r = 0; r < 16; ++r) { *(LAS v2*)(Fre + p + r * PSTR) = x[r].r; *(LAS v2*)(Fim + p + r * PSTR) = x[r].i; }
}
template <bool INV> __device__ __forceinline__ void r4_pass(LAS float* Fre, LAS float* Fim, int tid) {
#pragma unroll 2
    for (int bi = 0; bi < 4; ++bi) {
        const int p = fphys(8 * (tid + 512 * bi));
        const f32x4 ra = *(const LAS f32x4*)(Fre + p), rb = *(const LAS f32x4*)(Fre + p + 4), ia = *(const LAS f32x4*)(Fim + p), ib = *(const LAS f32x4*)(Fim + p + 4);
        C2 x0, x1, x2, x3;
        x0.r = (v2){ra[0], rb[0]}; x1.r = (v2){ra[1], rb[1]}; x2.r = (v2){ra[2], rb[2]}; x3.r = (v2){ra[3], rb[3]};
        x0.i = (v2){ia[0], ib[0]}; x1.i = (v2){ia[1], ib[1]}; x2.i = (v2){ia[2], ib[2]}; x3.i = (v2){ia[3], ib[3]};
        bf4<INV>(x0, x1, x2, x3);
        *(LAS f32x4*)(Fre + p) = (f32x4){x0.r[0], x1.r[0], x2.r[0], x3.r[0]}; *(LAS f32x4*)(Fre + p + 4) = (f32x4){x0.r[1], x1.r[1], x2.r[1], x3.r[1]};
        *(LAS f32x4*)(Fim + p) = (f32x4){x0.i[0], x1.i[0], x2.i[0], x3.i[0]}; *(LAS f32x4*)(Fim + p + 4) = (f32x4){x0.i[1], x1.i[1], x2.i[1], x3.i[1]};
    }
}
__device__ __forceinline__ void fft_fwd(LAS float* Fre, LAS float* Fim, int tid) {
    r16_pass<false, 10>(Fre, Fim, tid); __syncthreads(); r16_pass<false, 6>(Fre, Fim, tid); __syncthreads(); r16_pass<false, 2>(Fre, Fim, tid); __syncthreads(); r4_pass<false>(Fre, Fim, tid);
}
__device__ __forceinline__ void fft_inv(LAS float* Fre, LAS float* Fim, int tid) {
    r4_pass<true>(Fre, Fim, tid); __syncthreads(); r16_pass<true, 2>(Fre, Fim, tid); __syncthreads(); r16_pass<true, 6>(Fre, Fim, tid); __syncthreads(); r16_pass<true, 10>(Fre, Fim, tid);
}
typedef _Float16 h8v __attribute__((ext_vector_type(8)));
__device__ __forceinline__ void sconv8(const bf16_t* row, int n0, float w0, float w1, float w2, float b, float (&out)[8]) {
    const u32x4 q = *(const u32x4*)(row + n0);
    float x[10];
    x[0] = n0 > 0 ? bf2f(row[n0 - 1]) : 0.f;
    x[9] = n0 + 8 < L ? bf2f(row[n0 + 8]) : 0.f;
#pragma unroll
    for (int i = 0; i < 4; ++i) { x[1 + 2 * i] = bf_lo(q[i]); x[2 + 2 * i] = bf_hi(q[i]); }
#pragma unroll
    for (int e = 0; e < 8; ++e) out[e] = b + w0 * x[e] + w1 * x[e + 1] + w2 * x[e + 2];
}
template <bool CONJ> __device__ __forceinline__ void tw8(int n0, float (&tr)[8], float (&ti)[8]) {
    const float rev = (float)n0 * (1.0f / (float)(2 * L));
    const float sr = 0.99999998161642933f, si = CONJ ? 1.9174759731070330e-4f : -1.9174759731070330e-4f;
    tr[0] = __builtin_amdgcn_cosf(rev); ti[0] = CONJ ? __builtin_amdgcn_sinf(rev) : -__builtin_amdgcn_sinf(rev);
#pragma unroll
    for (int e = 1; e < 8; ++e) { tr[e] = tr[e - 1] * sr - ti[e - 1] * si; ti[e] = tr[e - 1] * si + ti[e - 1] * sr; }
}
__device__ __forceinline__ void st8(LAS float* p, const float (&v)[8]) { *(LAS f32x4*)p = (f32x4){v[0], v[1], v[2], v[3]}; *(LAS f32x4*)(p + 4) = (f32x4){v[4], v[5], v[6], v[7]}; }
__device__ __forceinline__ void ld8(const LAS float* p, float (&v)[8]) { const f32x4 a = *(const LAS f32x4*)p, b = *(const LAS f32x4*)(p + 4);
#pragma unroll
    for (int e = 0; e < 4; ++e) { v[e] = a[e]; v[4 + e] = b[e]; } }
template <bool DRY> __device__ void fft_phase(const Args& a, bf16_t* pbT, LAS unsigned char* lds) {
    const int tid = opaque_tid(), lane = tid & 63, w = tid >> 6;
    LAS float* Fre = (LAS float*)lds; LAS float* Fim = Fre + 17408;
    LAS float* red = (LAS float*)(lds + 17408 * 8);
    const int po = fphys(8 * tid);
    const half_t* KT = (const half_t*)(a.ws + WS_KT);
    unsigned char* scr = a.ws + WS_ACT + PBT_BYTES + (size_t)blockIdx.x * FFTSCR_PER_BLOCK;
    float* ybuf = (float*)scr;
    float* z1buf = (float*)(scr + 2ull * L * 8);
    const float* sw = a.in[15]; const float* sb = a.in[16]; const float* skip = a.in[23];
    for (int ch = blockIdx.x; ch < 512; ch += gridDim.x) {
        const float vw0 = sw[ch], vw1 = sw[1536 + ch], vw2 = sw[3072 + ch], vb = sb[ch];
#pragma unroll 1
        for (int o = 0; o < 2; ++o) {
            const half_t* kf = KT + ((size_t)((o * 512 + ch) * 2) << 14); const half_t* kb = kf + L;
            const int xc = (o == 0 ? 512 : 1024) + ch;
            const float gw0 = sw[xc], gw1 = sw[1536 + xc], gw2 = sw[3072 + xc], gb = sb[xc];
            const float skp = skip[o * 512 + ch];
            float ss = 0.f;
#pragma unroll 1
            for (int g = 0; g < 4; ++g) {
                const int n0 = 8 * (tid + 512 * g);
                const h8v f = *(const h8v*)(kf + n0), bk = *(const h8v*)(kb + n0);
#pragma unroll
                for (int e = 0; e < 8; ++e) { const float ff = (float)f[e], bb = (n0 + e > 0) ? (float)bk[e] : 0.f; ss += ff * ff + bb * bb; }
            }
#pragma unroll
            for (int of = 32; of > 0; of >>= 1) ss += __shfl_xor(ss, of);
            __syncthreads();
            if (lane == 0) red[w] = ss;
            __syncthreads();
            float tot = 0.f;
#pragma unroll
            for (int ww = 0; ww < 8; ++ww) tot += red[ww];
            const float kscale = rsqrtf(tot + EPS) * (0.5f / (float)L);
#pragma unroll 1
            for (int br = 0; br < 2; ++br) {
                __syncthreads();
#pragma unroll 1
                for (int g = 0; g < 4; ++g) {
                    const int n0 = 8 * (tid + 512 * g);
                    const h8v f = *(const h8v*)(kf + n0), bc = *(const h8v*)(kb + (L - 8 - n0));
                    const float b0 = n0 > 0 ? (float)kb[L - n0] : 0.f;
                    float d[8], vr[8], vi[8];
#pragma unroll
                    for (int e = 0; e < 8; ++e) { const float bk = (e == 0) ? b0 : (float)bc[8 - e]; d[e] = (br == 0 ? (float)f[e] + bk : (float)f[e] - bk) * kscale; }
                    if (br == 0) {
#pragma unroll
                        for (int e = 0; e < 8; ++e) { vr[e] = d[e]; vi[e] = 0.f; }
                    } else {
                        float tr[8], ti[8]; tw8<false>(n0, tr, ti);
#pragma unroll
                        for (int e = 0; e < 8; ++e) { vr[e] = d[e] * tr[e]; vi[e] = d[e] * ti[e]; }
                    }
                    st8(Fre + po + 4352 * g, vr); st8(Fim + po + 4352 * g, vi);
                }
                __syncthreads();
                fft_fwd(Fre, Fim, tid);
                __syncthreads();
                float KrR[32], KrI[32];
#pragma unroll
                for (int g = 0; g < 4; ++g) {
                    const f32x4 r0 = *(const LAS f32x4*)(Fre + po + 4352 * g), r1 = *(const LAS f32x4*)(Fre + po + 4352 * g + 4), i0 = *(const LAS f32x4*)(Fim + po + 4352 * g), i1 = *(const LAS f32x4*)(Fim + po + 4352 * g + 4);
#pragma unroll
                    for (int e = 0; e < 4; ++e) { KrR[g * 8 + e] = r0[e]; KrR[g * 8 + 4 + e] = r1[e]; KrI[g * 8 + e] = i0[e]; KrI[g * 8 + 4 + e] = i1[e]; }
                }
#pragma unroll 1
                for (int pk = 0; pk < 2; ++pk) {
                    __syncthreads();
#pragma unroll 1
                    for (int g = 0; g < 4; ++g) {
                        const int n0 = 8 * (tid + 512 * g);
                        float re[8], im[8];
                        if (o == 0) {
                            sconv8(pbT + ((size_t)((2 * pk) * 1536 + ch) << 14), n0, vw0, vw1, vw2, vb, re);
                            if (pk == 0) sconv8(pbT + ((size_t)(1536 + ch) << 14), n0, vw0, vw1, vw2, vb, im);
                        } else {
                            const f32x4 r0 = *(const f32x4*)(z1buf + (2 * pk) * L + n0), r1 = *(const f32x4*)(z1buf + (2 * pk) * L + n0 + 4);
#pragma unroll
                            for (int e = 0; e < 4; ++e) { re[e] = r0[e]; re[4 + e] = r1[e]; }
                            if (pk == 0) { const f32x4 i0 = *(const f32x4*)(z1buf + L + n0), i1 = *(const f32x4*)(z1buf + L + n0 + 4);
#pragma unroll
                                for (int e = 0; e < 4; ++e) { im[e] = i0[e]; im[4 + e] = i1[e]; } }
                        }
                        if (pk == 1) {
#pragma unroll
                            for (int e = 0; e < 8; ++e) im[e] = 0.f;
                        }
                        if (br == 1) {
                            float tr[8], ti[8]; tw8<false>(n0, tr, ti);
#pragma unroll
                            for (int e = 0; e < 8; ++e) { const float xr = re[e] * tr[e] - im[e] * ti[e], xi = re[e] * ti[e] + im[e] * tr[e]; re[e] = xr; im[e] = xi; }
                        }
                        st8(Fre + po + 4352 * g, re); st8(Fim + po + 4352 * g, im);
                    }
                    __syncthreads();
                    fft_fwd(Fre, Fim, tid);
                    __syncthreads();
#pragma unroll
                    for (int g = 0; g < 4; ++g) {
                        float xr[8], xi[8], yr[8], yi[8];
                        ld8(Fre + po + 4352 * g, xr); ld8(Fim + po + 4352 * g, xi);
#pragma unroll
                        for (int e = 0; e < 8; ++e) { yr[e] = xr[e] * KrR[g * 8 + e] - xi[e] * KrI[g * 8 + e]; yi[e] = xr[e] * KrI[g * 8 + e] + xi[e] * KrR[g * 8 + e]; }
                        st8(Fre + po + 4352 * g, yr); st8(Fim + po + 4352 * g, yi);
                    }
                    __syncthreads();
                    fft_inv(Fre, Fim, tid);
                    __syncthreads();
#pragma unroll 1
                    for (int g = 0; g < 4; ++g) {
                        const int n0 = 8 * (tid + 512 * g);
                        float rr[8], ri[8];
                        ld8(Fre + po + 4352 * g, rr); ld8(Fim + po + 4352 * g, ri);
                        float* ybr = ybuf + (size_t)pk * 2 * L + n0; float* ybi = ybr + L;
                        if (br == 0) {
                            *(f32x4*)ybr = (f32x4){rr[0], rr[1], rr[2], rr[3]}; *(f32x4*)(ybr + 4) = (f32x4){rr[4], rr[5], rr[6], rr[7]};
                            *(f32x4*)ybi = (f32x4){ri[0], ri[1], ri[2], ri[3]}; *(f32x4*)(ybi + 4) = (f32x4){ri[4], ri[5], ri[6], ri[7]};
                        } else {
                            const f32x4 yr0 = *(const f32x4*)ybr, yr1 = *(const f32x4*)(ybr + 4), yi0 = *(const f32x4*)ybi, yi1 = *(const f32x4*)(ybi + 4);
                            float tr[8], ti[8]; tw8<true>(n0, tr, ti);
                            float yre[8], yim[8];
#pragma unroll
                            for (int e = 0; e < 8; ++e) {
                                yre[e] = (e < 4 ? yr0[e & 3] : yr1[e & 3]) + rr[e] * tr[e] - ri[e] * ti[e];
                                yim[e] = (e < 4 ? yi0[e & 3] : yi1[e & 3]) + rr[e] * ti[e] + ri[e] * tr[e];
                            }
                            const int nseq = (pk == 0) ? 2 : 1;
#pragma unroll 1
                            for (int q = 0; q < nseq; ++q) {
                                const int s = 2 * pk + q;
                                float gate[8];
                                sconv8(pbT + ((size_t)(s * 1536 + xc) << 14), n0, gw0, gw1, gw2, gb, gate);
                                float* zp = z1buf + s * L + n0;
                                if (o == 0) {
                                    float vv[8];
                                    sconv8(pbT + ((size_t)(s * 1536 + ch) << 14), n0, vw0, vw1, vw2, vb, vv);
                                    float z[8];
#pragma unroll
                                    for (int e = 0; e < 8; ++e) z[e] = gate[e] * ((q == 0 ? yre[e] : yim[e]) + vv[e] * skp);
                                    *(f32x4*)zp = (f32x4){z[0], z[1], z[2], z[3]}; *(f32x4*)(zp + 4) = (f32x4){z[4], z[5], z[6], z[7]};
                                } else {
                                    const f32x4 z0 = *(const f32x4*)zp, z1 = *(const f32x4*)(zp + 4);
                                    float z[8];
#pragma unroll
                                    for (int e = 0; e < 8; ++e) z[e] = gate[e] * ((q == 0 ? yre[e] : yim[e]) + (e < 4 ? z0[e & 3] : z1[e & 3]) * skp);
                                    u32x4 wv; wv.x = pk_bf16(z[0], z[1]); wv.y = pk_bf16(z[2], z[3]); wv.z = pk_bf16(z[4], z[5]); wv.w = pk_bf16(z[6], z[7]);
                                    if (!DRY) *(u32x4*)(pbT + ((size_t)(s * 1536 + ch) << 14) + n0) = wv;
                                }
                            }
                        }
                    }
                }
            }
            __syncthreads();
        }
    }
    __syncthreads();
}

__device__ void ztrans_phase(const bf16_t* pbT, bf16_t* cat, LAS unsigned char* lds) {
    const int tid = opaque_tid();
    LAS unsigned* tl = (LAS unsigned*)lds;
    LAS bf16_t* tb = (LAS bf16_t*)lds;
    for (int tile = blockIdx.x; tile < 6144; tile += gridDim.x) {
        const int tt0 = (tile & 255) * 64, ct = (tile >> 8) & 7, s = tile >> 11;
        __syncthreads();
        { const int cc = tid >> 3, tk = (tid & 7) * 8;
          const u32x4 v = *(const u32x4*)(pbT + ((size_t)(s * 1536 + ct * 64 + cc) << 14) + tt0 + tk);
#pragma unroll
          for (int q = 0; q < 4; ++q) tl[cc * 33 + (tk >> 1) + q] = v[q]; }
        __syncthreads();
        { const int tt = tid >> 3, cg8 = (tid & 7) * 8; bf16_t e[8];
#pragma unroll
          for (int i = 0; i < 8; ++i) e[i] = tb[(cg8 + i) * 66 + tt];
          u32x4 wv; wv.x = e[0] | ((unsigned)e[1] << 16); wv.y = e[2] | ((unsigned)e[3] << 16); wv.z = e[4] | ((unsigned)e[5] << 16); wv.w = e[6] | ((unsigned)e[7] << 16);
          *(u32x4*)(cat + (size_t)(s * L + tt0 + tt) * 1024 + 512 + ct * 64 + cg8) = wv; }
    }
    __syncthreads();
}

__device__ void attn_phase(const Args& a, const bf16_t* qkv, bf16_t* ao, LAS unsigned char* lds) {
    const int tid = opaque_tid(), lane = tid & 63, w = tid >> 6, l31 = lane & 31, hh = lane >> 5;
    LAS bf16_t* Ks = (LAS bf16_t*)lds;
    LAS bf16_t* VT = (LAS bf16_t*)(lds + 384 * 72 * 2);
    const float* sink = a.in[26];
    for (int item = blockIdx.x; item < 1536; item += gridDim.x) {
        const int kvh = item & 3, qb = (item >> 2) & 127, seq = item >> 9;
        const int kb0 = qb * 128 - 128;
        __syncthreads();
        for (int idx = tid; idx < 384 * 8; idx += 512) {
            const int key = idx % 384, dc = idx / 384, kpos = kb0 + key;
            u32x4 kv = (u32x4){0u, 0u, 0u, 0u}, vv = (u32x4){0u, 0u, 0u, 0u};
            if (kpos >= 0 && kpos < L) { const bf16_t* rp = qkv + (size_t)(seq * L + kpos) * 1536 + kvh * 64 + dc * 8; kv = *(const u32x4*)(rp + 1024); vv = *(const u32x4*)(rp + 1280); }
            *(LAS u32x4*)(Ks + key * 72 + dc * 8) = kv;
#pragma unroll
            for (int i = 0; i < 8; ++i) VT[(dc * 8 + i) * 392 + key] = (bf16_t)((vv[i >> 1] >> (16 * (i & 1))) & 0xffffu);
        }
        __syncthreads();
        for (int uu = 0; uu < 2; ++uu) {
            const int u = w + 8 * uu, g = u >> 2, qs = u & 3, h = kvh * 4 + g, q0 = qb * 128 + 32 * qs;
            bf16x8 qf[4];
            const bf16_t* qp = qkv + (size_t)(seq * L + q0 + l31) * 1536 + h * 64 + 8 * hh;
#pragma unroll
            for (int ks = 0; ks < 4; ++ks) qf[ks] = *(const bf16x8*)(qp + 16 * ks);
            const float slope = exp2f(-0.5f * (float)(h + 1));
            float m = sink[h], lsum = 1.0f;
            f32x16 O0, O1;
#pragma unroll
            for (int r = 0; r < 16; ++r) { O0[r] = 0.f; O1[r] = 0.f; }
#pragma unroll 1
            for (int kt = 0; kt < 9; ++kt) {
                const int kl0 = 32 * qs + 32 * kt;
                f32x16 S;
#pragma unroll
                for (int r = 0; r < 16; ++r) S[r] = 0.f;
#pragma unroll
                for (int ks = 0; ks < 4; ++ks) { const bf16x8 af = *(const LAS bf16x8*)(Ks + (kl0 + l31) * 72 + 16 * ks + 8 * hh); S = __builtin_amdgcn_mfma_f32_32x32x16_bf16(af, qf[ks], S, 0, 0, 0); }
                float p[16]; float mt = -1e30f;
#pragma unroll
                for (int r = 0; r < 16; ++r) {
                    const int i = 8 * (r >> 2) + 4 * hh + (r & 3);
                    const int dist = 32 * kt + i - l31 - 128, kpos = q0 - 128 + 32 * kt + i;
                    const int ad = dist < 0 ? -dist : dist;
                    const bool valid = (ad <= 128) && (kpos >= 0) && (kpos < L);
                    p[r] = valid ? (S[r] * 0.125f - slope * (float)ad) : -1e30f;
                    mt = fmaxf(mt, p[r]);
                }
                mt = fmaxf(mt, __shfl_xor(mt, 32));
                const float mnew = fmaxf(m, mt), alpha = __expf(m - mnew);
                float rs = 0.f;
#pragma unroll
                for (int r = 0; r < 16; ++r) { p[r] = __expf(p[r] - mnew); rs += p[r]; }
                rs += __shfl_xor(rs, 32);
                lsum = lsum * alpha + rs; m = mnew;
#pragma unroll
                for (int r = 0; r < 16; ++r) { O0[r] *= alpha; O1[r] *= alpha; }
#pragma unroll
                for (int kk = 0; kk < 2; ++kk) {
                    u32x4 pw; pw.x = pk_bf16(p[8 * kk], p[8 * kk + 1]); pw.y = pk_bf16(p[8 * kk + 2], p[8 * kk + 3]); pw.z = pk_bf16(p[8 * kk + 4], p[8 * kk + 5]); pw.w = pk_bf16(p[8 * kk + 6], p[8 * kk + 7]);
                    const bf16x8 pf = __builtin_bit_cast(bf16x8, pw);
#pragma unroll
                    for (int dt = 0; dt < 2; ++dt) {
                        const LAS bf16_t* vp = VT + (32 * dt + l31) * 392 + kl0 + 16 * kk + 4 * hh;
                        const u32x2 lo = *(const LAS u32x2*)vp, hi = *(const LAS u32x2*)(vp + 8);
                        const bf16x8 vf = __builtin_bit_cast(bf16x8, (u32x4){lo.x, lo.y, hi.x, hi.y});
                        if (dt == 0) O0 = __builtin_amdgcn_mfma_f32_32x32x16_bf16(vf, pf, O0, 0, 0, 0);
                        else O1 = __builtin_amdgcn_mfma_f32_32x32x16_bf16(vf, pf, O1, 0, 0, 0);
                    }
                }
            }
            const float inv = 1.0f / lsum;
            bf16_t* op = ao + (size_t)(seq * L + q0 + l31) * 1024 + h * 64 + 4 * hh;
#pragma unroll
            for (int b = 0; b < 4; ++b) {
                u32x2 o0; o0.x = pk_bf16(O0[4 * b] * inv, O0[4 * b + 1] * inv); o0.y = pk_bf16(O0[4 * b + 2] * inv, O0[4 * b + 3] * inv);
                u32x2 o1; o1.x = pk_bf16(O1[4 * b] * inv, O1[4 * b + 1] * inv); o1.y = pk_bf16(O1[4 * b + 2] * inv, O1[4 * b + 3] * inv);
                *(u32x2*)(op + 8 * b) = o0; *(u32x2*)(op + 32 + 8 * b) = o1;
            }
        }
    }
    __syncthreads();
}

__global__ void __launch_bounds__(512, 2) mega(Args a) {
    extern __shared__ __attribute__((aligned(16))) unsigned char lds_raw[];
    LAS unsigned char* lds = (LAS unsigned char*)lds_raw;
    unsigned char* ws = a.ws;
    const int lo = a.ph_lo, hi = a.ph_hi;
    bf16_t* XB = (bf16_t*)(ws + WS_H);
    const float* mod = (const float*)(ws + WS_MOD);
    bf16_t* H = (bf16_t*)a.out;
    bf16_t* ACT = (bf16_t*)(ws + WS_ACT);
    bf16_t* PBT = ACT;
    bf16_t* PA = (bf16_t*)(ws + WS_ACT + PBT_BYTES);
    const int G = gridDim.x, bx = blockIdx.x;
    volatile LAS unsigned* bst = (volatile LAS unsigned*)(lds + LDS_BYTES - 16);
    if (threadIdx.x < 4) bst[threadIdx.x] = 0u;
    __syncthreads();
    const XcdBarrier xbar = xcd_barrier_post((unsigned*)(ws + WS_BAR), bst);
#define GSYNC() xcd_barrier(xbar)
#define IN(k) (lo <= (k) && (k) < hi)
#define SEAM(k) do { if (IN(k) && IN((k) + 1)) { GSYNC(); if ((RM >> 15) & 1) GSYNC(); } } while (0)
    int ph = 0;
    if (IN(0)) REP(0) { if (EN(0)) convert_weights(a, (LAS float*)lds); if (EN(1)) ada_phase(a, (LAS float*)lds); if (EN(2)) filter_phase(a, (LAS float*)lds); }
    if (IN(0) && IN(1)) cg::this_grid().sync();
    ph = 1;
#pragma unroll 1
    for (int layer = 0; layer < 2; ++layer) {
        const float* ml = mod + (size_t)layer * 3 * 9216;
        const float* ng = a.in[6] + layer * 3 * 1024;
#pragma unroll 1
        for (int sub = 0; sub < 3; ++sub) {
            const bool first = (layer == 0 && sub == 0);
            const float* xs0 = a.in[0]; const float* xs1 = a.in[1];
            const float* shp = ml + (3 * sub) * 1024; const float* scp = shp + 1024; const float* gp = shp + 2048;
            if (EN(3) && IN(ph)) REP(3) { if (first) norm_phase<true>(xs0, xs1, XB, ng + sub * 1024, shp, scp, H); else norm_phase<false>(xs0, xs1, XB, ng + sub * 1024, shp, scp, H); }
            SEAM(ph); ++ph;
            if (sub != 1) {
                const int fi = layer * 2 + (sub == 2 ? 1 : 0);
                if (EN(4) && IN(ph)) REP(4) { pg8::Gemm g{H, (const bf16_t*)(ws + WS_WIN) + (size_t)fi * 5632 * 1024, T, 5632, 1024}; pg8::StaticOrder S; S.init(T, 5632, G, bx);
                    EpiSwiglu E{ACT}; pg8::gemm_phase<EpiSwiglu>(lds, g, S, E); }
                SEAM(ph); ++ph;
                if (EN(5) && IN(ph)) { pg8::Gemm g{ACT, (const bf16_t*)(ws + WS_WOUT) + (size_t)fi * 1024 * 2816, T, 1024, DFF}; pg8::StaticOrder S; S.init(T, 1024, G, bx);
                    if (first) { EpiResid<true> E{xs0, xs1, XB, XB, gp, 0.5f}; pg8::gemm_phase<EpiResid<true>>(lds, g, S, E); } else { EpiResid<false> E{xs0, xs1, XB, XB, gp, 0.5f}; pg8::gemm_phase<EpiResid<false>>(lds, g, S, E); } }
                SEAM(ph); ++ph;
            } else if (layer == 0) {
                if (EN(6) && IN(ph)) REP(6) { pg8::Gemm g{H, (const bf16_t*)(ws + WS_WABIN), T, 2560, 1024}; pg8::StaticOrder S; S.init(T, 2560, G, bx);
                    EpiProj E{PA, PBT}; pg8::gemm_phase<EpiProj>(lds, g, S, E); }
                SEAM(ph); ++ph;
                if (IN(ph)) { if (EN(7)) REP(7) conva_phase(a, PA, H, lds); GSYNC(); if ((RM >> 8) & 1) fft_phase<true>(a, PBT, lds); if (EN(8)) fft_phase<false>(a, PBT, lds); }
                SEAM(ph); ++ph;
                if (EN(9) && IN(ph)) REP(9) ztrans_phase(PBT, H, lds);
                SEAM(ph); ++ph;
                if (EN(5) && IN(ph)) { pg8::Gemm g{H, (const bf16_t*)(ws + WS_WABOUT), T, 1024, 1024}; pg8::StaticOrder S; S.init(T, 1024, G, bx);
                    EpiResid<false> E{xs0, xs1, XB, XB, gp, 1.0f}; pg8::gemm_phase<EpiResid<false>>(lds, g, S, E); }
                SEAM(ph); ++ph;
            } else {
                if (EN(10) && IN(ph)) REP(10) { pg8::Gemm g{H, (const bf16_t*)(ws + WS_WQKV), T, 1536, 1024}; pg8::StaticOrder S; S.init(T, 1536, G, bx);
                    EpiBf16 E{ACT, 1536}; pg8::gemm_phase<EpiBf16>(lds, g, S, E); }
                SEAM(ph); ++ph;
                if (EN(11) && IN(ph)) REP(11) attn_phase(a, ACT, H, lds);
                SEAM(ph); ++ph;
                if (EN(5) && IN(ph)) { pg8::Gemm g{H, (const bf16_t*)(ws + WS_WATTO), T, 1024, 1024}; pg8::StaticOrder S; S.init(T, 1024, G, bx);
                    EpiResid<false> E{xs0, xs1, XB, XB, gp, 1.0f}; pg8::gemm_phase<EpiResid<false>>(lds, g, S, E); }
                SEAM(ph); ++ph;
            }
        }
    }
    if (EN(12) && IN(ph)) final_norm_phase(XB, a.out, a.in[9]);
#undef IN
#undef SEAM
}

extern "C" void kernel_launch(void* const* d_in, const int* in_sizes, int n_in, void* d_out, int out_size, void* d_ws, size_t ws_size, hipStream_t stream) {
    static int grid = 0;
    if (grid == 0) {
        int dev = 0, cus = 0, per_cu = 0;
        (void)hipGetDevice(&dev);
        (void)hipDeviceGetAttribute(&cus, hipDeviceAttributeMultiprocessorCount, dev);
        (void)hipFuncSetAttribute((const void*)mega, hipFuncAttributeMaxDynamicSharedMemorySize, LDS_BYTES);
        (void)hipOccupancyMaxActiveBlocksPerMultiprocessor(&per_cu, (const void*)mega, 512, LDS_BYTES);
        if (per_cu < 1) per_cu = 1;
        grid = cus * per_cu;
        if (grid > 256) grid = 256;
        if (ws_size < WS_END) { fprintf(stderr, "workspace too small: %zu < %zu\n", ws_size, (size_t)WS_END); grid = -1; }
    }
    if (grid < 0) return;
    Args a{};
    for (int i = 0; i < 28; ++i) a.in[i] = (const float*)d_in[i];
    a.out = (float*)d_out; a.ws = (unsigned char*)d_ws;
    (void)hipMemsetAsync((unsigned char*)d_ws + WS_BAR, 0, XCD_BAR_WORDS * 4, stream);
#if N_LAUNCH_MODE == 1
    a.ph_lo = 0; a.ph_hi = NPH;
    void* args[] = {&a};
    hipError_t e = hipLaunchCooperativeKernel((const void*)mega, dim3(grid), dim3(512), args, LDS_BYTES, stream);
    if (e != hipSuccess) fprintf(stderr, "cooperative launch failed: %s (grid %d)\n", hipGetErrorString(e), grid);
#else
    for (int p = 0; p < NPH; ++p) { a.ph_lo = p; a.ph_hi = p + 1; hipLaunchKernelGGL(mega, dim3(grid), dim3(512), LDS_BYTES, stream, a); }
#endif
}
```

```cpp
#include <hip/hip_runtime.h>
#include <hip/hip_cooperative_groups.h>
#include <cstdio>
namespace cg = cooperative_groups;

#ifndef PM
#define PM 0xffff
#endif
#define EN(b) ((PM >> (b)) & 1)
#ifndef RM
#define RM 0
#endif
#define REP(b) for (int rep_ = 0; rep_ < 1 + ((RM >> (b)) & 1); ++rep_)
#ifndef N_LAUNCH_MODE
#define N_LAUNCH_MODE 1
#endif

#define LAS __attribute__((address_space(3)))
typedef unsigned short bf16_t;
typedef short bf16x8 __attribute__((ext_vector_type(8)));
typedef float f32x4 __attribute__((ext_vector_type(4)));
typedef float f32x16 __attribute__((ext_vector_type(16)));
typedef unsigned u32x4 __attribute__((ext_vector_type(4)));
typedef unsigned u32x2 __attribute__((ext_vector_type(2)));
typedef __bf16 bf16x2v __attribute__((ext_vector_type(2)));
typedef float f32x2v __attribute__((ext_vector_type(2)));
typedef _Float16 half_t;

constexpr int T = 49152, D = 1024, L = 16384, DFF = 2816, NPH = 23;
constexpr float EPS = 1e-6f;
constexpr int LDS_BYTES = 147456;

constexpr size_t WS_WIN = 0;
constexpr size_t WS_WOUT = WS_WIN + 4ull * 5632 * 1024 * 2;
constexpr size_t WS_WABIN = WS_WOUT + 4ull * 1024 * 2816 * 2;
constexpr size_t WS_WABOUT = WS_WABIN + 2560ull * 1024 * 2;
constexpr size_t WS_WQKV = WS_WABOUT + 1024ull * 1024 * 2;
constexpr size_t WS_WATTO = WS_WQKV + 1536ull * 1024 * 2;
constexpr size_t WS_MOD = WS_WATTO + 1024ull * 1024 * 2;
constexpr size_t WS_BAR = WS_MOD + 221184;
constexpr size_t WS_H = WS_MOD + 262144;
constexpr size_t WS_ACT = WS_H + (size_t)T * 1024 * 2;
constexpr size_t WS_KT = WS_ACT + (size_t)T * DFF * 2;
constexpr size_t WS_END = WS_KT + 2ull * 512 * 2 * L * 2;
constexpr size_t PBT_BYTES = 3ull * 1536 * L * 2;
constexpr size_t FFTSCR_PER_BLOCK = 2ull * L * 8 + 3ull * L * 4;

__device__ __forceinline__ unsigned pk_bf16(float a, float b) { f32x2v f = {a, b}; bf16x2v r = __builtin_convertvector(f, bf16x2v); return __builtin_bit_cast(unsigned, r); }
__device__ __forceinline__ float bf_lo(unsigned v) { return __uint_as_float(v << 16); }
__device__ __forceinline__ float bf_hi(unsigned v) { return __uint_as_float(v & 0xffff0000u); }
__device__ __forceinline__ float bf2f(bf16_t v) { return __uint_as_float((unsigned)v << 16); }
__device__ __forceinline__ bf16_t f2bf(float f) { return (bf16_t)(pk_bf16(f, 0.f) & 0xffffu); }
__device__ __forceinline__ float fsigmoid(float x) { return __builtin_amdgcn_rcpf(1.0f + __expf(-x)); }
__device__ __forceinline__ float hw_sin(float x) { return __builtin_amdgcn_sinf(x * 0.15915494309189535f); }

__device__ __forceinline__ int opaque_tid() { int t = threadIdx.x; asm volatile("" : "+v"(t)); return t; }

#define XB_TMO      128
#define XB_XCNT(j)  (256  + 64 * (j))
#define XB_XSUB(j)  (1280 + 64 * (j))
#define XB_XGEN(j)  (2304 + 64 * (j))
#define XB_TOP      3328
#define XB_TOPGEN   3392
#define XCD_BAR_WORDS 3456
#define XB_SPIN_CAP (1u << 22)
__device__ __forceinline__ unsigned xb_ld(unsigned* p)              { return __hip_atomic_load(p, __ATOMIC_RELAXED, __HIP_MEMORY_SCOPE_AGENT); }
__device__ __forceinline__ unsigned xb_add(unsigned* p, unsigned v) { return __hip_atomic_fetch_add(p, v, __ATOMIC_RELAXED, __HIP_MEMORY_SCOPE_AGENT); }
__device__ __forceinline__ unsigned xb_xcc_id() { return (unsigned)__builtin_amdgcn_s_getreg((3 << 11) | 20) & 0xFu; }
#define XB_SPIN(cond, bar) do { unsigned _sp = 0; while (cond) { __builtin_amdgcn_s_sleep(1); \
    if ((++_sp & 255u) == 0u) { if (xb_ld(&(bar)[XB_TMO])) break; if (_sp > XB_SPIN_CAP) { atomicAdd(&(bar)[XB_TMO], 1u); break; } } } } while (0)
struct XcdBarrier { unsigned* bar; unsigned x; volatile LAS unsigned* st; };
__device__ __forceinline__ XcdBarrier xcd_barrier_post(unsigned* bar, volatile LAS unsigned* st) {
    XcdBarrier b; b.bar = bar; b.x = xb_xcc_id(); b.st = st;
    if (threadIdx.x == 0) (void)xb_add(&bar[XB_XCNT(b.x)], 1u);
    return b;
}
__device__ __forceinline__ void xcd_barrier_complete(unsigned* bar, unsigned x, unsigned& nloc, unsigned& nx) {
    const unsigned G = gridDim.x * gridDim.y * gridDim.z;
    unsigned sum, cnt, mine, sp = 0u;
    for (;;) {
        sum = 0u; cnt = 0u; mine = 0u;
#pragma unroll
        for (unsigned j = 0; j < 16; ++j) { const unsigned c = xb_ld(&bar[XB_XCNT(j)]); sum += c; cnt += (c > 0u) ? 1u : 0u; mine = (j == x) ? c : mine; }
        if (sum == G) break;
        __builtin_amdgcn_s_sleep(1);
        if ((++sp & 255u) == 0u) { if (xb_ld(&bar[XB_TMO])) break; if (sp > XB_SPIN_CAP) { atomicAdd(&bar[XB_TMO], 1u); break; } }
    }
    nloc = mine > 0u ? mine : 1u; nx = cnt > 0u ? cnt : 1u;
}
__device__ __forceinline__ void xcd_barrier(const XcdBarrier& b) {
    asm volatile("s_waitcnt vmcnt(0)" ::: "memory");
    __syncthreads();
    if (threadIdx.x == 0) {
        unsigned* bar = b.bar;
        __builtin_amdgcn_s_waitcnt(0);
        unsigned nloc = b.st[0], nx = b.st[1];
        if (nloc == 0u) { xcd_barrier_complete(bar, b.x, nloc, nx); b.st[0] = nloc; b.st[1] = nx; }
        const unsigned old = xb_add(&bar[XB_XSUB(b.x)], 1u);
        const unsigned gen = old / nloc;
        if (old + 1u == (gen + 1u) * nloc) {
            __builtin_amdgcn_fence(__ATOMIC_RELEASE, "agent");
            asm volatile("s_waitcnt vmcnt(0)" ::: "memory");
            const unsigned og = xb_add(&bar[XB_TOP], 1u);
            const unsigned tg = og / nx;
            if (og + 1u == (tg + 1u) * nx) xb_add(&bar[XB_TOPGEN], 1u);
            else XB_SPIN(xb_ld(&bar[XB_TOPGEN]) == tg, bar);
            __builtin_amdgcn_fence(__ATOMIC_ACQUIRE, "agent");
            xb_add(&bar[XB_XGEN(b.x)], 1u);
            asm volatile("s_waitcnt vmcnt(0)" ::: "memory");
        } else {
            XB_SPIN(xb_ld(&bar[XB_XGEN(b.x)]) == gen, bar);
            __builtin_amdgcn_fence(__ATOMIC_ACQUIRE, "agent");
            asm volatile("s_waitcnt vmcnt(0)" ::: "memory");
        }
    }
    __syncthreads();
}

struct Args { const float* in[28]; float* out; unsigned char* ws; int ph_lo, ph_hi; };

namespace pg8 {
constexpr int BM = 256, BK = 64, HALF = 128, HTB = HALF * BK * 2, STAGE_BYTES = 8 * HTB, NXCD = 8, WGM = 8;
__device__ __forceinline__ int lds_byte(int r, int c) { const int st = (r >> 4) * 2 + (c >> 5), rr = r & 15, cc = c & 31, ob = rr * 64 + cc * 2; return st * 1024 + (ob ^ (((ob >> 9) & 1) << 5)); }
__device__ __forceinline__ void stage_rc(int b, int& R, int& C) { const int st = b / 1024, sb = b % 1024, swz = sb ^ (((sb >> 9) & 1) << 5); R = (st >> 1) * 16 + swz / 64; C = (st & 1) * 32 + (swz % 64) / 2; }
__device__ __forceinline__ int perm32(int rho) { const int n = rho >> 4, i = rho & 15; return 8 * (i >> 2) + 4 * n + (i & 3); }
struct Unit { int pm, pn; };
struct Gemm { const bf16_t* A; const bf16_t* Bt; int M, N, K; };
struct StaticOrder {
    int nM, nN, nwg, G, c;
    __device__ void init(int M, int N, int G_, int c_) { nM = M / BM; nN = N / BM; nwg = nM * nN; G = G_; c = c_; }
    __device__ bool next(int i, Unit& u) const {
        const long Lx = (long)i * G + c; if (Lx >= nwg) return false;
        int wgid = (int)Lx; { const int q = nwg / NXCD, r = nwg % NXCD, xcd = wgid % NXCD, off = wgid / NXCD; wgid = (xcd < r ? xcd * (q + 1) : r * (q + 1) + (xcd - r) * q) + off; }
        const int nig = WGM * nN, gid = wgid / nig, fm = gid * WGM, gsz = (nM - fm) < WGM ? (nM - fm) : WGM;
        u.pm = fm + ((wgid % nig) % gsz); u.pn = (wgid % nig) / gsz; return true;
    }
};

template <class Epi>
__device__ __forceinline__ void gemm_phase(LAS unsigned char* lds, const Gemm g, const StaticOrder& S, const Epi& E) {
    const int tid = opaque_tid(), wid = __builtin_amdgcn_readfirstlane(tid >> 6), lane = tid & 63, wr = wid >> 2, wc = wid & 3, fr = lane & 15, fq = lane >> 4;
    const int K = g.K, nt = K / BK;
    unsigned voffA[2], voffB[2];
#pragma unroll
    for (int i = 0; i < 2; ++i) { int R, C; stage_rc(tid * 16 + i * 8192, R, C); const int Rb = Epi::PERM ? ((R & ~31) + perm32(R & 31)) : R;
        voffA[i] = (unsigned)(R * K + C) * 2u; voffB[i] = (unsigned)(Rb * K + C) * 2u; }
    const size_t kstep = (size_t)(BK * 2);
    const size_t hstep = (size_t)HALF * K * 2;
    const size_t tstep = 2 * hstep;
    const unsigned ldsw = (unsigned)wid * 1024u;
    const int aoff = lds_byte(wr * 64 + fr, fq * 8), boff = lds_byte(wc * 32 + fr, fq * 8);
#define PG8_SA(b, h) (((b) * 2 + (h)) * HTB)
#define PG8_SB(b, h) ((4 + (b) * 2 + (h)) * HTB)
#define PG8_STAGE(bufoff, gbase, voff) do { _Pragma("unroll") for (int _i = 0; _i < 2; ++_i) \
        __builtin_amdgcn_global_load_lds((const unsigned*)((const char*)(gbase) + (voff)[_i]), (LAS unsigned*)(lds + (bufoff) + ldsw + _i * 8192), 16, 0, 0); } while (0)
#define PG8_LDA(dst, b, h) do { _Pragma("unroll") for (int m = 0; m < 4; ++m) _Pragma("unroll") for (int k = 0; k < 2; ++k) dst[m][k] = *(const LAS bf16x8*)(lds + PG8_SA(b, h) + aoff + m * 2048 + k * 1024); } while (0)
#define PG8_LDB(dst, b, h) do { _Pragma("unroll") for (int n = 0; n < 2; ++n) _Pragma("unroll") for (int k = 0; k < 2; ++k) dst[n][k] = *(const LAS bf16x8*)(lds + PG8_SB(b, h) + boff + n * 2048 + k * 1024); } while (0)
#define PG8_MMA(ai, bj, At, Bt) do { __builtin_amdgcn_s_setprio(1); _Pragma("unroll") for (int m = 0; m < 4; ++m) _Pragma("unroll") for (int n = 0; n < 2; ++n) _Pragma("unroll") for (int k = 0; k < 2; ++k) \
        acc[ai][bj][m][n] = __builtin_amdgcn_mfma_f32_16x16x32_bf16(Bt[n][k], At[m][k], acc[ai][bj][m][n], 0, 0, 0); __builtin_amdgcn_s_setprio(0); } while (0)
#define PG8_WAIT_V(n) asm volatile("s_waitcnt vmcnt(" #n ")" ::: "memory")
#define PG8_WAIT_L(n) asm volatile("s_waitcnt lgkmcnt(" #n ")" ::: "memory")
#define PG8_BAR __builtin_amdgcn_s_barrier()
#define PG8_SCHED __builtin_amdgcn_sched_barrier(0)
    Unit cur, nxt; int ui = 0;
    if (!S.next(0, cur)) return;
    f32x4 acc[2][2][4][2];
#pragma unroll
    for (int a = 0; a < 2; ++a)
#pragma unroll
        for (int b = 0; b < 2; ++b)
#pragma unroll
            for (int m = 0; m < 4; ++m)
#pragma unroll
                for (int n = 0; n < 2; ++n) acc[a][b][m][n] = (f32x4){0.f, 0.f, 0.f, 0.f};
    bf16x8 At[4][2], B0[2][2], B1[2][2];
    const char* cA = (const char*)g.A + (size_t)cur.pm * tstep; const char* cB = (const char*)g.Bt + (size_t)cur.pn * tstep;
    PG8_STAGE(PG8_SB(0, 0), cB, voffB); PG8_STAGE(PG8_SA(0, 0), cA, voffA); PG8_STAGE(PG8_SB(0, 1), cB + hstep, voffB); PG8_STAGE(PG8_SA(0, 1), cA + hstep, voffA);
    if (wr == 1) PG8_BAR;
    PG8_WAIT_V(4); PG8_BAR;
    PG8_STAGE(PG8_SB(1, 0), cB + kstep, voffB); PG8_STAGE(PG8_SA(1, 0), cA + kstep, voffA); PG8_STAGE(PG8_SB(1, 1), cB + hstep + kstep, voffB);
    PG8_WAIT_V(6); PG8_BAR;
    for (;;) {
        const bool has_next = S.next(ui + 1, nxt);
        const char* nA = has_next ? (const char*)g.A + (size_t)nxt.pm * tstep : cA; const char* nB = has_next ? (const char*)g.Bt + (size_t)nxt.pn * tstep : cB;
        for (int t = 0; t < nt; t += 2) {
            const bool last = (t == nt - 2);
            const char* a1 = cA + (size_t)(t + 1) * kstep;
            const char* a2 = last ? nA : cA + (size_t)(t + 2) * kstep; const char* b2 = last ? nB : cB + (size_t)(t + 2) * kstep;
            const char* a3 = a2 + kstep; const char* b3 = b2 + kstep;
            PG8_LDB(B0, 0, 0); PG8_SCHED; PG8_LDA(At, 0, 0); PG8_STAGE(PG8_SA(1, 1), a1 + hstep, voffA);
            PG8_WAIT_L(8); PG8_BAR; PG8_WAIT_L(0); PG8_MMA(0, 0, At, B0); PG8_BAR; PG8_SCHED;
            PG8_LDB(B1, 0, 1); PG8_STAGE(PG8_SB(0, 0), b2, voffB);
            PG8_BAR; PG8_WAIT_L(0); PG8_MMA(0, 1, At, B1); PG8_BAR;
            PG8_LDA(At, 0, 1); PG8_STAGE(PG8_SA(0, 0), a2, voffA);
            PG8_BAR; PG8_WAIT_L(0); PG8_MMA(1, 0, At, B0); PG8_BAR; PG8_SCHED;
            PG8_STAGE(PG8_SB(0, 1), b2 + hstep, voffB);
            PG8_WAIT_V(6); PG8_BAR; PG8_MMA(1, 1, At, B1); PG8_BAR;
            PG8_LDB(B0, 1, 0); PG8_SCHED; PG8_LDA(At, 1, 0); PG8_STAGE(PG8_SA(0, 1), a2 + hstep, voffA);
            PG8_WAIT_L(8); PG8_BAR; PG8_WAIT_L(0); PG8_MMA(0, 0, At, B0); PG8_BAR; PG8_SCHED;
            PG8_LDB(B1, 1, 1); PG8_STAGE(PG8_SB(1, 0), b3, voffB);
            PG8_BAR; PG8_WAIT_L(0); PG8_MMA(0, 1, At, B1); PG8_BAR;
            PG8_LDA(At, 1, 1); PG8_STAGE(PG8_SA(1, 0), a3, voffA);
            PG8_BAR; PG8_WAIT_L(0); PG8_MMA(1, 0, At, B0); PG8_BAR; PG8_SCHED;
            PG8_STAGE(PG8_SB(1, 1), b3 + hstep, voffB);
            PG8_WAIT_V(6); PG8_BAR; PG8_MMA(1, 1, At, B1); PG8_BAR;
        }
        E(acc, cur, wr, wc, fr, fq);
        if (!has_next) break;
#pragma unroll
        for (int a = 0; a < 2; ++a)
#pragma unroll
            for (int b = 0; b < 2; ++b)
#pragma unroll
                for (int m = 0; m < 4; ++m)
#pragma unroll
                    for (int n = 0; n < 2; ++n) acc[a][b][m][n] = (f32x4){0.f, 0.f, 0.f, 0.f};
        cur = nxt; cA = nA; cB = nB; ++ui;
    }
    PG8_WAIT_V(0);
    if (wr == 0) PG8_BAR;
    PG8_BAR;
#undef PG8_SA
#undef PG8_SB
#undef PG8_STAGE
#undef PG8_LDA
#undef PG8_LDB
#undef PG8_MMA
#undef PG8_WAIT_V
#undef PG8_WAIT_L
#undef PG8_BAR
#undef PG8_SCHED
}
}

struct EpiSwiglu {
    static constexpr bool PERM = true;
    bf16_t* O;
    __device__ __forceinline__ void operator()(const f32x4 (&acc)[2][2][4][2], const pg8::Unit& u, int wr, int wc, int fr, int fq) const {
        const int row0 = u.pm * 256 + wr * 64 + fr, col0 = u.pn * 128 + wc * 32 + 8 * fq;
#pragma unroll
        for (int ai = 0; ai < 2; ++ai)
#pragma unroll
            for (int m = 0; m < 4; ++m) {
                bf16_t* rowp = O + (size_t)(row0 + ai * 128 + m * 16) * DFF + col0;
                float v[8];
#pragma unroll
                for (int n = 0; n < 2; ++n)
#pragma unroll
                    for (int j = 0; j < 4; ++j) { const float gg = acc[ai][0][m][n][j], uu = acc[ai][1][m][n][j]; v[n * 4 + j] = gg * fsigmoid(gg) * uu; }
                u32x4 w; w.x = pk_bf16(v[0], v[1]); w.y = pk_bf16(v[2], v[3]); w.z = pk_bf16(v[4], v[5]); w.w = pk_bf16(v[6], v[7]);
                *(u32x4*)rowp = w;
            }
    }
};
struct EpiBf16 {
    static constexpr bool PERM = true;
    bf16_t* O; int ldc;
    __device__ __forceinline__ void operator()(const f32x4 (&acc)[2][2][4][2], const pg8::Unit& u, int wr, int wc, int fr, int fq) const {
        const int row0 = u.pm * 256 + wr * 64 + fr, col0 = u.pn * 256 + wc * 32 + 8 * fq;
#pragma unroll
        for (int ai = 0; ai < 2; ++ai)
#pragma unroll
            for (int m = 0; m < 4; ++m) {
                bf16_t* rowp = O + (size_t)(row0 + ai * 128 + m * 16) * ldc + col0;
#pragma unroll
                for (int bj = 0; bj < 2; ++bj) {
                    const f32x4 v0 = acc[ai][bj][m][0], v1 = acc[ai][bj][m][1];
                    u32x4 w; w.x = pk_bf16(v0[0], v0[1]); w.y = pk_bf16(v0[2], v0[3]); w.z = pk_bf16(v1[0], v1[1]); w.w = pk_bf16(v1[2], v1[3]);
                    *(u32x4*)(rowp + bj * 128) = w;
                }
            }
    }
};
struct EpiProj {
    static constexpr bool PERM = true;
    bf16_t* Oa; bf16_t* ObT;
    __device__ __forceinline__ void operator()(const f32x4 (&acc)[2][2][4][2], const pg8::Unit& u, int wr, int wc, int fr, int fq) const {
        const int row0 = u.pm * 256 + wr * 64 + fr;
        if (u.pn < 4) {
            const int col0 = u.pn * 256 + wc * 32 + 8 * fq;
#pragma unroll
            for (int ai = 0; ai < 2; ++ai)
#pragma unroll
                for (int m = 0; m < 4; ++m) {
                    bf16_t* rowp = Oa + (size_t)(row0 + ai * 128 + m * 16) * 1024 + col0;
#pragma unroll
                    for (int bj = 0; bj < 2; ++bj) {
                        const f32x4 v0 = acc[ai][bj][m][0], v1 = acc[ai][bj][m][1];
                        u32x4 w; w.x = pk_bf16(v0[0], v0[1]); w.y = pk_bf16(v0[2], v0[3]); w.z = pk_bf16(v1[0], v1[1]); w.w = pk_bf16(v1[2], v1[3]);
                        *(u32x4*)(rowp + bj * 128) = w;
                    }
                }
        } else {
            const int seq = (u.pm * 256) >> 14;
            const int c0 = (u.pn - 4) * 256 + wc * 32 + 8 * fq;
#pragma unroll
            for (int ai = 0; ai < 2; ++ai)
#pragma unroll
                for (int m = 0; m < 4; ++m) {
                    const int nn = (row0 + ai * 128 + m * 16) & (L - 1);
#pragma unroll
                    for (int bj = 0; bj < 2; ++bj)
#pragma unroll
                        for (int n = 0; n < 2; ++n)
#pragma unroll
                            for (int j = 0; j < 4; ++j)
                                ObT[((size_t)(seq * 1536 + c0 + bj * 128 + 4 * n + j) << 14) + nn] = f2bf(acc[ai][bj][m][n][j]);
                }
        }
    }
};
template <bool SRC_F32> struct EpiResid {
    static constexpr bool PERM = true;
    const float* xs0; const float* xs1; const bf16_t* xbs; bf16_t* xbo; const float* gate; float scale;
    __device__ __forceinline__ void operator()(const f32x4 (&acc)[2][2][4][2], const pg8::Unit& u, int wr, int wc, int fr, int fq) const {
        const int row0 = u.pm * 256 + wr * 64 + fr, col0 = u.pn * 256 + wc * 32 + 8 * fq;
        const int seq = (u.pm * 256) >> 14;
        const float* gb = gate + seq * 9216 + col0;
        const float* sf = (seq < 2 ? xs0 + (size_t)row0 * 1024 : xs1 + (size_t)(row0 - 32768) * 1024) + col0;
        const size_t ob = (size_t)row0 * 1024 + col0;
#pragma unroll
        for (int bj = 0; bj < 2; ++bj) {
            const f32x4 g0 = *(const f32x4*)(gb + bj * 128) * scale, g1 = *(const f32x4*)(gb + bj * 128 + 4) * scale;
            f32x4 x0[2][4], x1[2][4]; u32x4 q[2][4];
#pragma unroll
            for (int ai = 0; ai < 2; ++ai)
#pragma unroll
                for (int m = 0; m < 4; ++m) {
                    const size_t off = (size_t)(ai * 128 + m * 16) * 1024 + bj * 128;
                    if (SRC_F32) { x0[ai][m] = *(const f32x4*)(sf + off); x1[ai][m] = *(const f32x4*)(sf + off + 4); }
                    else q[ai][m] = *(const u32x4*)(xbs + ob + off);
                }
#pragma unroll
            for (int ai = 0; ai < 2; ++ai)
#pragma unroll
                for (int m = 0; m < 4; ++m) {
                    const size_t off = (size_t)(ai * 128 + m * 16) * 1024 + bj * 128;
                    f32x4 a0, a1;
                    if (SRC_F32) { a0 = x0[ai][m]; a1 = x1[ai][m]; }
                    else { const u32x4 t = q[ai][m]; a0 = (f32x4){bf_lo(t.x), bf_hi(t.x), bf_lo(t.y), bf_hi(t.y)}; a1 = (f32x4){bf_lo(t.z), bf_hi(t.z), bf_lo(t.w), bf_hi(t.w)}; }
                    const f32x4 y0 = a0 + g0 * acc[ai][bj][m][0], y1 = a1 + g1 * acc[ai][bj][m][1];
                    u32x4 w; w.x = pk_bf16(y0[0], y0[1]); w.y = pk_bf16(y0[2], y0[3]); w.z = pk_bf16(y1[0], y1[1]); w.w = pk_bf16(y1[2], y1[3]);
                    *(u32x4*)(xbo + ob + off) = w;
                }
        }
    }
};

struct WTile { const float* src; bf16_t* dst; int K, N, k0, np0, n0; };
__device__ __forceinline__ WTile wtile_desc(const Args& a, int ti) {
    unsigned char* ws = a.ws;
    WTile t; int mode = 0, lt;
    if (ti < 5632) { const int mi = ti / 1408; lt = ti % 1408; t.src = a.in[7] + (size_t)mi * 1024 * 5632; t.dst = (bf16_t*)(ws + WS_WIN) + (size_t)mi * 5632 * 1024; t.K = 1024; t.N = 5632; mode = 1; }
    else if (ti < 8448) { const int mi = (ti - 5632) / 704; lt = (ti - 5632) % 704; t.src = a.in[8] + (size_t)mi * 2816 * 1024; t.dst = (bf16_t*)(ws + WS_WOUT) + (size_t)mi * 1024 * 2816; t.K = 2816; t.N = 1024; }
    else if (ti < 9088) { lt = ti - 8448; t.src = a.in[10]; t.dst = (bf16_t*)(ws + WS_WABIN); t.K = 1024; t.N = 2560; }
    else if (ti < 9344) { lt = ti - 9088; t.src = a.in[24]; t.dst = (bf16_t*)(ws + WS_WABOUT); t.K = 1024; t.N = 1024; }
    else if (ti < 9728) { lt = ti - 9344; t.src = a.in[25]; t.dst = (bf16_t*)(ws + WS_WQKV); t.K = 1024; t.N = 1536; }
    else { lt = ti - 9728; t.src = a.in[27]; t.dst = (bf16_t*)(ws + WS_WATTO); t.K = 1024; t.N = 1024; }
    const int nkt = t.K / 64;
    const int kt = lt % nkt, ntp = lt / nkt;
    t.k0 = kt * 64; t.np0 = ntp * 64; t.n0 = t.np0;
    if (mode == 1) { const int pn = t.np0 >> 8, bj = (t.np0 >> 7) & 1, c0 = t.np0 & 127; t.n0 = bj * DFF + 128 * pn + c0; }
    return t;
}
__device__ void convert_weights(const Args& a, LAS float* tile) {
    const int tid = opaque_tid();
    for (int base = blockIdx.x; base < 9984; base += 4 * gridDim.x) {
        __syncthreads();
        float v[4][8];
#pragma unroll
        for (int q = 0; q < 4; ++q) {
            const int ti = base + q * gridDim.x;
            if (ti < 9984) { const WTile t = wtile_desc(a, ti);
#pragma unroll
                for (int i = 0; i < 8; ++i) { const int k = (tid >> 6) + 8 * i, n = tid & 63; v[q][i] = t.src[(size_t)(t.k0 + k) * t.N + t.n0 + n]; } }
        }
#pragma unroll
        for (int q = 0; q < 4; ++q)
#pragma unroll
            for (int i = 0; i < 8; ++i) { const int k = (tid >> 6) + 8 * i, n = tid & 63; tile[q * 4160 + k * 65 + n] = v[q][i]; }
        __syncthreads();
#pragma unroll
        for (int q = 0; q < 4; ++q) {
            const int ti = base + q * gridDim.x;
            if (ti < 9984) { const WTile t = wtile_desc(a, ti);
                const int nn = tid >> 3, kk = (tid & 7) * 8;
                float x[8];
#pragma unroll
                for (int j = 0; j < 8; ++j) x[j] = tile[q * 4160 + (kk + j) * 65 + nn];
                u32x4 w; w.x = pk_bf16(x[0], x[1]); w.y = pk_bf16(x[2], x[3]); w.z = pk_bf16(x[4], x[5]); w.w = pk_bf16(x[6], x[7]);
                *(u32x4*)(t.dst + (size_t)(t.np0 + nn) * t.K + t.k0 + kk) = w; }
        }
    }
    __syncthreads();
}

__device__ void ada_phase(const Args& a, LAS float* lf) {
    const int tid = opaque_tid(), lane = tid & 63, w = tid >> 6;
    LAS float* cs = lf; LAS float* red = lf + 3072;
    float* mod = (float*)(a.ws + WS_MOD);
    __syncthreads();
    for (int i = tid; i < 3072; i += 512) { const int s = i >> 10, k = i & 1023; const float c = s < 2 ? a.in[2][s * 1024 + k] : a.in[3][k]; cs[i] = c * fsigmoid(c); }
    __syncthreads();
    for (int item = blockIdx.x; item < 1152; item += gridDim.x) {
        const int layer = item / 576, cgp = item % 576, cl = lane & 15, ks = lane >> 4, col = cgp * 16 + cl;
        const float* W = a.in[4] + (size_t)layer * 1024 * 9216 + col;
        const int kb = (w * 4 + ks) * 32;
        float a0 = 0.f, a1 = 0.f, a2 = 0.f;
#pragma unroll 16
        for (int k = kb; k < kb + 32; ++k) { const float wv = W[(size_t)k * 9216]; a0 += cs[k] * wv; a1 += cs[1024 + k] * wv; a2 += cs[2048 + k] * wv; }
        a0 += __shfl_xor(a0, 16); a0 += __shfl_xor(a0, 32); a1 += __shfl_xor(a1, 16); a1 += __shfl_xor(a1, 32); a2 += __shfl_xor(a2, 16); a2 += __shfl_xor(a2, 32);
        if (lane < 16) { red[(w * 3 + 0) * 16 + cl] = a0; red[(w * 3 + 1) * 16 + cl] = a1; red[(w * 3 + 2) * 16 + cl] = a2; }
        __syncthreads();
        if (tid < 48) { const int s = tid >> 4, c = tid & 15; float sum = 0.f;
#pragma unroll
            for (int ww = 0; ww < 8; ++ww) sum += red[(ww * 3 + s) * 16 + c];
            mod[(size_t)(layer * 3 + s) * 9216 + cgp * 16 + c] = sum + a.in[5][layer * 9216 + cgp * 16 + c]; }
        __syncthreads();
    }
}

__device__ void filter_phase(const Args& a, LAS float* lf) {
    const int tid = opaque_tid();
    LAS float* feats = lf;
    LAS float* h1 = lf + 64 * 33;
    LAS float* h2T = h1 + 64 * 65;
    const float* w1 = a.in[17]; const float* b1 = a.in[18]; const float* w2 = a.in[19]; const float* b2 = a.in[20]; const float* w3 = a.in[21]; const float* fr = a.in[22];
    half_t* KT = (half_t*)(a.ws + WS_KT);
    for (int item = blockIdx.x; item < 256; item += gridDim.x) {
        const int p0 = item * 64;
        __syncthreads();
        for (int idx = tid; idx < 64 * 33; idx += 512) {
            const int pos = idx / 33, f = idx % 33, n = p0 + pos; float v;
            if (f == 0) v = (float)n / (float)(L - 1);
            else { const int b = (f - 1) & 15; const double band = 1e-4 + (double)b * ((15.0 - 1e-4) / 15.0); double rev = (double)n * band / (double)L; rev -= floor(rev);
                   v = (f <= 16) ? __builtin_amdgcn_cosf((float)rev) : -__builtin_amdgcn_sinf((float)rev); }
            feats[idx] = v;
        }
        __syncthreads();
        { const int pos = tid >> 3, j0 = (tid & 7) * 8; float acc[8];
#pragma unroll
          for (int j = 0; j < 8; ++j) acc[j] = b1[j0 + j];
#pragma unroll 3
          for (int f = 0; f < 33; ++f) { const float x = feats[pos * 33 + f];
#pragma unroll
              for (int j = 0; j < 8; ++j) acc[j] += x * w1[f * 64 + j0 + j]; }
#pragma unroll
          for (int j = 0; j < 8; ++j) h1[pos * 65 + j0 + j] = hw_sin(fr[j0 + j] * acc[j]); }
        __syncthreads();
        { const int pos = tid >> 3, j0 = (tid & 7) * 8; float acc[8];
#pragma unroll
          for (int j = 0; j < 8; ++j) acc[j] = b2[j0 + j];
#pragma unroll 4
          for (int i = 0; i < 64; ++i) { const float x = h1[pos * 65 + i];
#pragma unroll
              for (int j = 0; j < 8; ++j) acc[j] += x * w2[i * 64 + j0 + j]; }
#pragma unroll
          for (int j = 0; j < 8; ++j) h2T[(j0 + j) * 64 + pos] = hw_sin(fr[j0 + j] * acc[j]); }
        __syncthreads();
        const int col0 = tid * 4;
        const int dir = col0 >> 10, ord = (col0 >> 9) & 1, ch0 = col0 & 511;
#pragma unroll 1
        for (int chunk = 0; chunk < 4; ++chunk) {
            float acc[16][4];
#pragma unroll
            for (int p = 0; p < 16; ++p)
#pragma unroll
                for (int c = 0; c < 4; ++c) acc[p][c] = 0.f;
#pragma unroll 2
            for (int j = 0; j < 64; ++j) {
                const f32x4 wv = *(const f32x4*)(w3 + j * 2048 + col0);
                f32x4 hv[4];
#pragma unroll
                for (int q = 0; q < 4; ++q) hv[q] = *(const LAS f32x4*)(h2T + j * 64 + chunk * 16 + q * 4);
#pragma unroll
                for (int p = 0; p < 16; ++p)
#pragma unroll
                    for (int c = 0; c < 4; ++c) acc[p][c] += hv[p >> 2][p & 3] * wv[c];
            }
#pragma unroll
            for (int c = 0; c < 4; ++c) {
                const int ch = ch0 + c;
                const float delta = 3.0701134573253945f + (float)ch * (12.280453829301578f / 511.0f);
                half_t* dstp = KT + ((size_t)((ord * 512 + ch) * 2 + dir) << 14) + p0 + chunk * 16;
                unsigned pk[8];
#pragma unroll
                for (int p = 0; p < 16; p += 2) {
                    const float t0 = (float)(p0 + chunk * 16 + p) / (float)(L - 1), t1 = (float)(p0 + chunk * 16 + p + 1) / (float)(L - 1);
                    const half_t x0 = (half_t)(acc[p][c] * __expf(-t0 * delta)), x1 = (half_t)(acc[p + 1][c] * __expf(-t1 * delta));
                    pk[p >> 1] = (unsigned)__builtin_bit_cast(unsigned short, x0) | ((unsigned)__builtin_bit_cast(unsigned short, x1) << 16);
                }
                *(u32x4*)dstp = (u32x4){pk[0], pk[1], pk[2], pk[3]};
                *(u32x4*)(dstp + 8) = (u32x4){pk[4], pk[5], pk[6], pk[7]};
            }
        }
    }
    __syncthreads();
}

template <bool SRC_F32> __device__ void norm_phase(const float* xs0, const float* xs1, const bf16_t* xb, const float* g, const float* sh, const float* sc, bf16_t* h) {
    constexpr int NR = SRC_F32 ? 2 : 4;
    const int tid_ = opaque_tid(); const int lane = tid_ & 63, w = tid_ >> 6;
    f32x4 gg[2][2];
#pragma unroll
    for (int i = 0; i < 2; ++i) { gg[i][0] = *(const f32x4*)(g + i * 512 + lane * 8); gg[i][1] = *(const f32x4*)(g + i * 512 + lane * 8 + 4); }
    for (int rb = (blockIdx.x * 8 + w) * NR; rb < T; rb += gridDim.x * 8 * NR) {
        const int seq = rb >> 14;
        f32x4 v[NR][2][2]; u32x4 q[NR][2];
#pragma unroll
        for (int r = 0; r < NR; ++r) {
            const int row = rb + r;
            if (SRC_F32) {
                const float* xr = seq < 2 ? xs0 + (size_t)row * 1024 : xs1 + (size_t)(row - 32768) * 1024;
#pragma unroll
                for (int i = 0; i < 2; ++i) { v[r][i][0] = *(const f32x4*)(xr + i * 512 + lane * 8); v[r][i][1] = *(const f32x4*)(xr + i * 512 + lane * 8 + 4); }
            } else {
#pragma unroll
                for (int i = 0; i < 2; ++i) q[r][i] = *(const u32x4*)(xb + (size_t)row * 1024 + i * 512 + lane * 8);
            }
        }
        f32x4 s1[2][2], s0[2][2];
#pragma unroll
        for (int i = 0; i < 2; ++i)
#pragma unroll
            for (int k = 0; k < 2; ++k) { s1[i][k] = *(const f32x4*)(sc + seq * 9216 + i * 512 + lane * 8 + 4 * k) + 1.0f; s0[i][k] = *(const f32x4*)(sh + seq * 9216 + i * 512 + lane * 8 + 4 * k); }
#pragma unroll
        for (int r = 0; r < NR; ++r) {
            const int row = rb + r;
            if (!SRC_F32) {
#pragma unroll
                for (int i = 0; i < 2; ++i) { const u32x4 t = q[r][i]; v[r][i][0] = (f32x4){bf_lo(t.x), bf_hi(t.x), bf_lo(t.y), bf_hi(t.y)}; v[r][i][1] = (f32x4){bf_lo(t.z), bf_hi(t.z), bf_lo(t.w), bf_hi(t.w)}; }
            }
            float ss = 0.f;
#pragma unroll
            for (int i = 0; i < 2; ++i)
#pragma unroll
                for (int k = 0; k < 2; ++k) ss += v[r][i][k][0] * v[r][i][k][0] + v[r][i][k][1] * v[r][i][k][1] + v[r][i][k][2] * v[r][i][k][2] + v[r][i][k][3] * v[r][i][k][3];
#pragma unroll
            for (int o = 32; o > 0; o >>= 1) ss += __shfl_xor(ss, o);
            const float rstd = rsqrtf(ss * (1.0f / 1024.0f) + EPS);
#pragma unroll
            for (int i = 0; i < 2; ++i) {
                const f32x4 y0 = v[r][i][0] * rstd * gg[i][0] * s1[i][0] + s0[i][0], y1 = v[r][i][1] * rstd * gg[i][1] * s1[i][1] + s0[i][1];
                u32x4 o; o.x = pk_bf16(y0[0], y0[1]); o.y = pk_bf16(y0[2], y0[3]); o.z = pk_bf16(y1[0], y1[1]); o.w = pk_bf16(y1[2], y1[3]);
                *(u32x4*)(h + (size_t)row * 1024 + i * 512 + lane * 8) = o;
            }
        }
    }
}
__device__ void final_norm_phase(const bf16_t* xb, float* out, const float* g) {
    constexpr int NR = 4;
    const int tid_ = opaque_tid(); const int lane = tid_ & 63, w = tid_ >> 6;
    f32x4 gg[2][2];
#pragma unroll
    for (int i = 0; i < 2; ++i) { gg[i][0] = *(const f32x4*)(g + i * 512 + lane * 8); gg[i][1] = *(const f32x4*)(g + i * 512 + lane * 8 + 4); }
    for (int rb = (blockIdx.x * 8 + w) * NR; rb < T; rb += gridDim.x * 8 * NR) {
        u32x4 q[NR][2];
#pragma unroll
        for (int r = 0; r < NR; ++r)
#pragma unroll
            for (int i = 0; i < 2; ++i) q[r][i] = *(const u32x4*)(xb + (size_t)(rb + r) * 1024 + i * 512 + lane * 8);
#pragma unroll
        for (int r = 0; r < NR; ++r) {
            f32x4 v[2][2]; float ss = 0.f;
#pragma unroll
            for (int i = 0; i < 2; ++i) { const u32x4 t = q[r][i]; v[i][0] = (f32x4){bf_lo(t.x), bf_hi(t.x), bf_lo(t.y), bf_hi(t.y)}; v[i][1] = (f32x4){bf_lo(t.z), bf_hi(t.z), bf_lo(t.w), bf_hi(t.w)}; }
#pragma unroll
            for (int i = 0; i < 2; ++i)
#pragma unroll
                for (int k = 0; k < 2; ++k) ss += v[i][k][0] * v[i][k][0] + v[i][k][1] * v[i][k][1] + v[i][k][2] * v[i][k][2] + v[i][k][3] * v[i][k][3];
#pragma unroll
            for (int o = 32; o > 0; o >>= 1) ss += __shfl_xor(ss, o);
            const float rstd = rsqrtf(ss * (1.0f / 1024.0f) + EPS);
#pragma unroll
            for (int i = 0; i < 2; ++i)
#pragma unroll
                for (int k = 0; k < 2; ++k) *(f32x4*)(out + (size_t)(rb + r) * 1024 + i * 512 + lane * 8 + 4 * k) = v[i][k] * rstd * gg[i][k];
        }
    }
}

__device__ void conva_phase(const Args& a, const bf16_t* pa, bf16_t* cat, LAS unsigned char* lds) {
    const int tid = opaque_tid(), lane = tid & 63, w = tid >> 6;
    LAS bf16_t* glu = (LAS bf16_t*)lds;
    LAS float* stage = (LAS float*)(lds + 94 * 512 * 2);
    const float* cw = a.in[11]; const float* cb = a.in[12]; const float* lg = a.in[13]; const float* lb = a.in[14];
    float wt[31];
#pragma unroll
    for (int j = 0; j < 31; ++j) wt[j] = cw[j * 512 + tid];
    const float bias = cb[tid];
    float lgv[8], lbv[8];
#pragma unroll
    for (int i = 0; i < 8; ++i) { lgv[i] = lg[lane + 64 * i]; lbv[i] = lb[lane + 64 * i]; }
    for (int tile = blockIdx.x; tile < 768; tile += gridDim.x) {
        const int seq = tile >> 8, t0 = (tile & 255) * 64;
        __syncthreads();
#pragma unroll 1
        for (int ib = 0; ib < 3; ++ib) {
            u32x4 x1[4], x2[4];
#pragma unroll
            for (int k = 0; k < 4; ++k) {
                const int idx = tid + 512 * (4 * ib + k); const int r = idx >> 6, cc = idx & 63, t = t0 - 15 + r;
                x1[k] = (u32x4){0u, 0u, 0u, 0u}; x2[k] = x1[k];
                if (idx < 94 * 64 && t >= 0 && t < L) { const bf16_t* rp = pa + (size_t)(seq * L + t) * 1024 + cc * 8; x1[k] = *(const u32x4*)rp; x2[k] = *(const u32x4*)(rp + 512); }
            }
#pragma unroll
            for (int k = 0; k < 4; ++k) {
                const int idx = tid + 512 * (4 * ib + k); const int r = idx >> 6, cc = idx & 63;
                u32x4 res;
#pragma unroll
                for (int q = 0; q < 4; ++q) res[q] = pk_bf16(bf_lo(x1[k][q]) * fsigmoid(bf_lo(x2[k][q])), bf_hi(x1[k][q]) * fsigmoid(bf_hi(x2[k][q])));
                if (idx < 94 * 64) *(LAS u32x4*)(glu + r * 512 + cc * 8) = res;
            }
        }
        __syncthreads();
        for (int chunk = 0; chunk < 8; ++chunk) {
            float o[8];
#pragma unroll
            for (int tt = 0; tt < 8; ++tt) o[tt] = bias;
#pragma unroll
            for (int i = 0; i < 38; ++i) {
                const float x = bf2f(glu[(chunk * 8 + i) * 512 + tid]);
#pragma unroll
                for (int tt = 0; tt < 8; ++tt) { const int j = i - tt; if (j >= 0 && j < 31) o[tt] += wt[j] * x; }
            }
#pragma unroll
            for (int tt = 0; tt < 8; ++tt) stage[tt * 512 + tid] = o[tt];
            __syncthreads();
            {
                float v[8]; float s = 0.f;
#pragma unroll
                for (int i = 0; i < 8; ++i) { v[i] = stage[w * 512 + lane + 64 * i]; s += v[i]; }
#pragma unroll
                for (int of = 32; of > 0; of >>= 1) s += __shfl_xor(s, of);
                const float mean = s * (1.0f / 512.0f);
                float q = 0.f;
#pragma unroll
                for (int i = 0; i < 8; ++i) { const float d = v[i] - mean; q += d * d; }
#pragma unroll
                for (int of = 32; of > 0; of >>= 1) q += __shfl_xor(q, of);
                const float rstd = rsqrtf(q * (1.0f / 512.0f) + EPS);
                bf16_t* op = cat + (size_t)(seq * L + t0 + chunk * 8 + w) * 1024;
#pragma unroll
                for (int i = 0; i < 8; ++i) { const float y = (v[i] - mean) * rstd * lgv[i] + lbv[i]; op[lane + 64 * i] = f2bf(y * fsigmoid(y)); }
            }
            __syncthreads();
        }
    }
    __syncthreads();
}

typedef float v2 __attribute__((ext_vector_type(2)));
__device__ __forceinline__ int fphys(int i) { return i + ((i >> 6) << 2); }
struct C2 { v2 r, i; };
__device__ __forceinline__ C2 cmul2(const C2& a, const C2& b) { C2 o; o.r = a.r * b.r - a.i * b.i; o.i = a.r * b.i + a.i * b.r; return o; }
__device__ __forceinline__ C2 cmulc(const C2& a, float cr, float ci) { C2 o; o.r = a.r * cr - a.i * ci; o.i = a.r * ci + a.i * cr; return o; }
template <bool INV> __device__ __forceinline__ void bf4(C2& a, C2& b, C2& c, C2& d) {
    C2 t0, t1, t2, e, t3;
    t0.r = a.r + c.r; t0.i = a.i + c.i; t1.r = a.r - c.r; t1.i = a.i - c.i; t2.r = b.r + d.r; t2.i = b.i + d.i; e.r = b.r - d.r; e.i = b.i - d.i;
    if (INV) { t3.r = -e.i; t3.i = e.r; } else { t3.r = e.i; t3.i = -e.r; }
    a.r = t0.r + t2.r; a.i = t0.i + t2.i; b.r = t1.r + t3.r; b.i = t1.i + t3.i; c.r = t0.r - t2.r; c.i = t0.i - t2.i; d.r = t1.r - t3.r; d.i = t1.i - t3.i;
}
template <bool INV, int K16> __device__ __forceinline__ C2 mulc16(const C2& a) {
    constexpr float cs[10] = {1.0f, 0.92387953251128674f, 0.70710678118654752f, 0.38268343236508977f, 0.0f, -0.38268343236508977f, -0.70710678118654752f, -0.92387953251128674f, -1.0f, -0.92387953251128674f};
    constexpr float sn[10] = {0.0f, 0.38268343236508977f, 0.70710678118654752f, 0.92387953251128674f, 1.0f, 0.92387953251128674f, 0.70710678118654752f, 0.38268343236508977f, 0.0f, -0.38268343236508977f};
    if (K16 == 4) { C2 o; if (INV) { o.r = -a.i; o.i = a.r; } else { o.r = a.i; o.i = -a.r; } return o; }
    return cmulc(a, cs[K16], INV ? sn[K16] : -sn[K16]);
}
template <bool INV, int LOGQ> __device__ __forceinline__ void r16_pass(LAS float* Fre, LAS float* Fim, int tid) {
    constexpr int Q = 1 << LOGQ;
    constexpr int PSTR = (Q >= 64) ? (Q + (Q >> 4)) : Q;
    const int b0 = 2 * tid, pos0 = b0 & (Q - 1), grp = b0 >> LOGQ, base = (grp << (LOGQ + 4)) + pos0;
    const int p = fphys(base);
    C2 x[16];
#pragma unroll
    for (int r = 0; r < 16; ++r) { x[r].r = *(const LAS v2*)(Fre + p + r * PSTR); x[r].i = *(const LAS v2*)(Fim + p + r * PSTR); }
    int posv = pos0; asm volatile("" : "+v"(posv));
    const float rev0 = (float)posv * (1.0f / (float)(16 * Q)), rev1 = (float)(posv + 1) * (1.0f / (float)(16 * Q));
    C2 w1; w1.r = (v2){__builtin_amdgcn_cosf(rev0), __builtin_amdgcn_cosf(rev1)};
    { const v2 sn = (v2){__builtin_amdgcn_sinf(rev0), __builtin_amdgcn_sinf(rev1)}; w1.i = INV ? sn : -sn; }
    const C2 w2 = cmul2(w1, w1), w3 = cmul2(w2, w1), w4 = cmul2(w2, w2), w8 = cmul2(w4, w4), w12 = cmul2(w8, w4);
    if (!INV) {
#pragma unroll
        for (int j = 0; j < 4; ++j) {
            bf4<false>(x[j], x[j + 4], x[j + 8], x[j + 12]);
            x[j + 4] = cmul2(x[j + 4], w1); x[j + 8] = cmul2(x[j + 8], w2); x[j + 12] = cmul2(x[j + 12], w3);
        }
        x[5] = mulc16<false, 1>(x[5]); x[9] = mulc16<false, 2>(x[9]); x[13] = mulc16<false, 3>(x[13]);
        x[6] = mulc16<false, 2>(x[6]); x[10] = mulc16<false, 4>(x[10]); x[14] = mulc16<false, 6>(x[14]);
        x[7] = mulc16<false, 3>(x[7]); x[11] = mulc16<false, 6>(x[11]); x[15] = mulc16<false, 9>(x[15]);
#pragma unroll
        for (int r = 0; r < 4; ++r) {
            bf4<false>(x[4 * r], x[4 * r + 1], x[4 * r + 2], x[4 * r + 3]);
            x[4 * r + 1] = cmul2(x[4 * r + 1], w4); x[4 * r + 2] = cmul2(x[4 * r + 2], w8); x[4 * r + 3] = cmul2(x[4 * r + 3], w12);
        }
    } else {
#pragma unroll
        for (int r = 0; r < 4; ++r) {
            x[4 * r + 1] = cmul2(x[4 * r + 1], w4); x[4 * r + 2] = cmul2(x[4 * r + 2], w8); x[4 * r + 3] = cmul2(x[4 * r + 3], w12);
            bf4<true>(x[4 * r], x[4 * r + 1], x[4 * r + 2], x[4 * r + 3]);
        }
        x[5] = mulc16<true, 1>(x[5]); x[9] = mulc16<true, 2>(x[9]); x[13] = mulc16<true, 3>(x[13]);
        x[6] = mulc16<true, 2>(x[6]); x[10] = mulc16<true, 4>(x[10]); x[14] = mulc16<true, 6>(x[14]);
        x[7] = mulc16<true, 3>(x[7]); x[11] = mulc16<true, 6>(x[11]); x[15] = mulc16<true, 9>(x[15]);
#pragma unroll
        for (int j = 0; j < 4; ++j) {
            x[j + 4] = cmul2(x[j + 4], w1); x[j + 8] = cmul2(x[j + 8], w2); x[j + 12] = cmul2(x[j + 12], w3);
            bf4<true>(x[j], x[j + 4], x[j + 8], x[j + 12]);
        }
    }
#pragma unroll
    for (int r = 0; r < 16; ++r) { *(LAS v2*)(Fre + p + r * PSTR) = x[r].r; *(LAS v2*)(Fim + p + r * PSTR) = x[r].i; }
}
template <bool INV> __device__ __forceinline__ void r4_pass(LAS float* Fre, LAS float* Fim, int tid) {
#pragma unroll 2
    for (int bi = 0; bi < 4; ++bi) {
        const int p = fphys(8 * (tid + 512 * bi));
        const f32x4 ra = *(const LAS f32x4*)(Fre + p), rb = *(const LAS f32x4*)(Fre + p + 4), ia = *(const LAS f32x4*)(Fim + p), ib = *(const LAS f32x4*)(Fim + p + 4);
        C2 x0, x1, x2, x3;
        x0.r = (v2){ra[0], rb[0]}; x1.r = (v2){ra[1], rb[1]}; x2.r = (v2){ra[2], rb[2]}; x3.r = (v2){ra[3], rb[3]};
        x0.i = (v2){ia[0], ib[0]}; x1.i = (v2){ia[1], ib[1]}; x2.i = (v2){ia[2], ib[2]}; x3.i = (v2){ia[3], ib[3]};
        bf4<INV>(x0, x1, x2, x3);
        *(LAS f32x4*)(Fre + p) = (f32x4){x0.r[0], x1.r[0], x2.r[0], x3.r[0]}; *(LAS f32x4*)(Fre + p + 4) = (f32x4){x0.r[1], x1.r[1], x2.r[1], x3.r[1]};
        *(LAS f32x4*)(Fim + p) = (f32x4){x0.i[0], x1.i[0], x2.i[0], x3.i[0]}; *(LAS f32x4*)(Fim + p + 4) = (f32x4){x0.i[1], x1.i[1], x2.i[1], x3.i[1]};
    }
}
__device__ __forceinline__ void fft_fwd(LAS float* Fre, LAS float* Fim, int tid) {
    r16_pass<false, 10>(Fre, Fim, tid); __syncthreads(); r16_pass<false, 6>(Fre, Fim, tid); __syncthreads(); r16_pass<false, 2>(Fre, Fim, tid); __syncthreads(); r4_pass<false>(Fre, Fim, tid);
}
__device__ __forceinline__ void fft_inv(LAS float* Fre, LAS float* Fim, int tid) {
    r4_pass<true>(Fre, Fim, tid); __syncthreads(); r16_pass<true, 2>(Fre, Fim, tid); __syncthreads(); r16_pass<true, 6>(Fre, Fim, tid); __syncthreads(); r16_pass<true, 10>(Fre, Fim, tid);
}
typedef _Float16 h8v __attribute__((ext_vector_type(8)));
__device__ __forceinline__ void sconv8(const bf16_t* row, int n0, float w0, float w1, float w2, float b, float (&out)[8]) {
    const u32x4 q = *(const u32x4*)(row + n0);
    float x[10];
    x[0] = n0 > 0 ? bf2f(row[n0 - 1]) : 0.f;
    x[9] = n0 + 8 < L ? bf2f(row[n0 + 8]) : 0.f;
#pragma unroll
    for (int i = 0; i < 4; ++i) { x[1 + 2 * i] = bf_lo(q[i]); x[2 + 2 * i] = bf_hi(q[i]); }
#pragma unroll
    for (int e = 0; e < 8; ++e) out[e] = b + w0 * x[e] + w1 * x[e + 1] + w2 * x[e + 2];
}
template <bool CONJ> __device__ __forceinline__ void tw8(int n0, float (&tr)[8], float (&ti)[8]) {
    const float rev = (float)n0 * (1.0f / (float)(2 * L));
    const float sr = 0.99999998161642933f, si = CONJ ? 1.9174759731070330e-4f : -1.9174759731070330e-4f;
    tr[0] = __builtin_amdgcn_cosf(rev); ti[0] = CONJ ? __builtin_amdgcn_sinf(rev) : -__builtin_amdgcn_sinf(rev);
#pragma unroll
    for (int e = 1; e < 8; ++e) { tr[e] = tr[e - 1] * sr - ti[e - 1] * si; ti[e] = tr[e - 1] * si + ti[e - 1] * sr; }
}
__device__ __forceinline__ void st8(LAS float* p, const float (&v)[8]) { *(LAS f32x4*)p = (f32x4){v[0], v[1], v[2], v[3]}; *(LAS f32x4*)(p + 4) = (f32x4){v[4], v[5], v[6], v[7]}; }
__device__ __forceinline__ void ld8(const LAS float* p, float (&v)[8]) { const f32x4 a = *(const LAS f32x4*)p, b = *(const LAS f32x4*)(p + 4);
#pragma unroll
    for (int e = 0; e < 4; ++e) { v[e] = a[e]; v[4 + e] = b[e]; } }
template <bool DRY> __device__ void fft_phase(const Args& a, bf16_t* pbT, LAS unsigned char* lds) {
    const int tid = opaque_tid(), lane = tid & 63, w = tid >> 6;
    LAS float* Fre = (LAS float*)lds; LAS float* Fim = Fre + 17408;
    LAS float* red = (LAS float*)(lds + 17408 * 8);
    const int po = fphys(8 * tid);
    const half_t* KT = (const half_t*)(a.ws + WS_KT);
    unsigned char* scr = a.ws + WS_ACT + PBT_BYTES + (size_t)blockIdx.x * FFTSCR_PER_BLOCK;
    float* ybuf = (float*)scr;
    float* z1buf = (float*)(scr + 2ull * L * 8);
    const float* sw = a.in[15]; const float* sb = a.in[16]; const float* skip = a.in[23];
    for (int ch = blockIdx.x; ch < 512; ch += gridDim.x) {
        const float vw0 = sw[ch], vw1 = sw[1536 + ch], vw2 = sw[3072 + ch], vb = sb[ch];
#pragma unroll 1
        for (int o = 0; o < 2; ++o) {
            const half_t* kf = KT + ((size_t)((o * 512 + ch) * 2) << 14); const half_t* kb = kf + L;
            const int xc = (o == 0 ? 512 : 1024) + ch;
            const float gw0 = sw[xc], gw1 = sw[1536 + xc], gw2 = sw[3072 + xc], gb = sb[xc];
            const float skp = skip[o * 512 + ch];
            float ss = 0.f;
#pragma unroll 1
            for (int g = 0; g < 4; ++g) {
                const int n0 = 8 * (tid + 512 * g);
                const h8v f = *(const h8v*)(kf + n0), bk = *(const h8v*)(kb + n0);
#pragma unroll
                for (int e = 0; e < 8; ++e) { const float ff = (float)f[e], bb = (n0 + e > 0) ? (float)bk[e] : 0.f; ss += ff * ff + bb * bb; }
            }
#pragma unroll
            for (int of = 32; of > 0; of >>= 1) ss += __shfl_xor(ss, of);
            __syncthreads();
            if (lane == 0) red[w] = ss;
            __syncthreads();
            float tot = 0.f;
#pragma unroll
            for (int ww = 0; ww < 8; ++ww) tot += red[ww];
            const float kscale = rsqrtf(tot + EPS) * (0.5f / (float)L);
#pragma unroll 1
            for (int br = 0; br < 2; ++br) {
                __syncthreads();
#pragma unroll 1
                for (int g = 0; g < 4; ++g) {
                    const int n0 = 8 * (tid + 512 * g);
                    const h8v f = *(const h8v*)(kf + n0), bc = *(const h8v*)(kb + (L - 8 - n0));
                    const float b0 = n0 > 0 ? (float)kb[L - n0] : 0.f;
                    float d[8], vr[8], vi[8];
#pragma unroll
                    for (int e = 0; e < 8; ++e) { const float bk = (e == 0) ? b0 : (float)bc[8 - e]; d[e] = (br == 0 ? (float)f[e] + bk : (float)f[e] - bk) * kscale; }
                    if (br == 0) {
#pragma unroll
                        for (int e = 0; e < 8; ++e) { vr[e] = d[e]; vi[e] = 0.f; }
                    } else {
                        float tr[8], ti[8]; tw8<false>(n0, tr, ti);
#pragma unroll
                        for (int e = 0; e < 8; ++e) { vr[e] = d[e] * tr[e]; vi[e] = d[e] * ti[e]; }
                    }
                    st8(Fre + po + 4352 * g, vr); st8(Fim + po + 4352 * g, vi);
                }
                __syncthreads();
                fft_fwd(Fre, Fim, tid);
                __syncthreads();
                float KrR[32], KrI[32];
#pragma unroll
                for (int g = 0; g < 4; ++g) {
                    const f32x4 r0 = *(const LAS f32x4*)(Fre + po + 4352 * g), r1 = *(const LAS f32x4*)(Fre + po + 4352 * g + 4), i0 = *(const LAS f32x4*)(Fim + po + 4352 * g), i1 = *(const LAS f32x4*)(Fim + po + 4352 * g + 4);
#pragma unroll
                    for (int e = 0; e < 4; ++e) { KrR[g * 8 + e] = r0[e]; KrR[g * 8 + 4 + e] = r1[e]; KrI[g * 8 + e] = i0[e]; KrI[g * 8 + 4 + e] = i1[e]; }
                }
#pragma unroll 1
                for (int pk = 0; pk < 2; ++pk) {
                    __syncthreads();
#pragma unroll 1
                    for (int g = 0; g < 4; ++g) {
                        const int n0 = 8 * (tid + 512 * g);
                        float re[8], im[8];
                        if (o == 0) {
                            sconv8(pbT + ((size_t)((2 * pk) * 1536 + ch) << 14), n0, vw0, vw1, vw2, vb, re);
                            if (pk == 0) sconv8(pbT + ((size_t)(1536 + ch) << 14), n0, vw0, vw1, vw2, vb, im);
                        } else {
                            const f32x4 r0 = *(const f32x4*)(z1buf + (2 * pk) * L + n0), r1 = *(const f32x4*)(z1buf + (2 * pk) * L + n0 + 4);
#pragma unroll
                            for (int e = 0; e < 4; ++e) { re[e] = r0[e]; re[4 + e] = r1[e]; }
                            if (pk == 0) { const f32x4 i0 = *(const f32x4*)(z1buf + L + n0), i1 = *(const f32x4*)(z1buf + L + n0 + 4);
#pragma unroll
                                for (int e = 0; e < 4; ++e) { im[e] = i0[e]; im[4 + e] = i1[e]; } }
                        }
                        if (pk == 1) {
#pragma unroll
                            for (int e = 0; e < 8; ++e) im[e] = 0.f;
                        }
                        if (br == 1) {
                            float tr[8], ti[8]; tw8<false>(n0, tr, ti);
#pragma unroll
                            for (int e = 0; e < 8; ++e) { const float xr = re[e] * tr[e] - im[e] * ti[e], xi = re[e] * ti[e] + im[e] * tr[e]; re[e] = xr; im[e] = xi; }
                        }
                        st8(Fre + po + 4352 * g, re); st8(Fim + po + 4352 * g, im);
                    }
                    __syncthreads();
                    fft_fwd(Fre, Fim, tid);
                    __syncthreads();
#pragma unroll
                    for (int g = 0; g < 4; ++g) {
                        float xr[8], xi[8], yr[8], yi[8];
                        ld8(Fre + po + 4352 * g, xr); ld8(Fim + po + 4352 * g, xi);
#pragma unroll
                        for (int e = 0; e < 8; ++e) { yr[e] = xr[e] * KrR[g * 8 + e] - xi[e] * KrI[g * 8 + e]; yi[e] = xr[e] * KrI[g * 8 + e] + xi[e] * KrR[g * 8 + e]; }
                        st8(Fre + po + 4352 * g, yr); st8(Fim + po + 4352 * g, yi);
                    }
                    __syncthreads();
                    fft_inv(Fre, Fim, tid);
                    __syncthreads();
#pragma unroll 1
                    for (int g = 0; g < 4; ++g) {
                        const int n0 = 8 * (tid + 512 * g);
                        float rr[8], ri[8];
                        ld8(Fre + po + 4352 * g, rr); ld8(Fim + po + 4352 * g, ri);
                        float* ybr = ybuf + (size_t)pk * 2 * L + n0; float* ybi = ybr + L;
                        if (br == 0) {
                            *(f32x4*)ybr = (f32x4){rr[0], rr[1], rr[2], rr[3]}; *(f32x4*)(ybr + 4) = (f32x4){rr[4], rr[5], rr[6], rr[7]};
                            *(f32x4*)ybi = (f32x4){ri[0], ri[1], ri[2], ri[3]}; *(f32x4*)(ybi + 4) = (f32x4){ri[4], ri[5], ri[6], ri[7]};
                        } else {
                            const f32x4 yr0 = *(const f32x4*)ybr, yr1 = *(const f32x4*)(ybr + 4), yi0 = *(const f32x4*)ybi, yi1 = *(const f32x4*)(ybi + 4);
                            float tr[8], ti[8]; tw8<true>(n0, tr, ti);
                            float yre[8], yim[8];
#pragma unroll
                            for (int e = 0; e < 8; ++e) {
                                yre[e] = (e < 4 ? yr0[e & 3] : yr1[e & 3]) + rr[e] * tr[e] - ri[e] * ti[e];
                                yim[e] = (e < 4 ? yi0[e & 3] : yi1[e & 3]) + rr[e] * ti[e] + ri[e] * tr[e];
                            }
                            const int nseq = (pk == 0) ? 2 : 1;
#pragma unroll 1
                            for (int q = 0; q < nseq; ++q) {
                                const int s = 2 * pk + q;
                                float gate[8];
                                sconv8(pbT + ((size_t)(s * 1536 + xc) << 14), n0, gw0, gw1, gw2, gb, gate);
                                float* zp = z1buf + s * L + n0;
                                if (o == 0) {
                                    float vv[8];
                                    sconv8(pbT + ((size_t)(s * 1536 + ch) << 14), n0, vw0, vw1, vw2, vb, vv);
                                    float z[8];
#pragma unroll
                                    for (int e = 0; e < 8; ++e) z[e] = gate[e] * ((q == 0 ? yre[e] : yim[e]) + vv[e] * skp);
                                    *(f32x4*)zp = (f32x4){z[0], z[1], z[2], z[3]}; *(f32x4*)(zp + 4) = (f32x4){z[4], z[5], z[6], z[7]};
                                } else {
                                    const f32x4 z0 = *(const f32x4*)zp, z1 = *(const f32x4*)(zp + 4);
                                    float z[8];
#pragma unroll
                                    for (int e = 0; e < 8; ++e) z[e] = gate[e] * ((q == 0 ? yre[e] : yim[e]) + (e < 4 ? z0[e & 3] : z1[e & 3]) * skp);
                                    u32x4 wv; wv.x = pk_bf16(z[0], z[1]); wv.y = pk_bf16(z[2], z[3]); wv.z = pk_bf16(z[4], z[5]); wv.w = pk_bf16(z[6], z[7]);
                                    if (!DRY) *(u32x4*)(pbT + ((size_t)(s * 1536 + ch) << 14) + n0) = wv;
                                }
                            }
                        }
                    }
                }
            }
            __syncthreads();
        }
    }
    __syncthreads();
}

__device__ void ztrans_phase(const bf16_t* pbT, bf16_t* cat, LAS unsigned char* lds) {
    const int tid = opaque_tid();
    LAS unsigned* tl = (LAS unsigned*)lds;
    LAS bf16_t* tb = (LAS bf16_t*)lds;
    for (int tile0 = blockIdx.x * 2; tile0 < 6144; tile0 += gridDim.x * 2) {
        __syncthreads();
        u32x4 v[2];
#pragma unroll
        for (int k = 0; k < 2; ++k) { const int tile = tile0 + k; const int tt0 = (tile & 255) * 64, ct = (tile >> 8) & 7, s = tile >> 11; const int cc = tid >> 3, tk = (tid & 7) * 8;
            v[k] = *(const u32x4*)(pbT + ((size_t)(s * 1536 + ct * 64 + cc) << 14) + tt0 + tk); }
#pragma unroll
        for (int k = 0; k < 2; ++k) { const int cc = tid >> 3, tk = (tid & 7) * 8;
#pragma unroll
            for (int q = 0; q < 4; ++q) tl[k * 2112 + cc * 33 + (tk >> 1) + q] = v[k][q]; }
        __syncthreads();
#pragma unroll
        for (int k = 0; k < 2; ++k) { const int tile = tile0 + k; const int tt0 = (tile & 255) * 64, ct = (tile >> 8) & 7, s = tile >> 11;
            const int tt = tid >> 3, cg8 = (tid & 7) * 8; bf16_t e[8];
#pragma unroll
            for (int i = 0; i < 8; ++i) e[i] = tb[k * 4224 + (cg8 + i) * 66 + tt];
            u32x4 wv; wv.x = e[0] | ((unsigned)e[1] << 16); wv.y = e[2] | ((unsigned)e[3] << 16); wv.z = e[4] | ((unsigned)e[5] << 16); wv.w = e[6] | ((unsigned)e[7] << 16);
            *(u32x4*)(cat + (size_t)(s * L + tt0 + tt) * 1024 + 512 + ct * 64 + cg8) = wv; }
    }
    __syncthreads();
}

__device__ void attn_phase(const Args& a, const bf16_t* qkv, bf16_t* ao, LAS unsigned char* lds) {
    const int tid = opaque_tid(), lane = tid & 63, w = tid >> 6, l31 = lane & 31, hh = lane >> 5;
    LAS bf16_t* Ks = (LAS bf16_t*)lds;
    LAS bf16_t* VT = (LAS bf16_t*)(lds + 384 * 72 * 2);
    const float* sink = a.in[26];
    for (int item = blockIdx.x; item < 1536; item += gridDim.x) {
        const int kvh = item & 3, qb = (item >> 2) & 127, seq = item >> 9;
        const int kb0 = qb * 128 - 128;
        __syncthreads();
#pragma unroll 1
        for (int ib = 0; ib < 2; ++ib) {
            u32x4 kv[3], vv[3];
#pragma unroll
            for (int k = 0; k < 3; ++k) {
                const int idx = tid + 512 * (3 * ib + k); const int key = idx % 384, dc = idx / 384, kpos = kb0 + key;
                kv[k] = (u32x4){0u, 0u, 0u, 0u}; vv[k] = kv[k];
                if (kpos >= 0 && kpos < L) { const bf16_t* rp = qkv + (size_t)(seq * L + kpos) * 1536 + kvh * 64 + dc * 8; kv[k] = *(const u32x4*)(rp + 1024); vv[k] = *(const u32x4*)(rp + 1280); }
            }
#pragma unroll
            for (int k = 0; k < 3; ++k) {
                const int idx = tid + 512 * (3 * ib + k); const int key = idx % 384, dc = idx / 384;
                *(LAS u32x4*)(Ks + key * 72 + dc * 8) = kv[k];
#pragma unroll
                for (int i = 0; i < 8; ++i) VT[(dc * 8 + i) * 392 + key] = (bf16_t)((vv[k][i >> 1] >> (16 * (i & 1))) & 0xffffu);
            }
        }
        __syncthreads();
        for (int uu = 0; uu < 2; ++uu) {
            const int u = w + 8 * uu, g = u >> 2, qs = u & 3, h = kvh * 4 + g, q0 = qb * 128 + 32 * qs;
            bf16x8 qf[4];
            const bf16_t* qp = qkv + (size_t)(seq * L + q0 + l31) * 1536 + h * 64 + 8 * hh;
#pragma unroll
            for (int ks = 0; ks < 4; ++ks) qf[ks] = *(const bf16x8*)(qp + 16 * ks);
            const float LOG2E = 1.4426950408889634f;
            const float c1 = 0.125f * LOG2E, slope2 = exp2f(-0.5f * (float)(h + 1)) * LOG2E;
            float m = sink[h] * LOG2E, lsum = 1.0f;
            const bool edge = (qb == 0) || (qb == 127);
            f32x16 O0, O1;
#pragma unroll
            for (int r = 0; r < 16; ++r) { O0[r] = 0.f; O1[r] = 0.f; }
#pragma unroll 1
            for (int kt = 0; kt < 9; ++kt) {
                const int kl0 = 32 * qs + 32 * kt;
                f32x16 S;
#pragma unroll
                for (int r = 0; r < 16; ++r) S[r] = 0.f;
#pragma unroll
                for (int ks = 0; ks < 4; ++ks) { const bf16x8 af = *(const LAS bf16x8*)(Ks + (kl0 + l31) * 72 + 16 * ks + 8 * hh); S = __builtin_amdgcn_mfma_f32_32x32x16_bf16(af, qf[ks], S, 0, 0, 0); }
                float p[16]; float mt = -1e30f;
                const float dbase = (float)(32 * kt - 128 + 4 * hh - l31);
                if (kt == 0 || kt == 8 || edge) {
#pragma unroll
                    for (int r = 0; r < 16; ++r) {
                        const int i = 8 * (r >> 2) + 4 * hh + (r & 3);
                        const int kpos = q0 - 128 + 32 * kt + i;
                        const float ad = __builtin_fabsf(dbase + (float)(8 * (r >> 2) + (r & 3)));
                        const bool valid = (ad <= 128.0f) && (kpos >= 0) && (kpos < L);
                        p[r] = valid ? (S[r] * c1 - slope2 * ad) : -1e30f;
                        mt = fmaxf(mt, p[r]);
                    }
                } else {
#pragma unroll
                    for (int r = 0; r < 16; ++r) {
                        const float ad = __builtin_fabsf(dbase + (float)(8 * (r >> 2) + (r & 3)));
                        p[r] = S[r] * c1 - slope2 * ad;
                        mt = fmaxf(mt, p[r]);
                    }
                }
                mt = fmaxf(mt, __shfl_xor(mt, 32));
                const float mnew = fmaxf(m, mt);
                if (__builtin_amdgcn_ballot_w64(mnew != m) != 0ull) {
                    const float alpha = __builtin_amdgcn_exp2f(m - mnew);
                    lsum *= alpha;
#pragma unroll
                    for (int r = 0; r < 16; ++r) { O0[r] *= alpha; O1[r] *= alpha; }
                    m = mnew;
                }
                float rs = 0.f;
#pragma unroll
                for (int r = 0; r < 16; ++r) { p[r] = __builtin_amdgcn_exp2f(p[r] - m); rs += p[r]; }
                rs += __shfl_xor(rs, 32);
                lsum += rs;
#pragma unroll
                for (int kk = 0; kk < 2; ++kk) {
                    u32x4 pw; pw.x = pk_bf16(p[8 * kk], p[8 * kk + 1]); pw.y = pk_bf16(p[8 * kk + 2], p[8 * kk + 3]); pw.z = pk_bf16(p[8 * kk + 4], p[8 * kk + 5]); pw.w = pk_bf16(p[8 * kk + 6], p[8 * kk + 7]);
                    const bf16x8 pf = __builtin_bit_cast(bf16x8, pw);
#pragma unroll
                    for (int dt = 0; dt < 2; ++dt) {
                        const LAS bf16_t* vp = VT + (32 * dt + l31) * 392 + kl0 + 16 * kk + 4 * hh;
                        const u32x2 lo = *(const LAS u32x2*)vp, hi = *(const LAS u32x2*)(vp + 8);
                        const bf16x8 vf = __builtin_bit_cast(bf16x8, (u32x4){lo.x, lo.y, hi.x, hi.y});
                        if (dt == 0) O0 = __builtin_amdgcn_mfma_f32_32x32x16_bf16(vf, pf, O0, 0, 0, 0);
                        else O1 = __builtin_amdgcn_mfma_f32_32x32x16_bf16(vf, pf, O1, 0, 0, 0);
                    }
                }
            }
            const float inv = 1.0f / lsum;
            bf16_t* op = ao + (size_t)(seq * L + q0 + l31) * 1024 + h * 64 + 4 * hh;
#pragma unroll
            for (int b = 0; b < 4; ++b) {
                u32x2 o0; o0.x = pk_bf16(O0[4 * b] * inv, O0[4 * b + 1] * inv); o0.y = pk_bf16(O0[4 * b + 2] * inv, O0[4 * b + 3] * inv);
                u32x2 o1; o1.x = pk_bf16(O1[4 * b] * inv, O1[4 * b + 1] * inv); o1.y = pk_bf16(O1[4 * b + 2] * inv, O1[4 * b + 3] * inv);
                *(u32x2*)(op + 8 * b) = o0; *(u32x2*)(op + 32 + 8 * b) = o1;
            }
        }
    }
    __syncthreads();
}

__global__ void __launch_bounds__(512, 2) mega(Args a) {
    extern __shared__ __attribute__((aligned(16))) unsigned char lds_raw[];
    LAS unsigned char* lds = (LAS unsigned char*)lds_raw;
    unsigned char* ws = a.ws;
    const int lo = a.ph_lo, hi = a.ph_hi;
    bf16_t* XB = (bf16_t*)(ws + WS_H);
    const float* mod = (const float*)(ws + WS_MOD);
    bf16_t* H = (bf16_t*)a.out;
    bf16_t* ACT = (bf16_t*)(ws + WS_ACT);
    bf16_t* PBT = ACT;
    bf16_t* PA = (bf16_t*)(ws + WS_ACT + PBT_BYTES);
    const int G = gridDim.x, bx = blockIdx.x;
    volatile LAS unsigned* bst = (volatile LAS unsigned*)(lds + LDS_BYTES - 16);
    if (threadIdx.x < 4) bst[threadIdx.x] = 0u;
    __syncthreads();
    const XcdBarrier xbar = xcd_barrier_post((unsigned*)(ws + WS_BAR), bst);
#define GSYNC() xcd_barrier(xbar)
#define IN(k) (lo <= (k) && (k) < hi)
#define SEAM(k) do { if (IN(k) && IN((k) + 1)) { GSYNC(); if ((RM >> 15) & 1) GSYNC(); } } while (0)
    int ph = 0;
    if (IN(0)) REP(0) { if (EN(0)) convert_weights(a, (LAS float*)lds); if (EN(1)) ada_phase(a, (LAS float*)lds); if (EN(2)) filter_phase(a, (LAS float*)lds); }
    if (IN(0) && IN(1)) cg::this_grid().sync();
    ph = 1;
#pragma unroll 1
    for (int layer = 0; layer < 2; ++layer) {
        const float* ml = mod + (size_t)layer * 3 * 9216;
        const float* ng = a.in[6] + layer * 3 * 1024;
#pragma unroll 1
        for (int sub = 0; sub < 3; ++sub) {
            const bool first = (layer == 0 && sub == 0);
            const float* xs0 = a.in[0]; const float* xs1 = a.in[1];
            const float* shp = ml + (3 * sub) * 1024; const float* scp = shp + 1024; const float* gp = shp + 2048;
            if (EN(3) && IN(ph)) REP(3) { if (first) norm_phase<true>(xs0, xs1, XB, ng + sub * 1024, shp, scp, H); else norm_phase<false>(xs0, xs1, XB, ng + sub * 1024, shp, scp, H); }
            SEAM(ph); ++ph;
            if (sub != 1) {
                const int fi = layer * 2 + (sub == 2 ? 1 : 0);
                if (EN(4) && IN(ph)) REP(4) { pg8::Gemm g{H, (const bf16_t*)(ws + WS_WIN) + (size_t)fi * 5632 * 1024, T, 5632, 1024}; pg8::StaticOrder S; S.init(T, 5632, G, bx);
                    EpiSwiglu E{ACT}; pg8::gemm_phase<EpiSwiglu>(lds, g, S, E); }
                SEAM(ph); ++ph;
                if (EN(5) && IN(ph)) { pg8::Gemm g{ACT, (const bf16_t*)(ws + WS_WOUT) + (size_t)fi * 1024 * 2816, T, 1024, DFF}; pg8::StaticOrder S; S.init(T, 1024, G, bx);
                    if (first) { EpiResid<true> E{xs0, xs1, XB, XB, gp, 0.5f}; pg8::gemm_phase<EpiResid<true>>(lds, g, S, E); } else { EpiResid<false> E{xs0, xs1, XB, XB, gp, 0.5f}; pg8::gemm_phase<EpiResid<false>>(lds, g, S, E); } }
                SEAM(ph); ++ph;
            } else if (layer == 0) {
                if (EN(6) && IN(ph)) REP(6) { pg8::Gemm g{H, (const bf16_t*)(ws + WS_WABIN), T, 2560, 1024}; pg8::StaticOrder S; S.init(T, 2560, G, bx);
                    EpiProj E{PA, PBT}; pg8::gemm_phase<EpiProj>(lds, g, S, E); }
                SEAM(ph); ++ph;
                if (IN(ph)) { if (EN(7)) REP(7) conva_phase(a, PA, H, lds); GSYNC(); if ((RM >> 8) & 1) fft_phase<true>(a, PBT, lds); if (EN(8)) fft_phase<false>(a, PBT, lds); }
                SEAM(ph); ++ph;
                if (EN(9) && IN(ph)) REP(9) ztrans_phase(PBT, H, lds);
                SEAM(ph); ++ph;
                if (EN(5) && IN(ph)) { pg8::Gemm g{H, (const bf16_t*)(ws + WS_WABOUT), T, 1024, 1024}; pg8::StaticOrder S; S.init(T, 1024, G, bx);
                    EpiResid<false> E{xs0, xs1, XB, XB, gp, 1.0f}; pg8::gemm_phase<EpiResid<false>>(lds, g, S, E); }
                SEAM(ph); ++ph;
            } else {
                if (EN(10) && IN(ph)) REP(10) { pg8::Gemm g{H, (const bf16_t*)(ws + WS_WQKV), T, 1536, 1024}; pg8::StaticOrder S; S.init(T, 1536, G, bx);
                    EpiBf16 E{ACT, 1536}; pg8::gemm_phase<EpiBf16>(lds, g, S, E); }
                SEAM(ph); ++ph;
                if (EN(11) && IN(ph)) REP(11) attn_phase(a, ACT, H, lds);
                SEAM(ph); ++ph;
                if (EN(5) && IN(ph)) { pg8::Gemm g{H, (const bf16_t*)(ws + WS_WATTO), T, 1024, 1024}; pg8::StaticOrder S; S.init(T, 1024, G, bx);
                    EpiResid<false> E{xs0, xs1, XB, XB, gp, 1.0f}; pg8::gemm_phase<EpiResid<false>>(lds, g, S, E); }
                SEAM(ph); ++ph;
            }
        }
    }
    if (EN(12) && IN(ph)) final_norm_phase(XB, a.out, a.in[9]);
#undef IN
#undef SEAM
}

extern "C" void kernel_launch(void* const* d_in, const int* in_sizes, int n_in, void* d_out, int out_size, void* d_ws, size_t ws_size, hipStream_t stream) {
    static int grid = 0;
    if (grid == 0) {
        int dev = 0, cus = 0, per_cu = 0;
        (void)hipGetDevice(&dev);
        (void)hipDeviceGetAttribute(&cus, hipDeviceAttributeMultiprocessorCount, dev);
        (void)hipFuncSetAttribute((const void*)mega, hipFuncAttributeMaxDynamicSharedMemorySize, LDS_BYTES);
        (void)hipOccupancyMaxActiveBlocksPerMultiprocessor(&per_cu, (const void*)mega, 512, LDS_BYTES);
        if (per_cu < 1) per_cu = 1;
        grid = cus * per_cu;
        if (grid > 256) grid = 256;
        if (ws_size < WS_END) { fprintf(stderr, "workspace too small: %zu < %zu\n", ws_size, (size_t)WS_END); grid = -1; }
    }
    if (grid < 0) return;
    Args a{};
    for (int i = 0; i < 28; ++i) a.in[i] = (const float*)d_in[i];
    a.out = (float*)d_out; a.ws = (unsigned char*)d_ws;
    (void)hipMemsetAsync((unsigned char*)d_ws + WS_BAR, 0, XCD_BAR_WORDS * 4, stream);
#if N_LAUNCH_MODE == 1
    a.ph_lo = 0; a.ph_hi = NPH;
    void* args[] = {&a};
    hipError_t e = hipLaunchCooperativeKernel((const void*)mega, dim3(grid), dim3(512), args, LDS_BYTES, stream);
    if (e != hipSuccess) fprintf(stderr, "cooperative launch failed: %s (grid %d)\n", hipGetErrorString(e), grid);
#else
    for (int p = 0; p < NPH; ++p) { a.ph_lo = p; a.ph_hi = p + 1; hipLaunchKernelGGL(mega, dim3(grid), dim3(512), LDS_BYTES, stream, a); }
#endif
}
```

```cpp
#include <hip/hip_runtime.h>
#include <hip/hip_cooperative_groups.h>
#include <cstdio>
namespace cg = cooperative_groups;

#ifndef PM
#define PM 0xffff
#endif
#define EN(b) ((PM >> (b)) & 1)
#ifndef RM
#define RM 0
#endif
#define REP(b) for (int rep_ = 0; rep_ < 1 + ((RM >> (b)) & 1); ++rep_)
#ifndef N_LAUNCH_MODE
#define N_LAUNCH_MODE 1
#endif

#define LAS __attribute__((address_space(3)))
typedef unsigned short bf16_t;
typedef short bf16x8 __attribute__((ext_vector_type(8)));
typedef float f32x4 __attribute__((ext_vector_type(4)));
typedef float f32x16 __attribute__((ext_vector_type(16)));
typedef unsigned u32x4 __attribute__((ext_vector_type(4)));
typedef unsigned u32x2 __attribute__((ext_vector_type(2)));
typedef __bf16 bf16x2v __attribute__((ext_vector_type(2)));
typedef float f32x2v __attribute__((ext_vector_type(2)));
typedef _Float16 half_t;

constexpr int T = 49152, D = 1024, L = 16384, DFF = 2816, NPH = 23;
constexpr float EPS = 1e-6f;
constexpr int LDS_BYTES = 147456;

constexpr size_t WS_WIN = 0;
constexpr size_t WS_WOUT = WS_WIN + 4ull * 5632 * 1024 * 2;
constexpr size_t WS_WABIN = WS_WOUT + 4ull * 1024 * 2816 * 2;
constexpr size_t WS_WABOUT = WS_WABIN + 2560ull * 1024 * 2;
constexpr size_t WS_WQKV = WS_WABOUT + 1024ull * 1024 * 2;
constexpr size_t WS_WATTO = WS_WQKV + 1536ull * 1024 * 2;
constexpr size_t WS_MOD = WS_WATTO + 1024ull * 1024 * 2;
constexpr size_t WS_BAR = WS_MOD + 221184;
constexpr size_t WS_H = WS_MOD + 262144;
constexpr size_t WS_ACT = WS_H + (size_t)T * 1024 * 2;
constexpr size_t WS_KT = WS_ACT + (size_t)T * DFF * 2;
constexpr size_t WS_END = WS_KT + 2ull * 512 * 2 * L * 2;
constexpr size_t PBT_BYTES = 3ull * 1536 * L * 2;
constexpr size_t FFTSCR_PER_BLOCK = 2ull * L * 8 + 3ull * L * 4;

__device__ __forceinline__ unsigned pk_bf16(float a, float b) { f32x2v f = {a, b}; bf16x2v r = __builtin_convertvector(f, bf16x2v); return __builtin_bit_cast(unsigned, r); }
__device__ __forceinline__ float bf_lo(unsigned v) { return __uint_as_float(v << 16); }
__device__ __forceinline__ float bf_hi(unsigned v) { return __uint_as_float(v & 0xffff0000u); }
__device__ __forceinline__ float bf2f(bf16_t v) { return __uint_as_float((unsigned)v << 16); }
__device__ __forceinline__ bf16_t f2bf(float f) { return (bf16_t)(pk_bf16(f, 0.f) & 0xffffu); }
__device__ __forceinline__ float fsigmoid(float x) { return __builtin_amdgcn_rcpf(1.0f + __expf(-x)); }
__device__ __forceinline__ float hw_sin(float x) { return __builtin_amdgcn_sinf(x * 0.15915494309189535f); }

__device__ __forceinline__ int opaque_tid() { int t = threadIdx.x; asm volatile("" : "+v"(t)); return t; }

#define XB_TMO      128
#define XB_XCNT(j)  (256  + 64 * (j))
#define XB_XSUB(j)  (1280 + 64 * (j))
#define XB_XGEN(j)  (2304 + 64 * (j))
#define XB_TOP      3328
#define XB_TOPGEN   3392
#define XCD_BAR_WORDS 3456
#define XB_SPIN_CAP (1u << 22)
__device__ __forceinline__ unsigned xb_ld(unsigned* p)              { return __hip_atomic_load(p, __ATOMIC_RELAXED, __HIP_MEMORY_SCOPE_AGENT); }
__device__ __forceinline__ unsigned xb_add(unsigned* p, unsigned v) { return __hip_atomic_fetch_add(p, v, __ATOMIC_RELAXED, __HIP_MEMORY_SCOPE_AGENT); }
__device__ __forceinline__ unsigned xb_xcc_id() { return (unsigned)__builtin_amdgcn_s_getreg((3 << 11) | 20) & 0xFu; }
#define XB_SPIN(cond, bar) do { unsigned _sp = 0; while (cond) { __builtin_amdgcn_s_sleep(1); \
    if ((++_sp & 255u) == 0u) { if (xb_ld(&(bar)[XB_TMO])) break; if (_sp > XB_SPIN_CAP) { atomicAdd(&(bar)[XB_TMO], 1u); break; } } } } while (0)
struct XcdBarrier { unsigned* bar; unsigned x; volatile LAS unsigned* st; };
__device__ __forceinline__ XcdBarrier xcd_barrier_post(unsigned* bar, volatile LAS unsigned* st) {
    XcdBarrier b; b.bar = bar; b.x = xb_xcc_id(); b.st = st;
    if (threadIdx.x == 0) (void)xb_add(&bar[XB_XCNT(b.x)], 1u);
    return b;
}
__device__ __forceinline__ void xcd_barrier_complete(unsigned* bar, unsigned x, unsigned& nloc, unsigned& nx) {
    const unsigned G = gridDim.x * gridDim.y * gridDim.z;
    unsigned sum, cnt, mine, sp = 0u;
    for (;;) {
        sum = 0u; cnt = 0u; mine = 0u;
#pragma unroll
        for (unsigned j = 0; j < 16; ++j) { const unsigned c = xb_ld(&bar[XB_XCNT(j)]); sum += c; cnt += (c > 0u) ? 1u : 0u; mine = (j == x) ? c : mine; }
        if (sum == G) break;
        __builtin_amdgcn_s_sleep(1);
        if ((++sp & 255u) == 0u) { if (xb_ld(&bar[XB_TMO])) break; if (sp > XB_SPIN_CAP) { atomicAdd(&bar[XB_TMO], 1u); break; } }
    }
    nloc = mine > 0u ? mine : 1u; nx = cnt > 0u ? cnt : 1u;
}
__device__ __forceinline__ void xcd_barrier(const XcdBarrier& b) {
    asm volatile("s_waitcnt vmcnt(0)" ::: "memory");
    __syncthreads();
    if (threadIdx.x == 0) {
        unsigned* bar = b.bar;
        __builtin_amdgcn_s_waitcnt(0);
        unsigned nloc = b.st[0], nx = b.st[1];
        if (nloc == 0u) { xcd_barrier_complete(bar, b.x, nloc, nx); b.st[0] = nloc; b.st[1] = nx; }
        const unsigned old = xb_add(&bar[XB_XSUB(b.x)], 1u);
        const unsigned gen = old / nloc;
        if (old + 1u == (gen + 1u) * nloc) {
            __builtin_amdgcn_fence(__ATOMIC_RELEASE, "agent");
            asm volatile("s_waitcnt vmcnt(0)" ::: "memory");
            const unsigned og = xb_add(&bar[XB_TOP], 1u);
            const unsigned tg = og / nx;
            if (og + 1u == (tg + 1u) * nx) xb_add(&bar[XB_TOPGEN], 1u);
            else XB_SPIN(xb_ld(&bar[XB_TOPGEN]) == tg, bar);
            __builtin_amdgcn_fence(__ATOMIC_ACQUIRE, "agent");
            xb_add(&bar[XB_XGEN(b.x)], 1u);
            asm volatile("s_waitcnt vmcnt(0)" ::: "memory");
        } else {
            XB_SPIN(xb_ld(&bar[XB_XGEN(b.x)]) == gen, bar);
            __builtin_amdgcn_fence(__ATOMIC_ACQUIRE, "agent");
            asm volatile("s_waitcnt vmcnt(0)" ::: "memory");
        }
    }
    __syncthreads();
}

struct Args { const float* in[28]; float* out; unsigned char* ws; int ph_lo, ph_hi; };

namespace pg8 {
constexpr int BM = 256, BK = 64, HALF = 128, HTB = HALF * BK * 2, STAGE_BYTES = 8 * HTB, NXCD = 8, WGM = 8;
__device__ __forceinline__ int lds_byte(int r, int c) { const int st = (r >> 4) * 2 + (c >> 5), rr = r & 15, cc = c & 31, ob = rr * 64 + cc * 2; return st * 1024 + (ob ^ (((ob >> 9) & 1) << 5)); }
__device__ __forceinline__ void stage_rc(int b, int& R, int& C) { const int st = b / 1024, sb = b % 1024, swz = sb ^ (((sb >> 9) & 1) << 5); R = (st >> 1) * 16 + swz / 64; C = (st & 1) * 32 + (swz % 64) / 2; }
__device__ __forceinline__ int perm32(int rho) { const int n = rho >> 4, i = rho & 15; return 8 * (i >> 2) + 4 * n + (i & 3); }
struct Unit { int pm, pn; };
struct Gemm { const bf16_t* A; const bf16_t* Bt; int M, N, K; };
struct StaticOrder {
    int nM, nN, nwg, G, c;
    __device__ void init(int M, int N, int G_, int c_) { nM = M / BM; nN = N / BM; nwg = nM * nN; G = G_; c = c_; }
    __device__ bool next(int i, Unit& u) const {
        const long Lx = (long)i * G + c; if (Lx >= nwg) return false;
        int wgid = (int)Lx; { const int q = nwg / NXCD, r = nwg % NXCD, xcd = wgid % NXCD, off = wgid / NXCD; wgid = (xcd < r ? xcd * (q + 1) : r * (q + 1) + (xcd - r) * q) + off; }
        const int nig = WGM * nN, gid = wgid / nig, fm = gid * WGM, gsz = (nM - fm) < WGM ? (nM - fm) : WGM;
        u.pm = fm + ((wgid % nig) % gsz); u.pn = (wgid % nig) / gsz; return true;
    }
};

template <class Epi>
__device__ __forceinline__ void gemm_phase(LAS unsigned char* lds, const Gemm g, const StaticOrder& S, const Epi& E) {
    const int tid = opaque_tid(), wid = __builtin_amdgcn_readfirstlane(tid >> 6), lane = tid & 63, wr = wid >> 2, wc = wid & 3, fr = lane & 15, fq = lane >> 4;
    const int K = g.K, nt = K / BK;
    unsigned voffA[2], voffB[2];
#pragma unroll
    for (int i = 0; i < 2; ++i) { int R, C; stage_rc(tid * 16 + i * 8192, R, C); const int Rb = Epi::PERM ? ((R & ~31) + perm32(R & 31)) : R;
        voffA[i] = (unsigned)(R * K + C) * 2u; voffB[i] = (unsigned)(Rb * K + C) * 2u; }
    const size_t kstep = (size_t)(BK * 2);
    const size_t hstep = (size_t)HALF * K * 2;
    const size_t tstep = 2 * hstep;
    const unsigned ldsw = (unsigned)wid * 1024u;
    const int aoff = lds_byte(wr * 64 + fr, fq * 8), boff = lds_byte(wc * 32 + fr, fq * 8);
#define PG8_SA(b, h) (((b) * 2 + (h)) * HTB)
#define PG8_SB(b, h) ((4 + (b) * 2 + (h)) * HTB)
#define PG8_STAGE(bufoff, gbase, voff) do { _Pragma("unroll") for (int _i = 0; _i < 2; ++_i) \
        __builtin_amdgcn_global_load_lds((const unsigned*)((const char*)(gbase) + (voff)[_i]), (LAS unsigned*)(lds + (bufoff) + ldsw + _i * 8192), 16, 0, 0); } while (0)
#define PG8_LDA(dst, b, h) do { _Pragma("unroll") for (int m = 0; m < 4; ++m) _Pragma("unroll") for (int k = 0; k < 2; ++k) dst[m][k] = *(const LAS bf16x8*)(lds + PG8_SA(b, h) + aoff + m * 2048 + k * 1024); } while (0)
#define PG8_LDB(dst, b, h) do { _Pragma("unroll") for (int n = 0; n < 2; ++n) _Pragma("unroll") for (int k = 0; k < 2; ++k) dst[n][k] = *(const LAS bf16x8*)(lds + PG8_SB(b, h) + boff + n * 2048 + k * 1024); } while (0)
#define PG8_MMA(ai, bj, At, Bt) do { __builtin_amdgcn_s_setprio(1); _Pragma("unroll") for (int m = 0; m < 4; ++m) _Pragma("unroll") for (int n = 0; n < 2; ++n) _Pragma("unroll") for (int k = 0; k < 2; ++k) \
        acc[ai][bj][m][n] = __builtin_amdgcn_mfma_f32_16x16x32_bf16(Bt[n][k], At[m][k], acc[ai][bj][m][n], 0, 0, 0); __builtin_amdgcn_s_setprio(0); } while (0)
#define PG8_WAIT_V(n) asm volatile("s_waitcnt vmcnt(" #n ")" ::: "memory")
#define PG8_WAIT_L(n) asm volatile("s_waitcnt lgkmcnt(" #n ")" ::: "memory")
#define PG8_BAR __builtin_amdgcn_s_barrier()
#define PG8_SCHED __builtin_amdgcn_sched_barrier(0)
    Unit cur, nxt; int ui = 0;
    if (!S.next(0, cur)) return;
    f32x4 acc[2][2][4][2];
#pragma unroll
    for (int a = 0; a < 2; ++a)
#pragma unroll
        for (int b = 0; b < 2; ++b)
#pragma unroll
            for (int m = 0; m < 4; ++m)
#pragma unroll
                for (int n = 0; n < 2; ++n) acc[a][b][m][n] = (f32x4){0.f, 0.f, 0.f, 0.f};
    bf16x8 At[4][2], B0[2][2], B1[2][2];
    const char* cA = (const char*)g.A + (size_t)cur.pm * tstep; const char* cB = (const char*)g.Bt + (size_t)cur.pn * tstep;
    PG8_STAGE(PG8_SB(0, 0), cB, voffB); PG8_STAGE(PG8_SA(0, 0), cA, voffA); PG8_STAGE(PG8_SB(0, 1), cB + hstep, voffB); PG8_STAGE(PG8_SA(0, 1), cA + hstep, voffA);
    if (wr == 1) PG8_BAR;
    PG8_WAIT_V(4); PG8_BAR;
    PG8_STAGE(PG8_SB(1, 0), cB + kstep, voffB); PG8_STAGE(PG8_SA(1, 0), cA + kstep, voffA); PG8_STAGE(PG8_SB(1, 1), cB + hstep + kstep, voffB);
    PG8_WAIT_V(6); PG8_BAR;
    for (;;) {
        const bool has_next = S.next(ui + 1, nxt);
        const char* nA = has_next ? (const char*)g.A + (size_t)nxt.pm * tstep : cA; const char* nB = has_next ? (const char*)g.Bt + (size_t)nxt.pn * tstep : cB;
        for (int t = 0; t < nt; t += 2) {
            const bool last = (t == nt - 2);
            const char* a1 = cA + (size_t)(t + 1) * kstep;
            const char* a2 = last ? nA : cA + (size_t)(t + 2) * kstep; const char* b2 = last ? nB : cB + (size_t)(t + 2) * kstep;
            const char* a3 = a2 + kstep; const char* b3 = b2 + kstep;
            PG8_LDB(B0, 0, 0); PG8_SCHED; PG8_LDA(At, 0, 0); PG8_STAGE(PG8_SA(1, 1), a1 + hstep, voffA);
            PG8_WAIT_L(8); PG8_BAR; PG8_WAIT_L(0); PG8_MMA(0, 0, At, B0); PG8_BAR; PG8_SCHED;
            PG8_LDB(B1, 0, 1); PG8_STAGE(PG8_SB(0, 0), b2, voffB);
            PG8_BAR; PG8_WAIT_L(0); PG8_MMA(0, 1, At, B1); PG8_BAR;
            PG8_LDA(At, 0, 1); PG8_STAGE(PG8_SA(0, 0), a2, voffA);
            PG8_BAR; PG8_WAIT_L(0); PG8_MMA(1, 0, At, B0); PG8_BAR; PG8_SCHED;
            PG8_STAGE(PG8_SB(0, 1), b2 + hstep, voffB);
            PG8_WAIT_V(6); PG8_BAR; PG8_MMA(1, 1, At, B1); PG8_BAR;
            PG8_LDB(B0, 1, 0); PG8_SCHED; PG8_LDA(At, 1, 0); PG8_STAGE(PG8_SA(0, 1), a2 + hstep, voffA);
            PG8_WAIT_L(8); PG8_BAR; PG8_WAIT_L(0); PG8_MMA(0, 0, At, B0); PG8_BAR; PG8_SCHED;
            PG8_LDB(B1, 1, 1); PG8_STAGE(PG8_SB(1, 0), b3, voffB);
            PG8_BAR; PG8_WAIT_L(0); PG8_MMA(0, 1, At, B1); PG8_BAR;
            PG8_LDA(At, 1, 1); PG8_STAGE(PG8_SA(1, 0), a3, voffA);
            PG8_BAR; PG8_WAIT_L(0); PG8_MMA(1, 0, At, B0); PG8_BAR; PG8_SCHED;
            PG8_STAGE(PG8_SB(1, 1), b3 + hstep, voffB);
            PG8_WAIT_V(6); PG8_BAR; PG8_MMA(1, 1, At, B1); PG8_BAR;
        }
        E(acc, cur, wr, wc, fr, fq);
        if (!has_next) break;
#pragma unroll
        for (int a = 0; a < 2; ++a)
#pragma unroll
            for (int b = 0; b < 2; ++b)
#pragma unroll
                for (int m = 0; m < 4; ++m)
#pragma unroll
                    for (int n = 0; n < 2; ++n) acc[a][b][m][n] = (f32x4){0.f, 0.f, 0.f, 0.f};
        cur = nxt; cA = nA; cB = nB; ++ui;
    }
    PG8_WAIT_V(0);
    if (wr == 0) PG8_BAR;
    PG8_BAR;
#undef PG8_SA
#undef PG8_SB
#undef PG8_STAGE
#undef PG8_LDA
#undef PG8_LDB
#undef PG8_MMA
#undef PG8_WAIT_V
#undef PG8_WAIT_L
#undef PG8_BAR
#undef PG8_SCHED
}
}

struct EpiSwiglu {
    static constexpr bool PERM = true;
    bf16_t* O;
    __device__ __forceinline__ void operator()(const f32x4 (&acc)[2][2][4][2], const pg8::Unit& u, int wr, int wc, int fr, int fq) const {
        const int row0 = u.pm * 256 + wr * 64 + fr, col0 = u.pn * 128 + wc * 32 + 8 * fq;
#pragma unroll
        for (int ai = 0; ai < 2; ++ai)
#pragma unroll
            for (int m = 0; m < 4; ++m) {
                bf16_t* rowp = O + (size_t)(row0 + ai * 128 + m * 16) * DFF + col0;
                float v[8];
#pragma unroll
                for (int n = 0; n < 2; ++n)
#pragma unroll
                    for (int j = 0; j < 4; ++j) { const float gg = acc[ai][0][m][n][j], uu = acc[ai][1][m][n][j]; v[n * 4 + j] = gg * fsigmoid(gg) * uu; }
                u32x4 w; w.x = pk_bf16(v[0], v[1]); w.y = pk_bf16(v[2], v[3]); w.z = pk_bf16(v[4], v[5]); w.w = pk_bf16(v[6], v[7]);
                *(u32x4*)rowp = w;
            }
    }
};
struct EpiBf16 {
    static constexpr bool PERM = true;
    bf16_t* O; int ldc;
    __device__ __forceinline__ void operator()(const f32x4 (&acc)[2][2][4][2], const pg8::Unit& u, int wr, int wc, int fr, int fq) const {
        const int row0 = u.pm * 256 + wr * 64 + fr, col0 = u.pn * 256 + wc * 32 + 8 * fq;
#pragma unroll
        for (int ai = 0; ai < 2; ++ai)
#pragma unroll
            for (int m = 0; m < 4; ++m) {
                bf16_t* rowp = O + (size_t)(row0 + ai * 128 + m * 16) * ldc + col0;
#pragma unroll
                for (int bj = 0; bj < 2; ++bj) {
                    const f32x4 v0 = acc[ai][bj][m][0], v1 = acc[ai][bj][m][1];
                    u32x4 w; w.x = pk_bf16(v0[0], v0[1]); w.y = pk_bf16(v0[2], v0[3]); w.z = pk_bf16(v1[0], v1[1]); w.w = pk_bf16(v1[2], v1[3]);
                    *(u32x4*)(rowp + bj * 128) = w;
                }
            }
    }
};
struct EpiProj {
    static constexpr bool PERM = true;
    bf16_t* Oa; bf16_t* ObT;
    __device__ __forceinline__ void operator()(const f32x4 (&acc)[2][2][4][2], const pg8::Unit& u, int wr, int wc, int fr, int fq) const {
        const int row0 = u.pm * 256 + wr * 64 + fr;
        if (u.pn < 4) {
            const int col0 = u.pn * 256 + wc * 32 + 8 * fq;
#pragma unroll
            for (int ai = 0; ai < 2; ++ai)
#pragma unroll
                for (int m = 0; m < 4; ++m) {
                    bf16_t* rowp = Oa + (size_t)(row0 + ai * 128 + m * 16) * 1024 + col0;
#pragma unroll
                    for (int bj = 0; bj < 2; ++bj) {
                        const f32x4 v0 = acc[ai][bj][m][0], v1 = acc[ai][bj][m][1];
                        u32x4 w; w.x = pk_bf16(v0[0], v0[1]); w.y = pk_bf16(v0[2], v0[3]); w.z = pk_bf16(v1[0], v1[1]); w.w = pk_bf16(v1[2], v1[3]);
                        *(u32x4*)(rowp + bj * 128) = w;
                    }
                }
        } else {
            const int seq = (u.pm * 256) >> 14;
            const int c0 = (u.pn - 4) * 256 + wc * 32 + 8 * fq;
#pragma unroll
            for (int ai = 0; ai < 2; ++ai)
#pragma unroll
                for (int m = 0; m < 4; ++m) {
                    const int nn = (row0 + ai * 128 + m * 16) & (L - 1);
#pragma unroll
                    for (int bj = 0; bj < 2; ++bj)
#pragma unroll
                        for (int n = 0; n < 2; ++n)
#pragma unroll
                            for (int j = 0; j < 4; ++j)
                                ObT[((size_t)(seq * 1536 + c0 + bj * 128 + 4 * n + j) << 14) + nn] = f2bf(acc[ai][bj][m][n][j]);
                }
        }
    }
};
template <bool SRC_F32> struct EpiResid {
    static constexpr bool PERM = true;
    const float* xs0; const float* xs1; const bf16_t* xbs; bf16_t* xbo; const float* gate; float scale;
    __device__ __forceinline__ void operator()(const f32x4 (&acc)[2][2][4][2], const pg8::Unit& u, int wr, int wc, int fr, int fq) const {
        const int row0 = u.pm * 256 + wr * 64 + fr, col0 = u.pn * 256 + wc * 32 + 8 * fq;
        const int seq = (u.pm * 256) >> 14;
        const float* gb = gate + seq * 9216 + col0;
        const float* sf = (seq < 2 ? xs0 + (size_t)row0 * 1024 : xs1 + (size_t)(row0 - 32768) * 1024) + col0;
        const size_t ob = (size_t)row0 * 1024 + col0;
#pragma unroll
        for (int bj = 0; bj < 2; ++bj) {
            const f32x4 g0 = *(const f32x4*)(gb + bj * 128) * scale, g1 = *(const f32x4*)(gb + bj * 128 + 4) * scale;
            f32x4 x0[2][4], x1[2][4]; u32x4 q[2][4];
#pragma unroll
            for (int ai = 0; ai < 2; ++ai)
#pragma unroll
                for (int m = 0; m < 4; ++m) {
                    const size_t off = (size_t)(ai * 128 + m * 16) * 1024 + bj * 128;
                    if (SRC_F32) { x0[ai][m] = *(const f32x4*)(sf + off); x1[ai][m] = *(const f32x4*)(sf + off + 4); }
                    else q[ai][m] = *(const u32x4*)(xbs + ob + off);
                }
#pragma unroll
            for (int ai = 0; ai < 2; ++ai)
#pragma unroll
                for (int m = 0; m < 4; ++m) {
                    const size_t off = (size_t)(ai * 128 + m * 16) * 1024 + bj * 128;
                    f32x4 a0, a1;
                    if (SRC_F32) { a0 = x0[ai][m]; a1 = x1[ai][m]; }
                    else { const u32x4 t = q[ai][m]; a0 = (f32x4){bf_lo(t.x), bf_hi(t.x), bf_lo(t.y), bf_hi(t.y)}; a1 = (f32x4){bf_lo(t.z), bf_hi(t.z), bf_lo(t.w), bf_hi(t.w)}; }
                    const f32x4 y0 = a0 + g0 * acc[ai][bj][m][0], y1 = a1 + g1 * acc[ai][bj][m][1];
                    u32x4 w; w.x = pk_bf16(y0[0], y0[1]); w.y = pk_bf16(y0[2], y0[3]); w.z = pk_bf16(y1[0], y1[1]); w.w = pk_bf16(y1[2], y1[3]);
                    *(u32x4*)(xbo + ob + off) = w;
                }
        }
    }
};

struct WTile { const float* src; bf16_t* dst; int K, N, k0, np0, n0; };
__device__ __forceinline__ WTile wtile_desc(const Args& a, int ti) {
    unsigned char* ws = a.ws;
    WTile t; int mode = 0, lt;
    if (ti < 5632) { const int mi = ti / 1408; lt = ti % 1408; t.src = a.in[7] + (size_t)mi * 1024 * 5632; t.dst = (bf16_t*)(ws + WS_WIN) + (size_t)mi * 5632 * 1024; t.K = 1024; t.N = 5632; mode = 1; }
    else if (ti < 8448) { const int mi = (ti - 5632) / 704; lt = (ti - 5632) % 704; t.src = a.in[8] + (size_t)mi * 2816 * 1024; t.dst = (bf16_t*)(ws + WS_WOUT) + (size_t)mi * 1024 * 2816; t.K = 2816; t.N = 1024; }
    else if (ti < 9088) { lt = ti - 8448; t.src = a.in[10]; t.dst = (bf16_t*)(ws + WS_WABIN); t.K = 1024; t.N = 2560; }
    else if (ti < 9344) { lt = ti - 9088; t.src = a.in[24]; t.dst = (bf16_t*)(ws + WS_WABOUT); t.K = 1024; t.N = 1024; }
    else if (ti < 9728) { lt = ti - 9344; t.src = a.in[25]; t.dst = (bf16_t*)(ws + WS_WQKV); t.K = 1024; t.N = 1536; }
    else { lt = ti - 9728; t.src = a.in[27]; t.dst = (bf16_t*)(ws + WS_WATTO); t.K = 1024; t.N = 1024; }
    const int nkt = t.K / 64;
    const int kt = lt % nkt, ntp = lt / nkt;
    t.k0 = kt * 64; t.np0 = ntp * 64; t.n0 = t.np0;
    if (mode == 1) { const int pn = t.np0 >> 8, bj = (t.np0 >> 7) & 1, c0 = t.np0 & 127; t.n0 = bj * DFF + 128 * pn + c0; }
    return t;
}
__device__ void convert_weights(const Args& a, LAS float* tile) {
    const int tid = opaque_tid();
    for (int base = blockIdx.x; base < 9984; base += 4 * gridDim.x) {
        __syncthreads();
        float v[4][8];
#pragma unroll
        for (int q = 0; q < 4; ++q) {
            const int ti = base + q * gridDim.x;
            if (ti < 9984) { const WTile t = wtile_desc(a, ti);
#pragma unroll
                for (int i = 0; i < 8; ++i) { const int k = (tid >> 6) + 8 * i, n = tid & 63; v[q][i] = t.src[(size_t)(t.k0 + k) * t.N + t.n0 + n]; } }
        }
#pragma unroll
        for (int q = 0; q < 4; ++q)
#pragma unroll
            for (int i = 0; i < 8; ++i) { const int k = (tid >> 6) + 8 * i, n = tid & 63; tile[q * 4160 + k * 65 + n] = v[q][i]; }
        __syncthreads();
#pragma unroll
        for (int q = 0; q < 4; ++q) {
            const int ti = base + q * gridDim.x;
            if (ti < 9984) { const WTile t = wtile_desc(a, ti);
                const int nn = tid >> 3, kk = (tid & 7) * 8;
                float x[8];
#pragma unroll
                for (int j = 0; j < 8; ++j) x[j] = tile[q * 4160 + (kk + j) * 65 + nn];
                u32x4 w; w.x = pk_bf16(x[0], x[1]); w.y = pk_bf16(x[2], x[3]); w.z = pk_bf16(x[4], x[5]); w.w = pk_bf16(x[6], x[7]);
                *(u32x4*)(t.dst + (size_t)(t.np0 + nn) * t.K + t.k0 + kk) = w; }
        }
    }
    __syncthreads();
}

__device__ void ada_phase(const Args& a, LAS float* lf) {
    const int tid = opaque_tid(), lane = tid & 63, w = tid >> 6;
    LAS float* cs = lf; LAS float* red = lf + 3072;
    float* mod = (float*)(a.ws + WS_MOD);
    __syncthreads();
    for (int i = tid; i < 3072; i += 512) { const int s = i >> 10, k = i & 1023; const float c = s < 2 ? a.in[2][s * 1024 + k] : a.in[3][k]; cs[i] = c * fsigmoid(c); }
    __syncthreads();
    for (int item = blockIdx.x; item < 1152; item += gridDim.x) {
        const int layer = item / 576, cgp = item % 576, cl = lane & 15, ks = lane >> 4, col = cgp * 16 + cl;
        const float* W = a.in[4] + (size_t)layer * 1024 * 9216 + col;
        const int kb = (w * 4 + ks) * 32;
        float a0 = 0.f, a1 = 0.f, a2 = 0.f;
#pragma unroll 16
        for (int k = kb; k < kb + 32; ++k) { const float wv = W[(size_t)k * 9216]; a0 += cs[k] * wv; a1 += cs[1024 + k] * wv; a2 += cs[2048 + k] * wv; }
        a0 += __shfl_xor(a0, 16); a0 += __shfl_xor(a0, 32); a1 += __shfl_xor(a1, 16); a1 += __shfl_xor(a1, 32); a2 += __shfl_xor(a2, 16); a2 += __shfl_xor(a2, 32);
        if (lane < 16) { red[(w * 3 + 0) * 16 + cl] = a0; red[(w * 3 + 1) * 16 + cl] = a1; red[(w * 3 + 2) * 16 + cl] = a2; }
        __syncthreads();
        if (tid < 48) { const int s = tid >> 4, c = tid & 15; float sum = 0.f;
#pragma unroll
            for (int ww = 0; ww < 8; ++ww) sum += red[(ww * 3 + s) * 16 + c];
            mod[(size_t)(layer * 3 + s) * 9216 + cgp * 16 + c] = sum + a.in[5][layer * 9216 + cgp * 16 + c]; }
        __syncthreads();
    }
}

__device__ void filter_phase(const Args& a, LAS float* lf) {
    const int tid = opaque_tid();
    LAS float* feats = lf;
    LAS float* h1 = lf + 64 * 33;
    LAS float* h2T = h1 + 64 * 65;
    const float* w1 = a.in[17]; const float* b1 = a.in[18]; const float* w2 = a.in[19]; const float* b2 = a.in[20]; const float* w3 = a.in[21]; const float* fr = a.in[22];
    half_t* KT = (half_t*)(a.ws + WS_KT);
    for (int item = blockIdx.x; item < 256; item += gridDim.x) {
        const int p0 = item * 64;
        __syncthreads();
        for (int idx = tid; idx < 64 * 33; idx += 512) {
            const int pos = idx / 33, f = idx % 33, n = p0 + pos; float v;
            if (f == 0) v = (float)n / (float)(L - 1);
            else { const int b = (f - 1) & 15; const double band = 1e-4 + (double)b * ((15.0 - 1e-4) / 15.0); double rev = (double)n * band / (double)L; rev -= floor(rev);
                   v = (f <= 16) ? __builtin_amdgcn_cosf((float)rev) : -__builtin_amdgcn_sinf((float)rev); }
            feats[idx] = v;
        }
        __syncthreads();
        { const int pos = tid >> 3, j0 = (tid & 7) * 8; float acc[8];
#pragma unroll
          for (int j = 0; j < 8; ++j) acc[j] = b1[j0 + j];
#pragma unroll 3
          for (int f = 0; f < 33; ++f) { const float x = feats[pos * 33 + f];
#pragma unroll
              for (int j = 0; j < 8; ++j) acc[j] += x * w1[f * 64 + j0 + j]; }
#pragma unroll
          for (int j = 0; j < 8; ++j) h1[pos * 65 + j0 + j] = hw_sin(fr[j0 + j] * acc[j]); }
        __syncthreads();
        { const int pos = tid >> 3, j0 = (tid & 7) * 8; float acc[8];
#pragma unroll
          for (int j = 0; j < 8; ++j) acc[j] = b2[j0 + j];
#pragma unroll 4
          for (int i = 0; i < 64; ++i) { const float x = h1[pos * 65 + i];
#pragma unroll
              for (int j = 0; j < 8; ++j) acc[j] += x * w2[i * 64 + j0 + j]; }
#pragma unroll
          for (int j = 0; j < 8; ++j) h2T[(j0 + j) * 64 + pos] = hw_sin(fr[j0 + j] * acc[j]); }
        __syncthreads();
        const int col0 = tid * 4;
        const int dir = col0 >> 10, ord = (col0 >> 9) & 1, ch0 = col0 & 511;
#pragma unroll 1
        for (int chunk = 0; chunk < 4; ++chunk) {
            float acc[16][4];
#pragma unroll
            for (int p = 0; p < 16; ++p)
#pragma unroll
                for (int c = 0; c < 4; ++c) acc[p][c] = 0.f;
#pragma unroll 2
            for (int j = 0; j < 64; ++j) {
                const f32x4 wv = *(const f32x4*)(w3 + j * 2048 + col0);
                f32x4 hv[4];
#pragma unroll
                for (int q = 0; q < 4; ++q) hv[q] = *(const LAS f32x4*)(h2T + j * 64 + chunk * 16 + q * 4);
#pragma unroll
                for (int p = 0; p < 16; ++p)
#pragma unroll
                    for (int c = 0; c < 4; ++c) acc[p][c] += hv[p >> 2][p & 3] * wv[c];
            }
#pragma unroll
            for (int c = 0; c < 4; ++c) {
                const int ch = ch0 + c;
                const float delta = 3.0701134573253945f + (float)ch * (12.280453829301578f / 511.0f);
                half_t* dstp = KT + ((size_t)((ord * 512 + ch) * 2 + dir) << 14) + p0 + chunk * 16;
                unsigned pk[8];
#pragma unroll
                for (int p = 0; p < 16; p += 2) {
                    const float t0 = (float)(p0 + chunk * 16 + p) / (float)(L - 1), t1 = (float)(p0 + chunk * 16 + p + 1) / (float)(L - 1);
                    const half_t x0 = (half_t)(acc[p][c] * __expf(-t0 * delta)), x1 = (half_t)(acc[p + 1][c] * __expf(-t1 * delta));
                    pk[p >> 1] = (unsigned)__builtin_bit_cast(unsigned short, x0) | ((unsigned)__builtin_bit_cast(unsigned short, x1) << 16);
                }
                *(u32x4*)dstp = (u32x4){pk[0], pk[1], pk[2], pk[3]};
                *(u32x4*)(dstp + 8) = (u32x4){pk[4], pk[5], pk[6], pk[7]};
            }
        }
    }
    __syncthreads();
}

template <bool SRC_F32> __device__ void norm_phase(const float* xs0, const float* xs1, const bf16_t* xb, const float* g, const float* sh, const float* sc, bf16_t* h) {
    constexpr int NR = SRC_F32 ? 2 : 4;
    const int tid_ = opaque_tid(); const int lane = tid_ & 63, w = tid_ >> 6;
    f32x4 gg[2][2];
#pragma unroll
    for (int i = 0; i < 2; ++i) { gg[i][0] = *(const f32x4*)(g + i * 512 + lane * 8); gg[i][1] = *(const f32x4*)(g + i * 512 + lane * 8 + 4); }
    for (int rb = (blockIdx.x * 8 + w) * NR; rb < T; rb += gridDim.x * 8 * NR) {
        const int seq = rb >> 14;
        f32x4 v[NR][2][2]; u32x4 q[NR][2];
#pragma unroll
        for (int r = 0; r < NR; ++r) {
            const int row = rb + r;
            if (SRC_F32) {
                const float* xr = seq < 2 ? xs0 + (size_t)row * 1024 : xs1 + (size_t)(row - 32768) * 1024;
#pragma unroll
                for (int i = 0; i < 2; ++i) { v[r][i][0] = *(const f32x4*)(xr + i * 512 + lane * 8); v[r][i][1] = *(const f32x4*)(xr + i * 512 + lane * 8 + 4); }
            } else {
#pragma unroll
                for (int i = 0; i < 2; ++i) q[r][i] = *(const u32x4*)(xb + (size_t)row * 1024 + i * 512 + lane * 8);
            }
        }
        f32x4 s1[2][2], s0[2][2];
#pragma unroll
        for (int i = 0; i < 2; ++i)
#pragma unroll
            for (int k = 0; k < 2; ++k) { s1[i][k] = *(const f32x4*)(sc + seq * 9216 + i * 512 + lane * 8 + 4 * k) + 1.0f; s0[i][k] = *(const f32x4*)(sh + seq * 9216 + i * 512 + lane * 8 + 4 * k); }
#pragma unroll
        for (int r = 0; r < NR; ++r) {
            const int row = rb + r;
            if (!SRC_F32) {
#pragma unroll
                for (int i = 0; i < 2; ++i) { const u32x4 t = q[r][i]; v[r][i][0] = (f32x4){bf_lo(t.x), bf_hi(t.x), bf_lo(t.y), bf_hi(t.y)}; v[r][i][1] = (f32x4){bf_lo(t.z), bf_hi(t.z), bf_lo(t.w), bf_hi(t.w)}; }
            }
            float ss = 0.f;
#pragma unroll
            for (int i = 0; i < 2; ++i)
#pragma unroll
                for (int k = 0; k < 2; ++k) ss += v[r][i][k][0] * v[r][i][k][0] + v[r][i][k][1] * v[r][i][k][1] + v[r][i][k][2] * v[r][i][k][2] + v[r][i][k][3] * v[r][i][k][3];
#pragma unroll
            for (int o = 32; o > 0; o >>= 1) ss += __shfl_xor(ss, o);
            const float rstd = rsqrtf(ss * (1.0f / 1024.0f) + EPS);
#pragma unroll
            for (int i = 0; i < 2; ++i) {
                const f32x4 y0 = v[r][i][0] * rstd * gg[i][0] * s1[i][0] + s0[i][0], y1 = v[r][i][1] * rstd * gg[i][1] * s1[i][1] + s0[i][1];
                u32x4 o; o.x = pk_bf16(y0[0], y0[1]); o.y = pk_bf16(y0[2], y0[3]); o.z = pk_bf16(y1[0], y1[1]); o.w = pk_bf16(y1[2], y1[3]);
                *(u32x4*)(h + (size_t)row * 1024 + i * 512 + lane * 8) = o;
            }
        }
    }
}
__device__ void final_norm_phase(const bf16_t* xb, float* out, const float* g) {
    constexpr int NR = 4;
    const int tid_ = opaque_tid(); const int lane = tid_ & 63, w = tid_ >> 6;
    f32x4 gg[2][2];
#pragma unroll
    for (int i = 0; i < 2; ++i) { gg[i][0] = *(const f32x4*)(g + i * 512 + lane * 8); gg[i][1] = *(const f32x4*)(g + i * 512 + lane * 8 + 4); }
    for (int rb = (blockIdx.x * 8 + w) * NR; rb < T; rb += gridDim.x * 8 * NR) {
        u32x4 q[NR][2];
#pragma unroll
        for (int r = 0; r < NR; ++r)
#pragma unroll
            for (int i = 0; i < 2; ++i) q[r][i] = *(const u32x4*)(xb + (size_t)(rb + r) * 1024 + i * 512 + lane * 8);
#pragma unroll
        for (int r = 0; r < NR; ++r) {
            f32x4 v[2][2]; float ss = 0.f;
#pragma unroll
            for (int i = 0; i < 2; ++i) { const u32x4 t = q[r][i]; v[i][0] = (f32x4){bf_lo(t.x), bf_hi(t.x), bf_lo(t.y), bf_hi(t.y)}; v[i][1] = (f32x4){bf_lo(t.z), bf_hi(t.z), bf_lo(t.w), bf_hi(t.w)}; }
#pragma unroll
            for (int i = 0; i < 2; ++i)
#pragma unroll
                for (int k = 0; k < 2; ++k) ss += v[i][k][0] * v[i][k][0] + v[i][k][1] * v[i][k][1] + v[i][k][2] * v[i][k][2] + v[i][k][3] * v[i][k][3];
#pragma unroll
            for (int o = 32; o > 0; o >>= 1) ss += __shfl_xor(ss, o);
            const float rstd = rsqrtf(ss * (1.0f / 1024.0f) + EPS);
#pragma unroll
            for (int i = 0; i < 2; ++i)
#pragma unroll
                for (int k = 0; k < 2; ++k) *(f32x4*)(out + (size_t)(rb + r) * 1024 + i * 512 + lane * 8 + 4 * k) = v[i][k] * rstd * gg[i][k];
        }
    }
}

__device__ void conva_phase(const Args& a, const bf16_t* pa, bf16_t* cat, LAS unsigned char* lds) {
    const int tid = opaque_tid(), lane = tid & 63, w = tid >> 6;
    LAS bf16_t* glu = (LAS bf16_t*)lds;
    LAS float* stage = (LAS float*)(lds + 94 * 512 * 2);
    const float* cw = a.in[11]; const float* cb = a.in[12]; const float* lg = a.in[13]; const float* lb = a.in[14];
    float wt[31];
#pragma unroll
    for (int j = 0; j < 31; ++j) wt[j] = cw[j * 512 + tid];
    const float bias = cb[tid];
    float lgv[8], lbv[8];
#pragma unroll
    for (int i = 0; i < 8; ++i) { lgv[i] = lg[lane + 64 * i]; lbv[i] = lb[lane + 64 * i]; }
    for (int tile = blockIdx.x; tile < 768; tile += gridDim.x) {
        const int seq = tile >> 8, t0 = (tile & 255) * 64;
        __syncthreads();
#pragma unroll 1
        for (int ib = 0; ib < 3; ++ib) {
            u32x4 x1[4], x2[4];
#pragma unroll
            for (int k = 0; k < 4; ++k) {
                const int idx = tid + 512 * (4 * ib + k); const int r = idx >> 6, cc = idx & 63, t = t0 - 15 + r;
                x1[k] = (u32x4){0u, 0u, 0u, 0u}; x2[k] = x1[k];
                if (idx < 94 * 64 && t >= 0 && t < L) { const bf16_t* rp = pa + (size_t)(seq * L + t) * 1024 + cc * 8; x1[k] = *(const u32x4*)rp; x2[k] = *(const u32x4*)(rp + 512); }
            }
#pragma unroll
            for (int k = 0; k < 4; ++k) {
                const int idx = tid + 512 * (4 * ib + k); const int r = idx >> 6, cc = idx & 63;
                u32x4 res;
#pragma unroll
                for (int q = 0; q < 4; ++q) res[q] = pk_bf16(bf_lo(x1[k][q]) * fsigmoid(bf_lo(x2[k][q])), bf_hi(x1[k][q]) * fsigmoid(bf_hi(x2[k][q])));
                if (idx < 94 * 64) *(LAS u32x4*)(glu + r * 512 + cc * 8) = res;
            }
        }
        __syncthreads();
        for (int chunk = 0; chunk < 8; ++chunk) {
            float o[8];
#pragma unroll
            for (int tt = 0; tt < 8; ++tt) o[tt] = bias;
#pragma unroll
            for (int i = 0; i < 38; ++i) {
                const float x = bf2f(glu[(chunk * 8 + i) * 512 + tid]);
#pragma unroll
                for (int tt = 0; tt < 8; ++tt) { const int j = i - tt; if (j >= 0 && j < 31) o[tt] += wt[j] * x; }
            }
#pragma unroll
            for (int tt = 0; tt < 8; ++tt) stage[tt * 512 + tid] = o[tt];
            __syncthreads();
            {
                float v[8]; float s = 0.f;
#pragma unroll
                for (int i = 0; i < 8; ++i) { v[i] = stage[w * 512 + lane + 64 * i]; s += v[i]; }
#pragma unroll
                for (int of = 32; of > 0; of >>= 1) s += __shfl_xor(s, of);
                const float mean = s * (1.0f / 512.0f);
                float q = 0.f;
#pragma unroll
                for (int i = 0; i < 8; ++i) { const float d = v[i] - mean; q += d * d; }
#pragma unroll
                for (int of = 32; of > 0; of >>= 1) q += __shfl_xor(q, of);
                const float rstd = rsqrtf(q * (1.0f / 512.0f) + EPS);
                bf16_t* op = cat + (size_t)(seq * L + t0 + chunk * 8 + w) * 1024;
#pragma unroll
                for (int i = 0; i < 8; ++i) { const float y = (v[i] - mean) * rstd * lgv[i] + lbv[i]; op[lane + 64 * i] = f2bf(y * fsigmoid(y)); }
            }
            __syncthreads();
        }
    }
    __syncthreads();
}

typedef float v2 __attribute__((ext_vector_type(2)));
__device__ __forceinline__ int fphys(int i) { return i + ((i >> 6) << 2); }
struct C2 { v2 r, i; };
__device__ __forceinline__ C2 cmul2(const C2& a, const C2& b) { C2 o; o.r = a.r * b.r - a.i * b.i; o.i = a.r * b.i + a.i * b.r; return o; }
__device__ __forceinline__ C2 cmulc(const C2& a, float cr, float ci) { C2 o; o.r = a.r * cr - a.i * ci; o.i = a.r * ci + a.i * cr; return o; }
template <bool INV> __device__ __forceinline__ void bf4(C2& a, C2& b, C2& c, C2& d) {
    C2 t0, t1, t2, e, t3;
    t0.r = a.r + c.r; t0.i = a.i + c.i; t1.r = a.r - c.r; t1.i = a.i - c.i; t2.r = b.r + d.r; t2.i = b.i + d.i; e.r = b.r - d.r; e.i = b.i - d.i;
    if (INV) { t3.r = -e.i; t3.i = e.r; } else { t3.r = e.i; t3.i = -e.r; }
    a.r = t0.r + t2.r; a.i = t0.i + t2.i; b.r = t1.r + t3.r; b.i = t1.i + t3.i; c.r = t0.r - t2.r; c.i = t0.i - t2.i; d.r = t1.r - t3.r; d.i = t1.i - t3.i;
}
template <bool INV, int K16> __device__ __forceinline__ C2 mulc16(const C2& a) {
    constexpr float cs[10] = {1.0f, 0.92387953251128674f, 0.70710678118654752f, 0.38268343236508977f, 0.0f, -0.38268343236508977f, -0.70710678118654752f, -0.92387953251128674f, -1.0f, -0.92387953251128674f};
    constexpr float sn[10] = {0.0f, 0.38268343236508977f, 0.70710678118654752f, 0.92387953251128674f, 1.0f, 0.92387953251128674f, 0.70710678118654752f, 0.38268343236508977f, 0.0f, -0.38268343236508977f};
    if (K16 == 4) { C2 o; if (INV) { o.r = -a.i; o.i = a.r; } else { o.r = a.i; o.i = -a.r; } return o; }
    return cmulc(a, cs[K16], INV ? sn[K16] : -sn[K16]);
}
template <bool INV, int LOGQ> __device__ __forceinline__ void r16_pass(LAS float* Fre, LAS float* Fim, int tid) {
    constexpr int Q = 1 << LOGQ;
    constexpr int PSTR = (Q >= 64) ? (Q + (Q >> 4)) : Q;
    const int b0 = 2 * tid, pos0 = b0 & (Q - 1), grp = b0 >> LOGQ, base = (grp << (LOGQ + 4)) + pos0;
    const int p = fphys(base);
    C2 x[16];
#pragma unroll
    for (int r = 0; r < 16; ++r) { x[r].r = *(const LAS v2*)(Fre + p + r * PSTR); x[r].i = *(const LAS v2*)(Fim + p + r * PSTR); }
    int posv = pos0; asm volatile("" : "+v"(posv));
    const float rev0 = (float)posv * (1.0f / (float)(16 * Q)), rev1 = (float)(posv + 1) * (1.0f / (float)(16 * Q));
    C2 w1; w1.r = (v2){__builtin_amdgcn_cosf(rev0), __builtin_amdgcn_cosf(rev1)};
    { const v2 sn = (v2){__builtin_amdgcn_sinf(rev0), __builtin_amdgcn_sinf(rev1)}; w1.i = INV ? sn : -sn; }
    const C2 w2 = cmul2(w1, w1), w3 = cmul2(w2, w1), w4 = cmul2(w2, w2), w8 = cmul2(w4, w4), w12 = cmul2(w8, w4);
    if (!INV) {
#pragma unroll
        for (int j = 0; j < 4; ++j) {
            bf4<false>(x[j], x[j + 4], x[j + 8], x[j + 12]);
            x[j + 4] = cmul2(x[j + 4], w1); x[j + 8] = cmul2(x[j + 8], w2); x[j + 12] = cmul2(x[j + 12], w3);
        }
        x[5] = mulc16<false, 1>(x[5]); x[9] = mulc16<false, 2>(x[9]); x[13] = mulc16<false, 3>(x[13]);
        x[6] = mulc16<false, 2>(x[6]); x[10] = mulc16<false, 4>(x[10]); x[14] = mulc16<false, 6>(x[14]);
        x[7] = mulc16<false, 3>(x[7]); x[11] = mulc16<false, 6>(x[11]); x[15] = mulc16<false, 9>(x[15]);
#pragma unroll
        for (int r = 0; r < 4; ++r) {
            bf4<false>(x[4 * r], x[4 * r + 1], x[4 * r + 2], x[4 * r + 3]);
            x[4 * r + 1] = cmul2(x[4 * r + 1], w4); x[4 * r + 2] = cmul2(x[4 * r + 2], w8); x[4 * r + 3] = cmul2(x[4 * r + 3], w12);
        }
    } else {
#pragma unroll
        for (int r = 0; r < 4; ++r) {
            x[4 * r + 1] = cmul2(x[4 * r + 1], w4); x[4 * r + 2] = cmul2(x[4 * r + 2], w8); x[4 * r + 3] = cmul2(x[4 * r + 3], w12);
            bf4<true>(x[4 * r], x[4 * r + 1], x[4 * r + 2], x[4 * r + 3]);
        }
        x[5] = mulc16<true, 1>(x[5]); x[9] = mulc16<true, 2>(x[9]); x[13] = mulc16<true, 3>(x[13]);
        x[6] = mulc16<true, 2>(x[6]); x[10] = mulc16<true, 4>(x[10]); x[14] = mulc16<true, 6>(x[14]);
        x[7] = mulc16<true, 3>(x[7]); x[11] = mulc16<true, 6>(x[11]); x[15] = mulc16<true, 9>(x[15]);
#pragma unroll
        for (int j = 0; j < 4; ++j) {
            x[j + 4] = cmul2(x[j + 4], w1); x[j + 8] = cmul2(x[j + 8], w2); x[j + 12] = cmul2(x[j + 12], w3);
            bf4<true>(x[j], x[j + 4], x[j + 8], x[j + 12]);
        }
    }
#pragma unroll
    for (int r = 0; r < 16; ++r) { *(LAS v2*)(Fre + p + r * PSTR) = x[r].r; *(LAS v2*)(Fim + p + r * PSTR) = x[r].i; }
}
template <bool INV> __device__ __forceinline__ void r4_pass(LAS float* Fre, LAS float* Fim, int tid) {
#pragma unroll 2
    for (int bi = 0; bi < 4; ++bi) {
        const int p = fphys(8 * (tid + 512 * bi));
        const f32x4 ra = *(const LAS f32x4*)(Fre + p), rb = *(const LAS f32x4*)(Fre + p + 4), ia = *(const LAS f32x4*)(Fim + p), ib = *(const LAS f32x4*)(Fim + p + 4);
        C2 x0, x1, x2, x3;
        x0.r = (v2){ra[0], rb[0]}; x1.r = (v2){ra[1], rb[1]}; x2.r = (v2){ra[2], rb[2]}; x3.r = (v2){ra[3], rb[3]};
        x0.i = (v2){ia[0], ib[0]}; x1.i = (v2){ia[1], ib[1]}; x2.i = (v2){ia[2], ib[2]}; x3.i = (v2){ia[3], ib[3]};
        bf4<INV>(x0, x1, x2, x3);
        *(LAS f32x4*)(Fre + p) = (f32x4){x0.r[0], x1.r[0], x2.r[0], x3.r[0]}; *(LAS f32x4*)(Fre + p + 4) = (f32x4){x0.r[1], x1.r[1], x2.r[1], x3.r[1]};
        *(LAS f32x4*)(Fim + p) = (f32x4){x0.i[0], x1.i[0], x2.i[0], x3.i[0]}; *(LAS f32x4*)(Fim + p + 4) = (f32x4){x0.i[1], x1.i[1], x2.i[1], x3.i[1]};
    }
}
__device__ __forceinline__ void fft_fwd(LAS float* Fre, LAS float* Fim, int tid) {
    r16_pass<false, 10>(Fre, Fim, tid); __syncthreads(); r16_pass<false, 6>(Fre, Fim, tid); __syncthreads(); r16_pass<false, 2>(Fre, Fim, tid); __syncthreads(); r4_pass<false>(Fre, Fim, tid);
}
__device__ __forceinline__ void fft_inv(LAS float* Fre, LAS float* Fim, int tid) {
    r4_pass<true>(Fre, Fim, tid); __syncthreads(); r16_pass<true, 2>(Fre, Fim, tid); __syncthreads(); r16_pass<true, 6>(Fre, Fim, tid); __syncthreads(); r16_pass<true, 10>(Fre, Fim, tid);
}
typedef _Float16 h8v __attribute__((ext_vector_type(8)));
__device__ __forceinline__ void sconv8(const bf16_t* row, int n0, float w0, float w1, float w2, float b, float (&out)[8]) {
    const u32x4 q = *(const u32x4*)(row + n0);
    float x[10];
    x[0] = n0 > 0 ? bf2f(row[n0 - 1]) : 0.f;
    x[9] = n0 + 8 < L ? bf2f(row[n0 + 8]) : 0.f;
#pragma unroll
    for (int i = 0; i < 4; ++i) { x[1 + 2 * i] = bf_lo(q[i]); x[2 + 2 * i] = bf_hi(q[i]); }
#pragma unroll
    for (int e = 0; e < 8; ++e) out[e] = b + w0 * x[e] + w1 * x[e + 1] + w2 * x[e + 2];
}
struct Raw8 { u32x4 q; unsigned short lo, hi; };
__device__ __forceinline__ Raw8 raw8_load(const bf16_t* row, int n0) {
    Raw8 r; r.q = *(const u32x4*)(row + n0);
    r.lo = n0 > 0 ? row[n0 - 1] : (unsigned short)0; r.hi = n0 + 8 < L ? row[n0 + 8] : (unsigned short)0;
    return r;
}
__device__ __forceinline__ void sconv8_raw(const Raw8& r, float w0, float w1, float w2, float b, float (&out)[8]) {
    float x[10];
    x[0] = bf2f(r.lo); x[9] = bf2f(r.hi);
#pragma unroll
    for (int i = 0; i < 4; ++i) { x[1 + 2 * i] = bf_lo(r.q[i]); x[2 + 2 * i] = bf_hi(r.q[i]); }
#pragma unroll
    for (int e = 0; e < 8; ++e) out[e] = b + w0 * x[e] + w1 * x[e + 1] + w2 * x[e + 2];
}
template <bool CONJ> __device__ __forceinline__ void tw8(int n0, float (&tr)[8], float (&ti)[8]) {
    const float rev = (float)n0 * (1.0f / (float)(2 * L));
    const float sr = 0.99999998161642933f, si = CONJ ? 1.9174759731070330e-4f : -1.9174759731070330e-4f;
    tr[0] = __builtin_amdgcn_cosf(rev); ti[0] = CONJ ? __builtin_amdgcn_sinf(rev) : -__builtin_amdgcn_sinf(rev);
#pragma unroll
    for (int e = 1; e < 8; ++e) { tr[e] = tr[e - 1] * sr - ti[e - 1] * si; ti[e] = tr[e - 1] * si + ti[e - 1] * sr; }
}
__device__ __forceinline__ void st8(LAS float* p, const float (&v)[8]) { *(LAS f32x4*)p = (f32x4){v[0], v[1], v[2], v[3]}; *(LAS f32x4*)(p + 4) = (f32x4){v[4], v[5], v[6], v[7]}; }
__device__ __forceinline__ void ld8(const LAS float* p, float (&v)[8]) { const f32x4 a = *(const LAS f32x4*)p, b = *(const LAS f32x4*)(p + 4);
#pragma unroll
    for (int e = 0; e < 4; ++e) { v[e] = a[e]; v[4 + e] = b[e]; } }
template <bool DRY> __device__ void fft_phase(const Args& a, bf16_t* pbT, LAS unsigned char* lds) {
    const int tid = opaque_tid(), lane = tid & 63, w = tid >> 6;
    LAS float* Fre = (LAS float*)lds; LAS float* Fim = Fre + 17408;
    LAS float* red = (LAS float*)(lds + 17408 * 8);
    const int po = fphys(8 * tid);
    const half_t* KT = (const half_t*)(a.ws + WS_KT);
    unsigned char* scr = a.ws + WS_ACT + PBT_BYTES + (size_t)blockIdx.x * FFTSCR_PER_BLOCK;
    float* ybuf = (float*)scr;
    float* z1buf = (float*)(scr + 2ull * L * 8);
    const float* sw = a.in[15]; const float* sb = a.in[16]; const float* skip = a.in[23];
    for (int ch = blockIdx.x; ch < 512; ch += gridDim.x) {
        const float vw0 = sw[ch], vw1 = sw[1536 + ch], vw2 = sw[3072 + ch], vb = sb[ch];
#pragma unroll 1
        for (int o = 0; o < 2; ++o) {
            const half_t* kf = KT + ((size_t)((o * 512 + ch) * 2) << 14); const half_t* kb = kf + L;
            const int xc = (o == 0 ? 512 : 1024) + ch;
            const float gw0 = sw[xc], gw1 = sw[1536 + xc], gw2 = sw[3072 + xc], gb = sb[xc];
            const float skp = skip[o * 512 + ch];
            float ss = 0.f;
#pragma unroll 1
            for (int g = 0; g < 4; ++g) {
                const int n0 = 8 * (tid + 512 * g);
                const h8v f = *(const h8v*)(kf + n0), bk = *(const h8v*)(kb + n0);
#pragma unroll
                for (int e = 0; e < 8; ++e) { const float ff = (float)f[e], bb = (n0 + e > 0) ? (float)bk[e] : 0.f; ss += ff * ff + bb * bb; }
            }
#pragma unroll
            for (int of = 32; of > 0; of >>= 1) ss += __shfl_xor(ss, of);
            __syncthreads();
            if (lane == 0) red[w] = ss;
            __syncthreads();
            float tot = 0.f;
#pragma unroll
            for (int ww = 0; ww < 8; ++ww) tot += red[ww];
            const float kscale = rsqrtf(tot + EPS) * (0.5f / (float)L);
#pragma unroll 1
            for (int br = 0; br < 2; ++br) {
                __syncthreads();
#pragma unroll 1
                for (int g = 0; g < 4; ++g) {
                    const int n0 = 8 * (tid + 512 * g);
                    const h8v f = *(const h8v*)(kf + n0), bc = *(const h8v*)(kb + (L - 8 - n0));
                    const float b0 = n0 > 0 ? (float)kb[L - n0] : 0.f;
                    float d[8], vr[8], vi[8];
#pragma unroll
                    for (int e = 0; e < 8; ++e) { const float bk = (e == 0) ? b0 : (float)bc[8 - e]; d[e] = (br == 0 ? (float)f[e] + bk : (float)f[e] - bk) * kscale; }
                    if (br == 0) {
#pragma unroll
                        for (int e = 0; e < 8; ++e) { vr[e] = d[e]; vi[e] = 0.f; }
                    } else {
                        float tr[8], ti[8]; tw8<false>(n0, tr, ti);
#pragma unroll
                        for (int e = 0; e < 8; ++e) { vr[e] = d[e] * tr[e]; vi[e] = d[e] * ti[e]; }
                    }
                    st8(Fre + po + 4352 * g, vr); st8(Fim + po + 4352 * g, vi);
                }
                __syncthreads();
                fft_fwd(Fre, Fim, tid);
                __syncthreads();
                float KrR[32], KrI[32];
#pragma unroll
                for (int g = 0; g < 4; ++g) {
                    const f32x4 r0 = *(const LAS f32x4*)(Fre + po + 4352 * g), r1 = *(const LAS f32x4*)(Fre + po + 4352 * g + 4), i0 = *(const LAS f32x4*)(Fim + po + 4352 * g), i1 = *(const LAS f32x4*)(Fim + po + 4352 * g + 4);
#pragma unroll
                    for (int e = 0; e < 4; ++e) { KrR[g * 8 + e] = r0[e]; KrR[g * 8 + 4 + e] = r1[e]; KrI[g * 8 + e] = i0[e]; KrI[g * 8 + 4 + e] = i1[e]; }
                }
#pragma unroll 1
                for (int pk = 0; pk < 2; ++pk) {
                    __syncthreads();
#pragma unroll 1
                    for (int g = 0; g < 4; ++g) {
                        const int n0 = 8 * (tid + 512 * g);
                        float re[8], im[8];
                        if (o == 0) {
                            sconv8(pbT + ((size_t)((2 * pk) * 1536 + ch) << 14), n0, vw0, vw1, vw2, vb, re);
                            if (pk == 0) sconv8(pbT + ((size_t)(1536 + ch) << 14), n0, vw0, vw1, vw2, vb, im);
                        } else {
                            const f32x4 r0 = *(const f32x4*)(z1buf + (2 * pk) * L + n0), r1 = *(const f32x4*)(z1buf + (2 * pk) * L + n0 + 4);
#pragma unroll
                            for (int e = 0; e < 4; ++e) { re[e] = r0[e]; re[4 + e] = r1[e]; }
                            if (pk == 0) { const f32x4 i0 = *(const f32x4*)(z1buf + L + n0), i1 = *(const f32x4*)(z1buf + L + n0 + 4);
#pragma unroll
                                for (int e = 0; e < 4; ++e) { im[e] = i0[e]; im[4 + e] = i1[e]; } }
                        }
                        if (pk == 1) {
#pragma unroll
                            for (int e = 0; e < 8; ++e) im[e] = 0.f;
                        }
                        if (br == 1) {
                            float tr[8], ti[8]; tw8<false>(n0, tr, ti);
#pragma unroll
                            for (int e = 0; e < 8; ++e) { const float xr = re[e] * tr[e] - im[e] * ti[e], xi = re[e] * ti[e] + im[e] * tr[e]; re[e] = xr; im[e] = xi; }
                        }
                        st8(Fre + po + 4352 * g, re); st8(Fim + po + 4352 * g, im);
                    }
                    __syncthreads();
                    fft_fwd(Fre, Fim, tid);
                    __syncthreads();
#pragma unroll
                    for (int g = 0; g < 4; ++g) {
                        float xr[8], xi[8], yr[8], yi[8];
                        ld8(Fre + po + 4352 * g, xr); ld8(Fim + po + 4352 * g, xi);
#pragma unroll
                        for (int e = 0; e < 8; ++e) { yr[e] = xr[e] * KrR[g * 8 + e] - xi[e] * KrI[g * 8 + e]; yi[e] = xr[e] * KrI[g * 8 + e] + xi[e] * KrR[g * 8 + e]; }
                        st8(Fre + po + 4352 * g, yr); st8(Fim + po + 4352 * g, yi);
                    }
                    __syncthreads();
                    fft_inv(Fre, Fim, tid);
                    __syncthreads();
#pragma unroll 1
                    for (int g = 0; g < 4; ++g) {
                        const int n0 = 8 * (tid + 512 * g);
                        float rr[8], ri[8];
                        ld8(Fre + po + 4352 * g, rr); ld8(Fim + po + 4352 * g, ri);
                        float* ybr = ybuf + (size_t)pk * 2 * L + n0; float* ybi = ybr + L;
                        if (br == 0) {
                            *(f32x4*)ybr = (f32x4){rr[0], rr[1], rr[2], rr[3]}; *(f32x4*)(ybr + 4) = (f32x4){rr[4], rr[5], rr[6], rr[7]};
                            *(f32x4*)ybi = (f32x4){ri[0], ri[1], ri[2], ri[3]}; *(f32x4*)(ybi + 4) = (f32x4){ri[4], ri[5], ri[6], ri[7]};
                        } else {
                            const f32x4 yr0 = *(const f32x4*)ybr, yr1 = *(const f32x4*)(ybr + 4), yi0 = *(const f32x4*)ybi, yi1 = *(const f32x4*)(ybi + 4);
                            const int s0 = 2 * pk;
                            Raw8 gt0 = raw8_load(pbT + ((size_t)(s0 * 1536 + xc) << 14), n0), gt1 = gt0, vt0 = gt0, vt1 = gt0;
                            f32x4 za0 = yr0, za1 = yr0, zb0 = yr0, zb1 = yr0;
                            if (pk == 0) gt1 = raw8_load(pbT + ((size_t)(1536 + xc) << 14), n0);
                            if (o == 0) { vt0 = raw8_load(pbT + ((size_t)(s0 * 1536 + ch) << 14), n0); if (pk == 0) vt1 = raw8_load(pbT + ((size_t)(1536 + ch) << 14), n0); }
                            else { za0 = *(const f32x4*)(z1buf + s0 * L + n0); za1 = *(const f32x4*)(z1buf + s0 * L + n0 + 4); if (pk == 0) { zb0 = *(const f32x4*)(z1buf + L + n0); zb1 = *(const f32x4*)(z1buf + L + n0 + 4); } }
                            float tr[8], ti[8]; tw8<true>(n0, tr, ti);
                            float yre[8], yim[8];
#pragma unroll
                            for (int e = 0; e < 8; ++e) {
                                yre[e] = (e < 4 ? yr0[e & 3] : yr1[e & 3]) + rr[e] * tr[e] - ri[e] * ti[e];
                                yim[e] = (e < 4 ? yi0[e & 3] : yi1[e & 3]) + rr[e] * ti[e] + ri[e] * tr[e];
                            }
                            const int nseq = (pk == 0) ? 2 : 1;
#pragma unroll
                            for (int q = 0; q < 2; ++q) if (q < nseq) {
                                const int s = 2 * pk + q;
                                float gate[8];
                                sconv8_raw(q == 0 ? gt0 : gt1, gw0, gw1, gw2, gb, gate);
                                float* zp = z1buf + s * L + n0;
                                float z[8];
                                if (o == 0) {
                                    float vv[8];
                                    sconv8_raw(q == 0 ? vt0 : vt1, vw0, vw1, vw2, vb, vv);
#pragma unroll
                                    for (int e = 0; e < 8; ++e) z[e] = gate[e] * ((q == 0 ? yre[e] : yim[e]) + vv[e] * skp);
                                    *(f32x4*)zp = (f32x4){z[0], z[1], z[2], z[3]}; *(f32x4*)(zp + 4) = (f32x4){z[4], z[5], z[6], z[7]};
                                } else {
                                    const f32x4 z0 = q == 0 ? za0 : zb0, z1 = q == 0 ? za1 : zb1;
#pragma unroll
                                    for (int e = 0; e < 8; ++e) z[e] = gate[e] * ((q == 0 ? yre[e] : yim[e]) + (e < 4 ? z0[e & 3] : z1[e & 3]) * skp);
                                    u32x4 wv; wv.x = pk_bf16(z[0], z[1]); wv.y = pk_bf16(z[2], z[3]); wv.z = pk_bf16(z[4], z[5]); wv.w = pk_bf16(z[6], z[7]);
                                    if (!DRY) *(u32x4*)(pbT + ((size_t)(s * 1536 + ch) << 14) + n0) = wv;
                                }
                            }
                        }
                    }
                }
            }
            __syncthreads();
        }
    }
    __syncthreads();
}

__device__ void ztrans_phase(const bf16_t* pbT, bf16_t* cat, LAS unsigned char* lds) {
    const int tid = opaque_tid();
    LAS unsigned* tl = (LAS unsigned*)lds;
    LAS bf16_t* tb = (LAS bf16_t*)lds;
    for (int tile0 = blockIdx.x * 2; tile0 < 6144; tile0 += gridDim.x * 2) {
        __syncthreads();
        u32x4 v[2];
#pragma unroll
        for (int k = 0; k < 2; ++k) { const int tile = tile0 + k; const int tt0 = (tile & 255) * 64, ct = (tile >> 8) & 7, s = tile >> 11; const int cc = tid >> 3, tk = (tid & 7) * 8;
            v[k] = *(const u32x4*)(pbT + ((size_t)(s * 1536 + ct * 64 + cc) << 14) + tt0 + tk); }
#pragma unroll
        for (int k = 0; k < 2; ++k) { const int cc = tid >> 3, tk = (tid & 7) * 8;
#pragma unroll
            for (int q = 0; q < 4; ++q) tl[k * 2112 + cc * 33 + (tk >> 1) + q] = v[k][q]; }
        __syncthreads();
#pragma unroll
        for (int k = 0; k < 2; ++k) { const int tile = tile0 + k; const int tt0 = (tile & 255) * 64, ct = (tile >> 8) & 7, s = tile >> 11;
            const int tt = tid >> 3, cg8 = (tid & 7) * 8; bf16_t e[8];
#pragma unroll
            for (int i = 0; i < 8; ++i) e[i] = tb[k * 4224 + (cg8 + i) * 66 + tt];
            u32x4 wv; wv.x = e[0] | ((unsigned)e[1] << 16); wv.y = e[2] | ((unsigned)e[3] << 16); wv.z = e[4] | ((unsigned)e[5] << 16); wv.w = e[6] | ((unsigned)e[7] << 16);
            *(u32x4*)(cat + (size_t)(s * L + tt0 + tt) * 1024 + 512 + ct * 64 + cg8) = wv; }
    }
    __syncthreads();
}

__device__ void attn_phase(const Args& a, const bf16_t* qkv, bf16_t* ao, LAS unsigned char* lds) {
    const int tid = opaque_tid(), lane = tid & 63, w = tid >> 6, l31 = lane & 31, hh = lane >> 5;
    LAS bf16_t* Ks = (LAS bf16_t*)lds;
    LAS bf16_t* VT = (LAS bf16_t*)(lds + 384 * 72 * 2);
    const float* sink = a.in[26];
    for (int item = blockIdx.x; item < 1536; item += gridDim.x) {
        const int kvh = item & 3, qb = (item >> 2) & 127, seq = item >> 9;
        const int kb0 = qb * 128 - 128;
        __syncthreads();
#pragma unroll 1
        for (int ib = 0; ib < 2; ++ib) {
            u32x4 kv[3], vv[3];
#pragma unroll
            for (int k = 0; k < 3; ++k) {
                const int idx = tid + 512 * (3 * ib + k); const int key = idx % 384, dc = idx / 384, kpos = kb0 + key;
                kv[k] = (u32x4){0u, 0u, 0u, 0u}; vv[k] = kv[k];
                if (kpos >= 0 && kpos < L) { const bf16_t* rp = qkv + (size_t)(seq * L + kpos) * 1536 + kvh * 64 + dc * 8; kv[k] = *(const u32x4*)(rp + 1024); vv[k] = *(const u32x4*)(rp + 1280); }
            }
#pragma unroll
            for (int k = 0; k < 3; ++k) {
                const int idx = tid + 512 * (3 * ib + k); const int key = idx % 384, dc = idx / 384;
                *(LAS u32x4*)(Ks + key * 72 + dc * 8) = kv[k];
#pragma unroll
                for (int i = 0; i < 8; ++i) VT[(dc * 8 + i) * 392 + key] = (bf16_t)((vv[k][i >> 1] >> (16 * (i & 1))) & 0xffffu);
            }
        }
        __syncthreads();
        for (int uu = 0; uu < 2; ++uu) {
            const int u = w + 8 * uu, g = u >> 2, qs = u & 3, h = kvh * 4 + g, q0 = qb * 128 + 32 * qs;
            bf16x8 qf[4];
            const bf16_t* qp = qkv + (size_t)(seq * L + q0 + l31) * 1536 + h * 64 + 8 * hh;
#pragma unroll
            for (int ks = 0; ks < 4; ++ks) qf[ks] = *(const bf16x8*)(qp + 16 * ks);
            const float LOG2E = 1.4426950408889634f;
            const float c1 = 0.125f * LOG2E, slope2 = exp2f(-0.5f * (float)(h + 1)) * LOG2E;
            float m = sink[h] * LOG2E, lsum = 1.0f;
            const bool edge = (qb == 0) || (qb == 127);
            f32x16 O0, O1;
#pragma unroll
            for (int r = 0; r < 16; ++r) { O0[r] = 0.f; O1[r] = 0.f; }
#pragma unroll 1
            for (int kt = 0; kt < 9; ++kt) {
                const int kl0 = 32 * qs + 32 * kt;
                f32x16 S;
#pragma unroll
                for (int r = 0; r < 16; ++r) S[r] = 0.f;
#pragma unroll
                for (int ks = 0; ks < 4; ++ks) { const bf16x8 af = *(const LAS bf16x8*)(Ks + (kl0 + l31) * 72 + 16 * ks + 8 * hh); S = __builtin_amdgcn_mfma_f32_32x32x16_bf16(af, qf[ks], S, 0, 0, 0); }
                float p[16]; float mt = -1e30f;
                const float dbase = (float)(32 * kt - 128 + 4 * hh - l31);
                if (kt == 0 || kt == 8 || edge) {
#pragma unroll
                    for (int r = 0; r < 16; ++r) {
                        const int i = 8 * (r >> 2) + 4 * hh + (r & 3);
                        const int kpos = q0 - 128 + 32 * kt + i;
                        const float ad = __builtin_fabsf(dbase + (float)(8 * (r >> 2) + (r & 3)));
                        const bool valid = (ad <= 128.0f) && (kpos >= 0) && (kpos < L);
                        p[r] = valid ? (S[r] * c1 - slope2 * ad) : -1e30f;
                        mt = fmaxf(mt, p[r]);
                    }
                } else {
#pragma unroll
                    for (int r = 0; r < 16; ++r) {
                        const float ad = __builtin_fabsf(dbase + (float)(8 * (r >> 2) + (r & 3)));
                        p[r] = S[r] * c1 - slope2 * ad;
                        mt = fmaxf(mt, p[r]);
                    }
                }
                mt = fmaxf(mt, __shfl_xor(mt, 32));
                const float mnew = fmaxf(m, mt);
                if (__builtin_amdgcn_ballot_w64(mnew != m) != 0ull) {
                    const float alpha = __builtin_amdgcn_exp2f(m - mnew);
                    lsum *= alpha;
#pragma unroll
                    for (int r = 0; r < 16; ++r) { O0[r] *= alpha; O1[r] *= alpha; }
                    m = mnew;
                }
                float rs = 0.f;
#pragma unroll
                for (int r = 0; r < 16; ++r) { p[r] = __builtin_amdgcn_exp2f(p[r] - m); rs += p[r]; }
                rs += __shfl_xor(rs, 32);
                lsum += rs;
#pragma unroll
                for (int kk = 0; kk < 2; ++kk) {
                    u32x4 pw; pw.x = pk_bf16(p[8 * kk], p[8 * kk + 1]); pw.y = pk_bf16(p[8 * kk + 2], p[8 * kk + 3]); pw.z = pk_bf16(p[8 * kk + 4], p[8 * kk + 5]); pw.w = pk_bf16(p[8 * kk + 6], p[8 * kk + 7]);
                    const bf16x8 pf = __builtin_bit_cast(bf16x8, pw);
#pragma unroll
                    for (int dt = 0; dt < 2; ++dt) {
                        const LAS bf16_t* vp = VT + (32 * dt + l31) * 392 + kl0 + 16 * kk + 4 * hh;
                        const u32x2 lo = *(const LAS u32x2*)vp, hi = *(const LAS u32x2*)(vp + 8);
                        const bf16x8 vf = __builtin_bit_cast(bf16x8, (u32x4){lo.x, lo.y, hi.x, hi.y});
                        if (dt == 0) O0 = __builtin_amdgcn_mfma_f32_32x32x16_bf16(vf, pf, O0, 0, 0, 0);
                        else O1 = __builtin_amdgcn_mfma_f32_32x32x16_bf16(vf, pf, O1, 0, 0, 0);
                    }
                }
            }
            const float inv = 1.0f / lsum;
            bf16_t* op = ao + (size_t)(seq * L + q0 + l31) * 1024 + h * 64 + 4 * hh;
#pragma unroll
            for (int b = 0; b < 4; ++b) {
                u32x2 o0; o0.x = pk_bf16(O0[4 * b] * inv, O0[4 * b + 1] * inv); o0.y = pk_bf16(O0[4 * b + 2] * inv, O0[4 * b + 3] * inv);
                u32x2 o1; o1.x = pk_bf16(O1[4 * b] * inv, O1[4 * b + 1] * inv); o1.y = pk_bf16(O1[4 * b + 2] * inv, O1[4 * b + 3] * inv);
                *(u32x2*)(op + 8 * b) = o0; *(u32x2*)(op + 32 + 8 * b) = o1;
            }
        }
    }
    __syncthreads();
}

__global__ void __launch_bounds__(512, 2) mega(Args a) {
    extern __shared__ __attribute__((aligned(16))) unsigned char lds_raw[];
    LAS unsigned char* lds = (LAS unsigned char*)lds_raw;
    unsigned char* ws = a.ws;
    const int lo = a.ph_lo, hi = a.ph_hi;
    bf16_t* XB = (bf16_t*)(ws + WS_H);
    const float* mod = (const float*)(ws + WS_MOD);
    bf16_t* H = (bf16_t*)a.out;
    bf16_t* ACT = (bf16_t*)(ws + WS_ACT);
    bf16_t* PBT = ACT;
    bf16_t* PA = (bf16_t*)(ws + WS_ACT + PBT_BYTES);
    const int G = gridDim.x, bx = blockIdx.x;
    volatile LAS unsigned* bst = (volatile LAS unsigned*)(lds + LDS_BYTES - 16);
    if (threadIdx.x < 4) bst[threadIdx.x] = 0u;
    __syncthreads();
    const XcdBarrier xbar = xcd_barrier_post((unsigned*)(ws + WS_BAR), bst);
#define GSYNC() xcd_barrier(xbar)
#define IN(k) (lo <= (k) && (k) < hi)
#define SEAM(k) do { if (IN(k) && IN((k) + 1)) { GSYNC(); if ((RM >> 15) & 1) GSYNC(); } } while (0)
    int ph = 0;
    if (IN(0)) REP(0) { if (EN(0)) convert_weights(a, (LAS float*)lds); if (EN(1)) ada_phase(a, (LAS float*)lds); if (EN(2)) filter_phase(a, (LAS float*)lds); }
    if (IN(0) && IN(1)) cg::this_grid().sync();
    ph = 1;
#pragma unroll 1
    for (int layer = 0; layer < 2; ++layer) {
        const float* ml = mod + (size_t)layer * 3 * 9216;
        const float* ng = a.in[6] + layer * 3 * 1024;
#pragma unroll 1
        for (int sub = 0; sub < 3; ++sub) {
            const bool first = (layer == 0 && sub == 0);
            const float* xs0 = a.in[0]; const float* xs1 = a.in[1];
            const float* shp = ml + (3 * sub) * 1024; const float* scp = shp + 1024; const float* gp = shp + 2048;
            if (EN(3) && IN(ph)) REP(3) { if (first) norm_phase<true>(xs0, xs1, XB, ng + sub * 1024, shp, scp, H); else norm_phase<false>(xs0, xs1, XB, ng + sub * 1024, shp, scp, H); }
            SEAM(ph); ++ph;
            if (sub != 1) {
                const int fi = layer * 2 + (sub == 2 ? 1 : 0);
                if (EN(4) && IN(ph)) REP(4) { pg8::Gemm g{H, (const bf16_t*)(ws + WS_WIN) + (size_t)fi * 5632 * 1024, T, 5632, 1024}; pg8::StaticOrder S; S.init(T, 5632, G, bx);
                    EpiSwiglu E{ACT}; pg8::gemm_phase<EpiSwiglu>(lds, g, S, E); }
                SEAM(ph); ++ph;
                if (EN(5) && IN(ph)) { pg8::Gemm g{ACT, (const bf16_t*)(ws + WS_WOUT) + (size_t)fi * 1024 * 2816, T, 1024, DFF}; pg8::StaticOrder S; S.init(T, 1024, G, bx);
                    if (first) { EpiResid<true> E{xs0, xs1, XB, XB, gp, 0.5f}; pg8::gemm_phase<EpiResid<true>>(lds, g, S, E); } else { EpiResid<false> E{xs0, xs1, XB, XB, gp, 0.5f}; pg8::gemm_phase<EpiResid<false>>(lds, g, S, E); } }
                SEAM(ph); ++ph;
            } else if (layer == 0) {
                if (EN(6) && IN(ph)) REP(6) { pg8::Gemm g{H, (const bf16_t*)(ws + WS_WABIN), T, 2560, 1024}; pg8::StaticOrder S; S.init(T, 2560, G, bx);
                    EpiProj E{PA, PBT}; pg8::gemm_phase<EpiProj>(lds, g, S, E); }
                SEAM(ph); ++ph;
                if (IN(ph)) { if (EN(7)) REP(7) conva_phase(a, PA, H, lds); GSYNC(); if ((RM >> 8) & 1) fft_phase<true>(a, PBT, lds); if (EN(8)) fft_phase<false>(a, PBT, lds); }
                SEAM(ph); ++ph;
                if (EN(9) && IN(ph)) REP(9) ztrans_phase(PBT, H, lds);
                SEAM(ph); ++ph;
                if (EN(5) && IN(ph)) { pg8::Gemm g{H, (const bf16_t*)(ws + WS_WABOUT), T, 1024, 1024}; pg8::StaticOrder S; S.init(T, 1024, G, bx);
                    EpiResid<false> E{xs0, xs1, XB, XB, gp, 1.0f}; pg8::gemm_phase<EpiResid<false>>(lds, g, S, E); }
                SEAM(ph); ++ph;
            } else {
                if (EN(10) && IN(ph)) REP(10) { pg8::Gemm g{H, (const bf16_t*)(ws + WS_WQKV), T, 1536, 1024}; pg8::StaticOrder S; S.init(T, 1536, G, bx);
                    EpiBf16 E{ACT, 1536}; pg8::gemm_phase<EpiBf16>(lds, g, S, E); }
                SEAM(ph); ++ph;
                if (EN(11) && IN(ph)) REP(11) attn_phase(a, ACT, H, lds);
                SEAM(ph); ++ph;
                if (EN(5) && IN(ph)) { pg8::Gemm g{H, (const bf16_t*)(ws + WS_WATTO), T, 1024, 1024}; pg8::StaticOrder S; S.init(T, 1024, G, bx);
                    EpiResid<false> E{xs0, xs1, XB, XB, gp, 1.0f}; pg8::gemm_phase<EpiResid<false>>(lds, g, S, E); }
                SEAM(ph); ++ph;
            }
        }
    }
    if (EN(12) && IN(ph)) final_norm_phase(XB, a.out, a.in[9]);
#undef IN
#undef SEAM
}

extern "C" void kernel_launch(void* const* d_in, const int* in_sizes, int n_in, void* d_out, int out_size, void* d_ws, size_t ws_size, hipStream_t stream) {
    static int grid = 0;
    if (grid == 0) {
        int dev = 0, cus = 0, per_cu = 0;
        (void)hipGetDevice(&dev);
        (void)hipDeviceGetAttribute(&cus, hipDeviceAttributeMultiprocessorCount, dev);
        (void)hipFuncSetAttribute((const void*)mega, hipFuncAttributeMaxDynamicSharedMemorySize, LDS_BYTES);
        (void)hipOccupancyMaxActiveBlocksPerMultiprocessor(&per_cu, (const void*)mega, 512, LDS_BYTES);
        if (per_cu < 1) per_cu = 1;
        grid = cus * per_cu;
        if (grid > 256) grid = 256;
        if (ws_size < WS_END) { fprintf(stderr, "workspace too small: %zu < %zu\n", ws_size, (size_t)WS_END); grid = -1; }
    }
    if (grid < 0) return;
    Args a{};
    for (int i = 0; i < 28; ++i) a.in[i] = (const float*)d_in[i];
    a.out = (float*)d_out; a.ws = (unsigned char*)d_ws;
    (void)hipMemsetAsync((unsigned char*)d_ws + WS_BAR, 0, XCD_BAR_WORDS * 4, stream);
#if N_LAUNCH_MODE == 1
    a.ph_lo = 0; a.ph_hi = NPH;
    void* args[] = {&a};
    hipError_t e = hipLaunchCooperativeKernel((const void*)mega, dim3(grid), dim3(512), args, LDS_BYTES, stream);
    if (e != hipSuccess) fprintf(stderr, "cooperative launch failed: %s (grid %d)\n", hipGetErrorString(e), grid);
#else
    for (int p = 0; p < NPH; ++p) { a.ph_lo = p; a.ph_hi = p + 1; hipLaunchKernelGGL(mega, dim3(grid), dim3(512), LDS_BYTES, stream, a); }
#endif
}
```

```cpp
#include <hip/hip_runtime.h>
#include <hip/hip_cooperative_groups.h>
#include <cstdio>
namespace cg = cooperative_groups;

#ifndef PM
#define PM 0xffff
#endif
#define EN(b) ((PM >> (b)) & 1)
#ifndef RM
#define RM 0
#endif
#define REP(b) for (int rep_ = 0; rep_ < 1 + ((RM >> (b)) & 1); ++rep_)
#ifndef N_LAUNCH_MODE
#define N_LAUNCH_MODE 1
#endif

#define LAS __attribute__((address_space(3)))
typedef unsigned short bf16_t;
typedef short bf16x8 __attribute__((ext_vector_type(8)));
typedef float f32x4 __attribute__((ext_vector_type(4)));
typedef float f32x16 __attribute__((ext_vector_type(16)));
typedef unsigned u32x4 __attribute__((ext_vector_type(4)));
typedef unsigned u32x2 __attribute__((ext_vector_type(2)));
typedef __bf16 bf16x2v __attribute__((ext_vector_type(2)));
typedef float f32x2v __attribute__((ext_vector_type(2)));
typedef _Float16 half_t;

constexpr int T = 49152, D = 1024, L = 16384, DFF = 2816, NPH = 23;
constexpr float EPS = 1e-6f;
constexpr int LDS_BYTES = 147456;

constexpr size_t WS_WIN = 0;
constexpr size_t WS_WOUT = WS_WIN + 4ull * 5632 * 1024 * 2;
constexpr size_t WS_WABIN = WS_WOUT + 4ull * 1024 * 2816 * 2;
constexpr size_t WS_WABOUT = WS_WABIN + 2560ull * 1024 * 2;
constexpr size_t WS_WQKV = WS_WABOUT + 1024ull * 1024 * 2;
constexpr size_t WS_WATTO = WS_WQKV + 1536ull * 1024 * 2;
constexpr size_t WS_MOD = WS_WATTO + 1024ull * 1024 * 2;
constexpr size_t WS_BAR = WS_MOD + 221184;
constexpr size_t WS_H = WS_MOD + 262144;
constexpr size_t WS_ACT = WS_H + (size_t)T * 1024 * 2;
constexpr size_t WS_KT = WS_ACT + (size_t)T * DFF * 2;
constexpr size_t WS_END = WS_KT + 2ull * 512 * 2 * L * 2;
constexpr size_t PBT_BYTES = 3ull * 1536 * L * 2;
constexpr size_t FFTSCR_PER_BLOCK = 2ull * L * 8 + 3ull * L * 4;

__device__ __forceinline__ unsigned pk_bf16(float a, float b) { f32x2v f = {a, b}; bf16x2v r = __builtin_convertvector(f, bf16x2v); return __builtin_bit_cast(unsigned, r); }
__device__ __forceinline__ float bf_lo(unsigned v) { return __uint_as_float(v << 16); }
__device__ __forceinline__ float bf_hi(unsigned v) { return __uint_as_float(v & 0xffff0000u); }
__device__ __forceinline__ float bf2f(bf16_t v) { return __uint_as_float((unsigned)v << 16); }
__device__ __forceinline__ bf16_t f2bf(float f) { return (bf16_t)(pk_bf16(f, 0.f) & 0xffffu); }
__device__ __forceinline__ float fsigmoid(float x) { return __builtin_amdgcn_rcpf(1.0f + __expf(-x)); }
__device__ __forceinline__ float hw_sin(float x) { return __builtin_amdgcn_sinf(x * 0.15915494309189535f); }

__device__ __forceinline__ int opaque_tid() { int t = threadIdx.x; asm volatile("" : "+v"(t)); return t; }

#define XB_TMO      128
#define XB_XCNT(j)  (256  + 64 * (j))
#define XB_XSUB(j)  (1280 + 64 * (j))
#define XB_XGEN(j)  (2304 + 64 * (j))
#define XB_TOP      3328
#define XB_TOPGEN   3392
#define XCD_BAR_WORDS 3456
#define XB_SPIN_CAP (1u << 22)
__device__ __forceinline__ unsigned xb_ld(unsigned* p)              { return __hip_atomic_load(p, __ATOMIC_RELAXED, __HIP_MEMORY_SCOPE_AGENT); }
__device__ __forceinline__ unsigned xb_add(unsigned* p, unsigned v) { return __hip_atomic_fetch_add(p, v, __ATOMIC_RELAXED, __HIP_MEMORY_SCOPE_AGENT); }
__device__ __forceinline__ unsigned xb_xcc_id() { return (unsigned)__builtin_amdgcn_s_getreg((3 << 11) | 20) & 0xFu; }
#define XB_SPIN(cond, bar) do { unsigned _sp = 0; while (cond) { __builtin_amdgcn_s_sleep(1); \
    if ((++_sp & 255u) == 0u) { if (xb_ld(&(bar)[XB_TMO])) break; if (_sp > XB_SPIN_CAP) { atomicAdd(&(bar)[XB_TMO], 1u); break; } } } } while (0)
struct XcdBarrier { unsigned* bar; unsigned x; volatile LAS unsigned* st; };
__device__ __forceinline__ XcdBarrier xcd_barrier_post(unsigned* bar, volatile LAS unsigned* st) {
    XcdBarrier b; b.bar = bar; b.x = xb_xcc_id(); b.st = st;
    if (threadIdx.x == 0) (void)xb_add(&bar[XB_XCNT(b.x)], 1u);
    return b;
}
__device__ __forceinline__ void xcd_barrier_complete(unsigned* bar, unsigned x, unsigned& nloc, unsigned& nx) {
    const unsigned G = gridDim.x * gridDim.y * gridDim.z;
    unsigned sum, cnt, mine, sp = 0u;
    for (;;) {
        sum = 0u; cnt = 0u; mine = 0u;
#pragma unroll
        for (unsigned j = 0; j < 16; ++j) { const unsigned c = xb_ld(&bar[XB_XCNT(j)]); sum += c; cnt += (c > 0u) ? 1u : 0u; mine = (j == x) ? c : mine; }
        if (sum == G) break;
        __builtin_amdgcn_s_sleep(1);
        if ((++sp & 255u) == 0u) { if (xb_ld(&bar[XB_TMO])) break; if (sp > XB_SPIN_CAP) { atomicAdd(&bar[XB_TMO], 1u); break; } }
    }
    nloc = mine > 0u ? mine : 1u; nx = cnt > 0u ? cnt : 1u;
}
__device__ __forceinline__ void xcd_barrier(const XcdBarrier& b) {
    asm volatile("s_waitcnt vmcnt(0)" ::: "memory");
    __syncthreads();
    if (threadIdx.x == 0) {
        unsigned* bar = b.bar;
        __builtin_amdgcn_s_waitcnt(0);
        unsigned nloc = b.st[0], nx = b.st[1];
        if (nloc == 0u) { xcd_barrier_complete(bar, b.x, nloc, nx); b.st[0] = nloc; b.st[1] = nx; }
        const unsigned old = xb_add(&bar[XB_XSUB(b.x)], 1u);
        const unsigned gen = old / nloc;
        if (old + 1u == (gen + 1u) * nloc) {
            __builtin_amdgcn_fence(__ATOMIC_RELEASE, "agent");
            asm volatile("s_waitcnt vmcnt(0)" ::: "memory");
            const unsigned og = xb_add(&bar[XB_TOP], 1u);
            const unsigned tg = og / nx;
            if (og + 1u == (tg + 1u) * nx) xb_add(&bar[XB_TOPGEN], 1u);
            else XB_SPIN(xb_ld(&bar[XB_TOPGEN]) == tg, bar);
            __builtin_amdgcn_fence(__ATOMIC_ACQUIRE, "agent");
            xb_add(&bar[XB_XGEN(b.x)], 1u);
            asm volatile("s_waitcnt vmcnt(0)" ::: "memory");
        } else {
            XB_SPIN(xb_ld(&bar[XB_XGEN(b.x)]) == gen, bar);
            __builtin_amdgcn_fence(__ATOMIC_ACQUIRE, "agent");
            asm volatile("s_waitcnt vmcnt(0)" ::: "memory");
        }
    }
    __syncthreads();
}

struct Args { const float* in[28]; float* out; unsigned char* ws; int ph_lo, ph_hi; };

namespace pg8 {
constexpr int BM = 256, BK = 64, HALF = 128, HTB = HALF * BK * 2, STAGE_BYTES = 8 * HTB, NXCD = 8, WGM = 8;
__device__ __forceinline__ int lds_byte(int r, int c) { const int st = (r >> 4) * 2 + (c >> 5), rr = r & 15, cc = c & 31, ob = rr * 64 + cc * 2; return st * 1024 + (ob ^ (((ob >> 9) & 1) << 5)); }
__device__ __forceinline__ void stage_rc(int b, int& R, int& C) { const int st = b / 1024, sb = b % 1024, swz = sb ^ (((sb >> 9) & 1) << 5); R = (st >> 1) * 16 + swz / 64; C = (st & 1) * 32 + (swz % 64) / 2; }
__device__ __forceinline__ int perm32(int rho) { const int n = rho >> 4, i = rho & 15; return 8 * (i >> 2) + 4 * n + (i & 3); }
struct Unit { int pm, pn; };
struct Gemm { const bf16_t* A; const bf16_t* Bt; int M, N, K; };
struct StaticOrder {
    int nM, nN, nwg, G, c;
    __device__ void init(int M, int N, int G_, int c_) { nM = M / BM; nN = N / BM; nwg = nM * nN; G = G_; c = c_; }
    __device__ bool next(int i, Unit& u) const {
        const long Lx = (long)i * G + c; if (Lx >= nwg) return false;
        int wgid = (int)Lx; { const int q = nwg / NXCD, r = nwg % NXCD, xcd = wgid % NXCD, off = wgid / NXCD; wgid = (xcd < r ? xcd * (q + 1) : r * (q + 1) + (xcd - r) * q) + off; }
        const int nig = WGM * nN, gid = wgid / nig, fm = gid * WGM, gsz = (nM - fm) < WGM ? (nM - fm) : WGM;
        u.pm = fm + ((wgid % nig) % gsz); u.pn = (wgid % nig) / gsz; return true;
    }
};

template <class Epi>
__device__ __forceinline__ void gemm_phase(LAS unsigned char* lds, const Gemm g, const StaticOrder& S, const Epi& E) {
    const int tid = opaque_tid(), wid = __builtin_amdgcn_readfirstlane(tid >> 6), lane = tid & 63, wr = wid >> 2, wc = wid & 3, fr = lane & 15, fq = lane >> 4;
    const int K = g.K, nt = K / BK;
    unsigned voffA[2], voffB[2];
#pragma unroll
    for (int i = 0; i < 2; ++i) { int R, C; stage_rc(tid * 16 + i * 8192, R, C); const int Rb = Epi::PERM ? ((R & ~31) + perm32(R & 31)) : R;
        voffA[i] = (unsigned)(R * K + C) * 2u; voffB[i] = (unsigned)(Rb * K + C) * 2u; }
    const size_t kstep = (size_t)(BK * 2);
    const size_t hstep = (size_t)HALF * K * 2;
    const size_t tstep = 2 * hstep;
    const unsigned ldsw = (unsigned)wid * 1024u;
    const int aoff = lds_byte(wr * 64 + fr, fq * 8), boff = lds_byte(wc * 32 + fr, fq * 8);
#define PG8_SA(b, h) (((b) * 2 + (h)) * HTB)
#define PG8_SB(b, h) ((4 + (b) * 2 + (h)) * HTB)
#define PG8_STAGE(bufoff, gbase, voff) do { _Pragma("unroll") for (int _i = 0; _i < 2; ++_i) \
        __builtin_amdgcn_global_load_lds((const unsigned*)((const char*)(gbase) + (voff)[_i]), (LAS unsigned*)(lds + (bufoff) + ldsw + _i * 8192), 16, 0, 0); } while (0)
#define PG8_LDA(dst, b, h) do { _Pragma("unroll") for (int m = 0; m < 4; ++m) _Pragma("unroll") for (int k = 0; k < 2; ++k) dst[m][k] = *(const LAS bf16x8*)(lds + PG8_SA(b, h) + aoff + m * 2048 + k * 1024); } while (0)
#define PG8_LDB(dst, b, h) do { _Pragma("unroll") for (int n = 0; n < 2; ++n) _Pragma("unroll") for (int k = 0; k < 2; ++k) dst[n][k] = *(const LAS bf16x8*)(lds + PG8_SB(b, h) + boff + n * 2048 + k * 1024); } while (0)
#define PG8_MMA(ai, bj, At, Bt) do { __builtin_amdgcn_s_setprio(1); _Pragma("unroll") for (int m = 0; m < 4; ++m) _Pragma("unroll") for (int n = 0; n < 2; ++n) _Pragma("unroll") for (int k = 0; k < 2; ++k) \
        acc[ai][bj][m][n] = __builtin_amdgcn_mfma_f32_16x16x32_bf16(Bt[n][k], At[m][k], acc[ai][bj][m][n], 0, 0, 0); __builtin_amdgcn_s_setprio(0); } while (0)
#define PG8_WAIT_V(n) asm volatile("s_waitcnt vmcnt(" #n ")" ::: "memory")
#define PG8_WAIT_L(n) asm volatile("s_waitcnt lgkmcnt(" #n ")" ::: "memory")
#define PG8_BAR __builtin_amdgcn_s_barrier()
#define PG8_SCHED __builtin_amdgcn_sched_barrier(0)
    Unit cur, nxt; int ui = 0;
    if (!S.next(0, cur)) return;
    f32x4 acc[2][2][4][2];
#pragma unroll
    for (int a = 0; a < 2; ++a)
#pragma unroll
        for (int b = 0; b < 2; ++b)
#pragma unroll
            for (int m = 0; m < 4; ++m)
#pragma unroll
                for (int n = 0; n < 2; ++n) acc[a][b][m][n] = (f32x4){0.f, 0.f, 0.f, 0.f};
    bf16x8 At[4][2], B0[2][2], B1[2][2];
    const char* cA = (const char*)g.A + (size_t)cur.pm * tstep; const char* cB = (const char*)g.Bt + (size_t)cur.pn * tstep;
    PG8_STAGE(PG8_SB(0, 0), cB, voffB); PG8_STAGE(PG8_SA(0, 0), cA, voffA); PG8_STAGE(PG8_SB(0, 1), cB + hstep, voffB); PG8_STAGE(PG8_SA(0, 1), cA + hstep, voffA);
    if (wr == 1) PG8_BAR;
    PG8_WAIT_V(4); PG8_BAR;
    PG8_STAGE(PG8_SB(1, 0), cB + kstep, voffB); PG8_STAGE(PG8_SA(1, 0), cA + kstep, voffA); PG8_STAGE(PG8_SB(1, 1), cB + hstep + kstep, voffB);
    PG8_WAIT_V(6); PG8_BAR;
    for (;;) {
        const bool has_next = S.next(ui + 1, nxt);
        const char* nA = has_next ? (const char*)g.A + (size_t)nxt.pm * tstep : cA; const char* nB = has_next ? (const char*)g.Bt + (size_t)nxt.pn * tstep : cB;
        for (int t = 0; t < nt; t += 2) {
            const bool last = (t == nt - 2);
            const char* a1 = cA + (size_t)(t + 1) * kstep;
            const char* a2 = last ? nA : cA + (size_t)(t + 2) * kstep; const char* b2 = last ? nB : cB + (size_t)(t + 2) * kstep;
            const char* a3 = a2 + kstep; const char* b3 = b2 + kstep;
            PG8_LDB(B0, 0, 0); PG8_SCHED; PG8_LDA(At, 0, 0); PG8_STAGE(PG8_SA(1, 1), a1 + hstep, voffA);
            PG8_WAIT_L(8); PG8_BAR; PG8_WAIT_L(0); PG8_MMA(0, 0, At, B0); PG8_BAR; PG8_SCHED;
            PG8_LDB(B1, 0, 1); PG8_STAGE(PG8_SB(0, 0), b2, voffB);
            PG8_BAR; PG8_WAIT_L(0); PG8_MMA(0, 1, At, B1); PG8_BAR;
            PG8_LDA(At, 0, 1); PG8_STAGE(PG8_SA(0, 0), a2, voffA);
            PG8_BAR; PG8_WAIT_L(0); PG8_MMA(1, 0, At, B0); PG8_BAR; PG8_SCHED;
            PG8_STAGE(PG8_SB(0, 1), b2 + hstep, voffB);
            PG8_WAIT_V(6); PG8_BAR; PG8_MMA(1, 1, At, B1); PG8_BAR;
            PG8_LDB(B0, 1, 0); PG8_SCHED; PG8_LDA(At, 1, 0); PG8_STAGE(PG8_SA(0, 1), a2 + hstep, voffA);
            PG8_WAIT_L(8); PG8_BAR; PG8_WAIT_L(0); PG8_MMA(0, 0, At, B0); PG8_BAR; PG8_SCHED;
            PG8_LDB(B1, 1, 1); PG8_STAGE(PG8_SB(1, 0), b3, voffB);
            PG8_BAR; PG8_WAIT_L(0); PG8_MMA(0, 1, At, B1); PG8_BAR;
            PG8_LDA(At, 1, 1); PG8_STAGE(PG8_SA(1, 0), a3, voffA);
            PG8_BAR; PG8_WAIT_L(0); PG8_MMA(1, 0, At, B0); PG8_BAR; PG8_SCHED;
            PG8_STAGE(PG8_SB(1, 1), b3 + hstep, voffB);
            PG8_WAIT_V(6); PG8_BAR; PG8_MMA(1, 1, At, B1); PG8_BAR;
        }
        E(acc, cur, wr, wc, fr, fq);
        if (!has_next) break;
#pragma unroll
        for (int a = 0; a < 2; ++a)
#pragma unroll
            for (int b = 0; b < 2; ++b)
#pragma unroll
                for (int m = 0; m < 4; ++m)
#pragma unroll
                    for (int n = 0; n < 2; ++n) acc[a][b][m][n] = (f32x4){0.f, 0.f, 0.f, 0.f};
        cur = nxt; cA = nA; cB = nB; ++ui;
    }
    PG8_WAIT_V(0);
    if (wr == 0) PG8_BAR;
    PG8_BAR;
#undef PG8_SA
#undef PG8_SB
#undef PG8_STAGE
#undef PG8_LDA
#undef PG8_LDB
#undef PG8_MMA
#undef PG8_WAIT_V
#undef PG8_WAIT_L
#undef PG8_BAR
#undef PG8_SCHED
}
}

struct EpiSwiglu {
    static constexpr bool PERM = true;
    bf16_t* O;
    __device__ __forceinline__ void operator()(const f32x4 (&acc)[2][2][4][2], const pg8::Unit& u, int wr, int wc, int fr, int fq) const {
        const int row0 = u.pm * 256 + wr * 64 + fr, col0 = u.pn * 128 + wc * 32 + 8 * fq;
#pragma unroll
        for (int ai = 0; ai < 2; ++ai)
#pragma unroll
            for (int m = 0; m < 4; ++m) {
                bf16_t* rowp = O + (size_t)(row0 + ai * 128 + m * 16) * DFF + col0;
                float v[8];
#pragma unroll
                for (int n = 0; n < 2; ++n)
#pragma unroll
                    for (int j = 0; j < 4; ++j) { const float gg = acc[ai][0][m][n][j], uu = acc[ai][1][m][n][j]; v[n * 4 + j] = gg * fsigmoid(gg) * uu; }
                u32x4 w; w.x = pk_bf16(v[0], v[1]); w.y = pk_bf16(v[2], v[3]); w.z = pk_bf16(v[4], v[5]); w.w = pk_bf16(v[6], v[7]);
                *(u32x4*)rowp = w;
            }
    }
};
struct EpiBf16 {
    static constexpr bool PERM = true;
    bf16_t* O; int ldc;
    __device__ __forceinline__ void operator()(const f32x4 (&acc)[2][2][4][2], const pg8::Unit& u, int wr, int wc, int fr, int fq) const {
        const int row0 = u.pm * 256 + wr * 64 + fr, col0 = u.pn * 256 + wc * 32 + 8 * fq;
#pragma unroll
        for (int ai = 0; ai < 2; ++ai)
#pragma unroll
            for (int m = 0; m < 4; ++m) {
                bf16_t* rowp = O + (size_t)(row0 + ai * 128 + m * 16) * ldc + col0;
#pragma unroll
                for (int bj = 0; bj < 2; ++bj) {
                    const f32x4 v0 = acc[ai][bj][m][0], v1 = acc[ai][bj][m][1];
                    u32x4 w; w.x = pk_bf16(v0[0], v0[1]); w.y = pk_bf16(v0[2], v0[3]); w.z = pk_bf16(v1[0], v1[1]); w.w = pk_bf16(v1[2], v1[3]);
                    *(u32x4*)(rowp + bj * 128) = w;
                }
            }
    }
};
struct EpiProj {
    static constexpr bool PERM = true;
    bf16_t* Oa; bf16_t* ObT;
    __device__ __forceinline__ void operator()(const f32x4 (&acc)[2][2][4][2], const pg8::Unit& u, int wr, int wc, int fr, int fq) const {
        const int row0 = u.pm * 256 + wr * 64 + fr;
        if (u.pn < 4) {
            const int col0 = u.pn * 256 + wc * 32 + 8 * fq;
#pragma unroll
            for (int ai = 0; ai < 2; ++ai)
#pragma unroll
                for (int m = 0; m < 4; ++m) {
                    bf16_t* rowp = Oa + (size_t)(row0 + ai * 128 + m * 16) * 1024 + col0;
#pragma unroll
                    for (int bj = 0; bj < 2; ++bj) {
                        const f32x4 v0 = acc[ai][bj][m][0], v1 = acc[ai][bj][m][1];
                        u32x4 w; w.x = pk_bf16(v0[0], v0[1]); w.y = pk_bf16(v0[2], v0[3]); w.z = pk_bf16(v1[0], v1[1]); w.w = pk_bf16(v1[2], v1[3]);
                        *(u32x4*)(rowp + bj * 128) = w;
                    }
                }
        } else {
            const int seq = (u.pm * 256) >> 14;
            const int c0 = (u.pn - 4) * 256 + wc * 32 + 8 * fq;
#pragma unroll
            for (int ai = 0; ai < 2; ++ai)
#pragma unroll
                for (int m = 0; m < 4; ++m) {
                    const int nn = (row0 + ai * 128 + m * 16) & (L - 1);
#pragma unroll
                    for (int bj = 0; bj < 2; ++bj)
#pragma unroll
                        for (int n = 0; n < 2; ++n)
#pragma unroll
                            for (int j = 0; j < 4; ++j)
                                ObT[((size_t)(seq * 1536 + c0 + bj * 128 + 4 * n + j) << 14) + nn] = f2bf(acc[ai][bj][m][n][j]);
                }
        }
    }
};
template <bool SRC_F32> struct EpiResid {
    static constexpr bool PERM = true;
    const float* xs0; const float* xs1; const bf16_t* xbs; bf16_t* xbo; const float* gate; float scale;
    __device__ __forceinline__ void operator()(const f32x4 (&acc)[2][2][4][2], const pg8::Unit& u, int wr, int wc, int fr, int fq) const {
        const int row0 = u.pm * 256 + wr * 64 + fr, col0 = u.pn * 256 + wc * 32 + 8 * fq;
        const int seq = (u.pm * 256) >> 14;
        const float* gb = gate + seq * 9216 + col0;
        const float* sf = (seq < 2 ? xs0 + (size_t)row0 * 1024 : xs1 + (size_t)(row0 - 32768) * 1024) + col0;
        const size_t ob = (size_t)row0 * 1024 + col0;
#pragma unroll
        for (int bj = 0; bj < 2; ++bj) {
            const f32x4 g0 = *(const f32x4*)(gb + bj * 128) * scale, g1 = *(const f32x4*)(gb + bj * 128 + 4) * scale;
            f32x4 x0[2][4], x1[2][4]; u32x4 q[2][4];
#pragma unroll
            for (int ai = 0; ai < 2; ++ai)
#pragma unroll
                for (int m = 0; m < 4; ++m) {
                    const size_t off = (size_t)(ai * 128 + m * 16) * 1024 + bj * 128;
                    if (SRC_F32) { x0[ai][m] = *(const f32x4*)(sf + off); x1[ai][m] = *(const f32x4*)(sf + off + 4); }
                    else q[ai][m] = *(const u32x4*)(xbs + ob + off);
                }
#pragma unroll
            for (int ai = 0; ai < 2; ++ai)
#pragma unroll
                for (int m = 0; m < 4; ++m) {
                    const size_t off = (size_t)(ai * 128 + m * 16) * 1024 + bj * 128;
                    f32x4 a0, a1;
                    if (SRC_F32) { a0 = x0[ai][m]; a1 = x1[ai][m]; }
                    else { const u32x4 t = q[ai][m]; a0 = (f32x4){bf_lo(t.x), bf_hi(t.x), bf_lo(t.y), bf_hi(t.y)}; a1 = (f32x4){bf_lo(t.z), bf_hi(t.z), bf_lo(t.w), bf_hi(t.w)}; }
                    const f32x4 y0 = a0 + g0 * acc[ai][bj][m][0], y1 = a1 + g1 * acc[ai][bj][m][1];
                    u32x4 w; w.x = pk_bf16(y0[0], y0[1]); w.y = pk_bf16(y0[2], y0[3]); w.z = pk_bf16(y1[0], y1[1]); w.w = pk_bf16(y1[2], y1[3]);
                    *(u32x4*)(xbo + ob + off) = w;
                }
        }
    }
};

struct WTile { const float* src; bf16_t* dst; int K, N, k0, np0, n0; };
__device__ __forceinline__ WTile wtile_desc(const Args& a, int ti) {
    unsigned char* ws = a.ws;
    WTile t; int mode = 0, lt;
    if (ti < 5632) { const int mi = ti / 1408; lt = ti % 1408; t.src = a.in[7] + (size_t)mi * 1024 * 5632; t.dst = (bf16_t*)(ws + WS_WIN) + (size_t)mi * 5632 * 1024; t.K = 1024; t.N = 5632; mode = 1; }
    else if (ti < 8448) { const int mi = (ti - 5632) / 704; lt = (ti - 5632) % 704; t.src = a.in[8] + (size_t)mi * 2816 * 1024; t.dst = (bf16_t*)(ws + WS_WOUT) + (size_t)mi * 1024 * 2816; t.K = 2816; t.N = 1024; }
    else if (ti < 9088) { lt = ti - 8448; t.src = a.in[10]; t.dst = (bf16_t*)(ws + WS_WABIN); t.K = 1024; t.N = 2560; }
    else if (ti < 9344) { lt = ti - 9088; t.src = a.in[24]; t.dst = (bf16_t*)(ws + WS_WABOUT); t.K = 1024; t.N = 1024; }
    else if (ti < 9728) { lt = ti - 9344; t.src = a.in[25]; t.dst = (bf16_t*)(ws + WS_WQKV); t.K = 1024; t.N = 1536; }
    else { lt = ti - 9728; t.src = a.in[27]; t.dst = (bf16_t*)(ws + WS_WATTO); t.K = 1024; t.N = 1024; }
    const int nkt = t.K / 64;
    const int kt = lt % nkt, ntp = lt / nkt;
    t.k0 = kt * 64; t.np0 = ntp * 64; t.n0 = t.np0;
    if (mode == 1) { const int pn = t.np0 >> 8, bj = (t.np0 >> 7) & 1, c0 = t.np0 & 127; t.n0 = bj * DFF + 128 * pn + c0; }
    return t;
}
__device__ void convert_span(const Args& a, LAS float* tile, int lo, int hi, int bi, int nb) {
    const int tid = opaque_tid();
    for (int base = lo + bi; base < hi; base += 4 * nb) {
        __syncthreads();
        float v[4][8];
#pragma unroll
        for (int q = 0; q < 4; ++q) {
            const int ti = base + q * nb;
            if (ti < hi) { const WTile t = wtile_desc(a, ti);
#pragma unroll
                for (int i = 0; i < 8; ++i) { const int k = (tid >> 6) + 8 * i, n = tid & 63; v[q][i] = t.src[(size_t)(t.k0 + k) * t.N + t.n0 + n]; } }
        }
#pragma unroll
        for (int q = 0; q < 4; ++q)
#pragma unroll
            for (int i = 0; i < 8; ++i) { const int k = (tid >> 6) + 8 * i, n = tid & 63; tile[q * 4160 + k * 65 + n] = v[q][i]; }
        __syncthreads();
#pragma unroll
        for (int q = 0; q < 4; ++q) {
            const int ti = base + q * nb;
            if (ti < hi) { const WTile t = wtile_desc(a, ti);
                const int nn = tid >> 3, kk = (tid & 7) * 8;
                float x[8];
#pragma unroll
                for (int j = 0; j < 8; ++j) x[j] = tile[q * 4160 + (kk + j) * 65 + nn];
                u32x4 w; w.x = pk_bf16(x[0], x[1]); w.y = pk_bf16(x[2], x[3]); w.z = pk_bf16(x[4], x[5]); w.w = pk_bf16(x[6], x[7]);
                *(u32x4*)(t.dst + (size_t)(t.np0 + nn) * t.K + t.k0 + kk) = w; }
        }
    }
    __syncthreads();
}
__device__ void convert_weights(const Args& a, LAS float* tile) {
    const int G = gridDim.x, bx = blockIdx.x;
#pragma unroll 1
    for (int r = 0; r < 3; ++r) { const int lo = r == 0 ? 0 : r == 1 ? 5632 : 8448, hi = r == 0 ? 2816 : r == 1 ? 7040 : 9344; convert_span(a, tile, lo, hi, bx, G); }
}
__device__ void convert_tail(const Args& a, LAS float* tile, int which, int nwg) {
    const int G = gridDim.x, bx = blockIdx.x, rem = nwg % G;
    int bi = bx, nb = G;
    if (rem != 0) { if (bx < rem) return; bi = bx - rem; nb = G - rem; }
#pragma unroll 1
    for (int r = 0; r < 2; ++r) {
        int lo, hi;
        if (which == 0) { lo = r == 0 ? 2816 : 0; hi = r == 0 ? 4736 : 0; }
        else if (which == 1) { lo = r == 0 ? 4736 : 7040; hi = r == 0 ? 5632 : 8064; }
        else { lo = r == 0 ? 8064 : 9344; hi = r == 0 ? 8448 : 9984; }
        convert_span(a, tile, lo, hi, bi, nb);
    }
}

__device__ void ada_phase(const Args& a, LAS float* lf) {
    const int tid = opaque_tid(), lane = tid & 63, w = tid >> 6;
    LAS float* cs = lf; LAS float* red = lf + 3072;
    float* mod = (float*)(a.ws + WS_MOD);
    __syncthreads();
    for (int i = tid; i < 3072; i += 512) { const int s = i >> 10, k = i & 1023; const float c = s < 2 ? a.in[2][s * 1024 + k] : a.in[3][k]; cs[i] = c * fsigmoid(c); }
    __syncthreads();
    for (int item = blockIdx.x; item < 1152; item += gridDim.x) {
        const int layer = item / 576, cgp = item % 576, cl = lane & 15, ks = lane >> 4, col = cgp * 16 + cl;
        const float* W = a.in[4] + (size_t)layer * 1024 * 9216 + col;
        const int kb = (w * 4 + ks) * 32;
        float a0 = 0.f, a1 = 0.f, a2 = 0.f;
#pragma unroll 16
        for (int k = kb; k < kb + 32; ++k) { const float wv = W[(size_t)k * 9216]; a0 += cs[k] * wv; a1 += cs[1024 + k] * wv; a2 += cs[2048 + k] * wv; }
        a0 += __shfl_xor(a0, 16); a0 += __shfl_xor(a0, 32); a1 += __shfl_xor(a1, 16); a1 += __shfl_xor(a1, 32); a2 += __shfl_xor(a2, 16); a2 += __shfl_xor(a2, 32);
        if (lane < 16) { red[(w * 3 + 0) * 16 + cl] = a0; red[(w * 3 + 1) * 16 + cl] = a1; red[(w * 3 + 2) * 16 + cl] = a2; }
        __syncthreads();
        if (tid < 48) { const int s = tid >> 4, c = tid & 15; float sum = 0.f;
#pragma unroll
            for (int ww = 0; ww < 8; ++ww) sum += red[(ww * 3 + s) * 16 + c];
            mod[(size_t)(layer * 3 + s) * 9216 + cgp * 16 + c] = sum + a.in[5][layer * 9216 + cgp * 16 + c]; }
        __syncthreads();
    }
}

__device__ void filter_phase(const Args& a, LAS float* lf) {
    const int tid = opaque_tid();
    LAS float* feats = lf;
    LAS float* h1 = lf + 64 * 33;
    LAS float* h2T = h1 + 64 * 65;
    const float* w1 = a.in[17]; const float* b1 = a.in[18]; const float* w2 = a.in[19]; const float* b2 = a.in[20]; const float* w3 = a.in[21]; const float* fr = a.in[22];
    half_t* KT = (half_t*)(a.ws + WS_KT);
    for (int item = blockIdx.x; item < 256; item += gridDim.x) {
        const int p0 = item * 64;
        __syncthreads();
        for (int idx = tid; idx < 64 * 33; idx += 512) {
            const int pos = idx / 33, f = idx % 33, n = p0 + pos; float v;
            if (f == 0) v = (float)n / (float)(L - 1);
            else { const int b = (f - 1) & 15; const double band = 1e-4 + (double)b * ((15.0 - 1e-4) / 15.0); double rev = (double)n * band / (double)L; rev -= floor(rev);
                   v = (f <= 16) ? __builtin_amdgcn_cosf((float)rev) : -__builtin_amdgcn_sinf((float)rev); }
            feats[idx] = v;
        }
        __syncthreads();
        { const int pos = tid >> 3, j0 = (tid & 7) * 8; float acc[8];
#pragma unroll
          for (int j = 0; j < 8; ++j) acc[j] = b1[j0 + j];
#pragma unroll 3
          for (int f = 0; f < 33; ++f) { const float x = feats[pos * 33 + f];
#pragma unroll
              for (int j = 0; j < 8; ++j) acc[j] += x * w1[f * 64 + j0 + j]; }
#pragma unroll
          for (int j = 0; j < 8; ++j) h1[pos * 65 + j0 + j] = hw_sin(fr[j0 + j] * acc[j]); }
        __syncthreads();
        { const int pos = tid >> 3, j0 = (tid & 7) * 8; float acc[8];
#pragma unroll
          for (int j = 0; j < 8; ++j) acc[j] = b2[j0 + j];
#pragma unroll 4
          for (int i = 0; i < 64; ++i) { const float x = h1[pos * 65 + i];
#pragma unroll
              for (int j = 0; j < 8; ++j) acc[j] += x * w2[i * 64 + j0 + j]; }
#pragma unroll
          for (int j = 0; j < 8; ++j) h2T[(j0 + j) * 64 + pos] = hw_sin(fr[j0 + j] * acc[j]); }
        __syncthreads();
        const int col0 = tid * 4;
        const int dir = col0 >> 10, ord = (col0 >> 9) & 1, ch0 = col0 & 511;
#pragma unroll 1
        for (int chunk = 0; chunk < 4; ++chunk) {
            float acc[16][4];
#pragma unroll
            for (int p = 0; p < 16; ++p)
#pragma unroll
                for (int c = 0; c < 4; ++c) acc[p][c] = 0.f;
#pragma unroll 2
            for (int j = 0; j < 64; ++j) {
                const f32x4 wv = *(const f32x4*)(w3 + j * 2048 + col0);
                f32x4 hv[4];
#pragma unroll
                for (int q = 0; q < 4; ++q) hv[q] = *(const LAS f32x4*)(h2T + j * 64 + chunk * 16 + q * 4);
#pragma unroll
                for (int p = 0; p < 16; ++p)
#pragma unroll
                    for (int c = 0; c < 4; ++c) acc[p][c] += hv[p >> 2][p & 3] * wv[c];
            }
#pragma unroll
            for (int c = 0; c < 4; ++c) {
                const int ch = ch0 + c;
                const float delta = 3.0701134573253945f + (float)ch * (12.280453829301578f / 511.0f);
                half_t* dstp = KT + ((size_t)((ord * 512 + ch) * 2 + dir) << 14) + p0 + chunk * 16;
                unsigned pk[8];
#pragma unroll
                for (int p = 0; p < 16; p += 2) {
                    const float t0 = (float)(p0 + chunk * 16 + p) / (float)(L - 1), t1 = (float)(p0 + chunk * 16 + p + 1) / (float)(L - 1);
                    const half_t x0 = (half_t)(acc[p][c] * __expf(-t0 * delta)), x1 = (half_t)(acc[p + 1][c] * __expf(-t1 * delta));
                    pk[p >> 1] = (unsigned)__builtin_bit_cast(unsigned short, x0) | ((unsigned)__builtin_bit_cast(unsigned short, x1) << 16);
                }
                *(u32x4*)dstp = (u32x4){pk[0], pk[1], pk[2], pk[3]};
                *(u32x4*)(dstp + 8) = (u32x4){pk[4], pk[5], pk[6], pk[7]};
            }
        }
    }
    __syncthreads();
}

template <bool SRC_F32> __device__ void norm_phase(const float* xs0, const float* xs1, const bf16_t* xb, const float* g, const float* sh, const float* sc, bf16_t* h) {
    constexpr int NR = SRC_F32 ? 2 : 4;
    const int tid_ = opaque_tid(); const int lane = tid_ & 63, w = tid_ >> 6;
    f32x4 gg[2][2];
#pragma unroll
    for (int i = 0; i < 2; ++i) { gg[i][0] = *(const f32x4*)(g + i * 512 + lane * 8); gg[i][1] = *(const f32x4*)(g + i * 512 + lane * 8 + 4); }
    for (int rb = (blockIdx.x * 8 + w) * NR; rb < T; rb += gridDim.x * 8 * NR) {
        const int seq = rb >> 14;
        f32x4 v[NR][2][2]; u32x4 q[NR][2];
#pragma unroll
        for (int r = 0; r < NR; ++r) {
            const int row = rb + r;
            if (SRC_F32) {
                const float* xr = seq < 2 ? xs0 + (size_t)row * 1024 : xs1 + (size_t)(row - 32768) * 1024;
#pragma unroll
                for (int i = 0; i < 2; ++i) { v[r][i][0] = *(const f32x4*)(xr + i * 512 + lane * 8); v[r][i][1] = *(const f32x4*)(xr + i * 512 + lane * 8 + 4); }
            } else {
#pragma unroll
                for (int i = 0; i < 2; ++i) q[r][i] = *(const u32x4*)(xb + (size_t)row * 1024 + i * 512 + lane * 8);
            }
        }
        f32x4 s1[2][2], s0[2][2];
#pragma unroll
        for (int i = 0; i < 2; ++i)
#pragma unroll
            for (int k = 0; k < 2; ++k) { s1[i][k] = *(const f32x4*)(sc + seq * 9216 + i * 512 + lane * 8 + 4 * k) + 1.0f; s0[i][k] = *(const f32x4*)(sh + seq * 9216 + i * 512 + lane * 8 + 4 * k); }
#pragma unroll
        for (int r = 0; r < NR; ++r) {
            const int row = rb + r;
            if (!SRC_F32) {
#pragma unroll
                for (int i = 0; i < 2; ++i) { const u32x4 t = q[r][i]; v[r][i][0] = (f32x4){bf_lo(t.x), bf_hi(t.x), bf_lo(t.y), bf_hi(t.y)}; v[r][i][1] = (f32x4){bf_lo(t.z), bf_hi(t.z), bf_lo(t.w), bf_hi(t.w)}; }
            }
            float ss = 0.f;
#pragma unroll
            for (int i = 0; i < 2; ++i)
#pragma unroll
                for (int k = 0; k < 2; ++k) ss += v[r][i][k][0] * v[r][i][k][0] + v[r][i][k][1] * v[r][i][k][1] + v[r][i][k][2] * v[r][i][k][2] + v[r][i][k][3] * v[r][i][k][3];
#pragma unroll
            for (int o = 32; o > 0; o >>= 1) ss += __shfl_xor(ss, o);
            const float rstd = rsqrtf(ss * (1.0f / 1024.0f) + EPS);
#pragma unroll
            for (int i = 0; i < 2; ++i) {
                const f32x4 y0 = v[r][i][0] * rstd * gg[i][0] * s1[i][0] + s0[i][0], y1 = v[r][i][1] * rstd * gg[i][1] * s1[i][1] + s0[i][1];
                u32x4 o; o.x = pk_bf16(y0[0], y0[1]); o.y = pk_bf16(y0[2], y0[3]); o.z = pk_bf16(y1[0], y1[1]); o.w = pk_bf16(y1[2], y1[3]);
                *(u32x4*)(h + (size_t)row * 1024 + i * 512 + lane * 8) = o;
            }
        }
    }
}
__device__ void final_norm_phase(const bf16_t* xb, float* out, const float* g) {
    constexpr int NR = 4;
    const int tid_ = opaque_tid(); const int lane = tid_ & 63, w = tid_ >> 6;
    f32x4 gg[2][2];
#pragma unroll
    for (int i = 0; i < 2; ++i) { gg[i][0] = *(const f32x4*)(g + i * 512 + lane * 8); gg[i][1] = *(const f32x4*)(g + i * 512 + lane * 8 + 4); }
    for (int rb = (blockIdx.x * 8 + w) * NR; rb < T; rb += gridDim.x * 8 * NR) {
        u32x4 q[NR][2];
#pragma unroll
        for (int r = 0; r < NR; ++r)
#pragma unroll
            for (int i = 0; i < 2; ++i) q[r][i] = *(const u32x4*)(xb + (size_t)(rb + r) * 1024 + i * 512 + lane * 8);
#pragma unroll
        for (int r = 0; r < NR; ++r) {
            f32x4 v[2][2]; float ss = 0.f;
#pragma unroll
            for (int i = 0; i < 2; ++i) { const u32x4 t = q[r][i]; v[i][0] = (f32x4){bf_lo(t.x), bf_hi(t.x), bf_lo(t.y), bf_hi(t.y)}; v[i][1] = (f32x4){bf_lo(t.z), bf_hi(t.z), bf_lo(t.w), bf_hi(t.w)}; }
#pragma unroll
            for (int i = 0; i < 2; ++i)
#pragma unroll
                for (int k = 0; k < 2; ++k) ss += v[i][k][0] * v[i][k][0] + v[i][k][1] * v[i][k][1] + v[i][k][2] * v[i][k][2] + v[i][k][3] * v[i][k][3];
#pragma unroll
            for (int o = 32; o > 0; o >>= 1) ss += __shfl_xor(ss, o);
            const float rstd = rsqrtf(ss * (1.0f / 1024.0f) + EPS);
#pragma unroll
            for (int i = 0; i < 2; ++i)
#pragma unroll
                for (int k = 0; k < 2; ++k) *(f32x4*)(out + (size_t)(rb + r) * 1024 + i * 512 + lane * 8 + 4 * k) = v[i][k] * rstd * gg[i][k];
        }
    }
}

__device__ void conva_phase(const Args& a, const bf16_t* pa, bf16_t* cat, LAS unsigned char* lds) {
    const int tid = opaque_tid(), lane = tid & 63, w = tid >> 6;
    LAS bf16_t* glu = (LAS bf16_t*)lds;
    LAS float* stage = (LAS float*)(lds + 94 * 512 * 2);
    const float* cw = a.in[11]; const float* cb = a.in[12]; const float* lg = a.in[13]; const float* lb = a.in[14];
    float wt[31];
#pragma unroll
    for (int j = 0; j < 31; ++j) wt[j] = cw[j * 512 + tid];
    const float bias = cb[tid];
    float lgv[8], lbv[8];
#pragma unroll
    for (int i = 0; i < 8; ++i) { lgv[i] = lg[lane + 64 * i]; lbv[i] = lb[lane + 64 * i]; }
    for (int tile = blockIdx.x; tile < 768; tile += gridDim.x) {
        const int seq = tile >> 8, t0 = (tile & 255) * 64;
        __syncthreads();
#pragma unroll 1
        for (int ib = 0; ib < 3; ++ib) {
            u32x4 x1[4], x2[4];
#pragma unroll
            for (int k = 0; k < 4; ++k) {
                const int idx = tid + 512 * (4 * ib + k); const int r = idx >> 6, cc = idx & 63, t = t0 - 15 + r;
                x1[k] = (u32x4){0u, 0u, 0u, 0u}; x2[k] = x1[k];
                if (idx < 94 * 64 && t >= 0 && t < L) { const bf16_t* rp = pa + (size_t)(seq * L + t) * 1024 + cc * 8; x1[k] = *(const u32x4*)rp; x2[k] = *(const u32x4*)(rp + 512); }
            }
#pragma unroll
            for (int k = 0; k < 4; ++k) {
                const int idx = tid + 512 * (4 * ib + k); const int r = idx >> 6, cc = idx & 63;
                u32x4 res;
#pragma unroll
                for (int q = 0; q < 4; ++q) res[q] = pk_bf16(bf_lo(x1[k][q]) * fsigmoid(bf_lo(x2[k][q])), bf_hi(x1[k][q]) * fsigmoid(bf_hi(x2[k][q])));
                if (idx < 94 * 64) *(LAS u32x4*)(glu + r * 512 + cc * 8) = res;
            }
        }
        __syncthreads();
        for (int chunk = 0; chunk < 8; ++chunk) {
            float o[8];
#pragma unroll
            for (int tt = 0; tt < 8; ++tt) o[tt] = bias;
#pragma unroll
            for (int i = 0; i < 38; ++i) {
                const float x = bf2f(glu[(chunk * 8 + i) * 512 + tid]);
#pragma unroll
                for (int tt = 0; tt < 8; ++tt) { const int j = i - tt; if (j >= 0 && j < 31) o[tt] += wt[j] * x; }
            }
#pragma unroll
            for (int tt = 0; tt < 8; ++tt) stage[tt * 512 + tid] = o[tt];
            __syncthreads();
            {
                float v[8]; float s = 0.f;
#pragma unroll
                for (int i = 0; i < 8; ++i) { v[i] = stage[w * 512 + lane + 64 * i]; s += v[i]; }
#pragma unroll
                for (int of = 32; of > 0; of >>= 1) s += __shfl_xor(s, of);
                const float mean = s * (1.0f / 512.0f);
                float q = 0.f;
#pragma unroll
                for (int i = 0; i < 8; ++i) { const float d = v[i] - mean; q += d * d; }
#pragma unroll
                for (int of = 32; of > 0; of >>= 1) q += __shfl_xor(q, of);
                const float rstd = rsqrtf(q * (1.0f / 512.0f) + EPS);
                bf16_t* op = cat + (size_t)(seq * L + t0 + chunk * 8 + w) * 1024;
#pragma unroll
                for (int i = 0; i < 8; ++i) { const float y = (v[i] - mean) * rstd * lgv[i] + lbv[i]; op[lane + 64 * i] = f2bf(y * fsigmoid(y)); }
            }
            __syncthreads();
        }
    }
    __syncthreads();
}

typedef float v2 __attribute__((ext_vector_type(2)));
__device__ __forceinline__ int fphys(int i) { return i + ((i >> 6) << 2); }
struct C2 { v2 r, i; };
__device__ __forceinline__ C2 cmul2(const C2& a, const C2& b) { C2 o; o.r = a.r * b.r - a.i * b.i; o.i = a.r * b.i + a.i * b.r; return o; }
__device__ __forceinline__ C2 cmulc(const C2& a, float cr, float ci) { C2 o; o.r = a.r * cr - a.i * ci; o.i = a.r * ci + a.i * cr; return o; }
template <bool INV> __device__ __forceinline__ void bf4(C2& a, C2& b, C2& c, C2& d) {
    C2 t0, t1, t2, e, t3;
    t0.r = a.r + c.r; t0.i = a.i + c.i; t1.r = a.r - c.r; t1.i = a.i - c.i; t2.r = b.r + d.r; t2.i = b.i + d.i; e.r = b.r - d.r; e.i = b.i - d.i;
    if (INV) { t3.r = -e.i; t3.i = e.r; } else { t3.r = e.i; t3.i = -e.r; }
    a.r = t0.r + t2.r; a.i = t0.i + t2.i; b.r = t1.r + t3.r; b.i = t1.i + t3.i; c.r = t0.r - t2.r; c.i = t0.i - t2.i; d.r = t1.r - t3.r; d.i = t1.i - t3.i;
}
template <bool INV, int K16> __device__ __forceinline__ C2 mulc16(const C2& a) {
    constexpr float cs[10] = {1.0f, 0.92387953251128674f, 0.70710678118654752f, 0.38268343236508977f, 0.0f, -0.38268343236508977f, -0.70710678118654752f, -0.92387953251128674f, -1.0f, -0.92387953251128674f};
    constexpr float sn[10] = {0.0f, 0.38268343236508977f, 0.70710678118654752f, 0.92387953251128674f, 1.0f, 0.92387953251128674f, 0.70710678118654752f, 0.38268343236508977f, 0.0f, -0.38268343236508977f};
    if (K16 == 4) { C2 o; if (INV) { o.r = -a.i; o.i = a.r; } else { o.r = a.i; o.i = -a.r; } return o; }
    return cmulc(a, cs[K16], INV ? sn[K16] : -sn[K16]);
}
template <bool INV, int LOGQ> __device__ __forceinline__ void r16_pass(LAS float* Fre, LAS float* Fim, int tid) {
    constexpr int Q = 1 << LOGQ;
    constexpr int PSTR = (Q >= 64) ? (Q + (Q >> 4)) : Q;
    const int b0 = 2 * tid, pos0 = b0 & (Q - 1), grp = b0 >> LOGQ, base = (grp << (LOGQ + 4)) + pos0;
    const int p = fphys(base);
    C2 x[16];
#pragma unroll
    for (int r = 0; r < 16; ++r) { x[r].r = *(const LAS v2*)(Fre + p + r * PSTR); x[r].i = *(const LAS v2*)(Fim + p + r * PSTR); }
    int posv = pos0; asm volatile("" : "+v"(posv));
    const float rev0 = (float)posv * (1.0f / (float)(16 * Q)), rev1 = (float)(posv + 1) * (1.0f / (float)(16 * Q));
    C2 w1; w1.r = (v2){__builtin_amdgcn_cosf(rev0), __builtin_amdgcn_cosf(rev1)};
    { const v2 sn = (v2){__builtin_amdgcn_sinf(rev0), __builtin_amdgcn_sinf(rev1)}; w1.i = INV ? sn : -sn; }
    const C2 w2 = cmul2(w1, w1), w3 = cmul2(w2, w1), w4 = cmul2(w2, w2), w8 = cmul2(w4, w4), w12 = cmul2(w8, w4);
    if (!INV) {
#pragma unroll
        for (int j = 0; j < 4; ++j) {
            bf4<false>(x[j], x[j + 4], x[j + 8], x[j + 12]);
            x[j + 4] = cmul2(x[j + 4], w1); x[j + 8] = cmul2(x[j + 8], w2); x[j + 12] = cmul2(x[j + 12], w3);
        }
        x[5] = mulc16<false, 1>(x[5]); x[9] = mulc16<false, 2>(x[9]); x[13] = mulc16<false, 3>(x[13]);
        x[6] = mulc16<false, 2>(x[6]); x[10] = mulc16<false, 4>(x[10]); x[14] = mulc16<false, 6>(x[14]);
        x[7] = mulc16<false, 3>(x[7]); x[11] = mulc16<false, 6>(x[11]); x[15] = mulc16<false, 9>(x[15]);
#pragma unroll
        for (int r = 0; r < 4; ++r) {
            bf4<false>(x[4 * r], x[4 * r + 1], x[4 * r + 2], x[4 * r + 3]);
            x[4 * r + 1] = cmul2(x[4 * r + 1], w4); x[4 * r + 2] = cmul2(x[4 * r + 2], w8); x[4 * r + 3] = cmul2(x[4 * r + 3], w12);
        }
    } else {
#pragma unroll
        for (int r = 0; r < 4; ++r) {
            x[4 * r + 1] = cmul2(x[4 * r + 1], w4); x[4 * r + 2] = cmul2(x[4 * r + 2], w8); x[4 * r + 3] = cmul2(x[4 * r + 3], w12);
            bf4<true>(x[4 * r], x[4 * r + 1], x[4 * r + 2], x[4 * r + 3]);
        }
        x[5] = mulc16<true, 1>(x[5]); x[9] = mulc16<true, 2>(x[9]); x[13] = mulc16<true, 3>(x[13]);
        x[6] = mulc16<true, 2>(x[6]); x[10] = mulc16<true, 4>(x[10]); x[14] = mulc16<true, 6>(x[14]);
        x[7] = mulc16<true, 3>(x[7]); x[11] = mulc16<true, 6>(x[11]); x[15] = mulc16<true, 9>(x[15]);
#pragma unroll
        for (int j = 0; j < 4; ++j) {
            x[j + 4] = cmul2(x[j + 4], w1); x[j + 8] = cmul2(x[j + 8], w2); x[j + 12] = cmul2(x[j + 12], w3);
            bf4<true>(x[j], x[j + 4], x[j + 8], x[j + 12]);
        }
    }
#pragma unroll
    for (int r = 0; r < 16; ++r) { *(LAS v2*)(Fre + p + r * PSTR) = x[r].r; *(LAS v2*)(Fim + p + r * PSTR) = x[r].i; }
}
template <bool INV> __device__ __forceinline__ void r4_pass(LAS float* Fre, LAS float* Fim, int tid) {
#pragma unroll 2
    for (int bi = 0; bi < 4; ++bi) {
        const int p = fphys(8 * (tid + 512 * bi));
        const f32x4 ra = *(const LAS f32x4*)(Fre + p), rb = *(const LAS f32x4*)(Fre + p + 4), ia = *(const LAS f32x4*)(Fim + p), ib = *(const LAS f32x4*)(Fim + p + 4);
        C2 x0, x1, x2, x3;
        x0.r = (v2){ra[0], rb[0]}; x1.r = (v2){ra[1], rb[1]}; x2.r = (v2){ra[2], rb[2]}; x3.r = (v2){ra[3], rb[3]};
        x0.i = (v2){ia[0], ib[0]}; x1.i = (v2){ia[1], ib[1]}; x2.i = (v2){ia[2], ib[2]}; x3.i = (v2){ia[3], ib[3]};
        bf4<INV>(x0, x1, x2, x3);
        *(LAS f32x4*)(Fre + p) = (f32x4){x0.r[0], x1.r[0], x2.r[0], x3.r[0]}; *(LAS f32x4*)(Fre + p + 4) = (f32x4){x0.r[1], x1.r[1], x2.r[1], x3.r[1]};
        *(LAS f32x4*)(Fim + p) = (f32x4){x0.i[0], x1.i[0], x2.i[0], x3.i[0]}; *(LAS f32x4*)(Fim + p + 4) = (f32x4){x0.i[1], x1.i[1], x2.i[1], x3.i[1]};
    }
}
__device__ __forceinline__ void fft_fwd(LAS float* Fre, LAS float* Fim, int tid) {
    r16_pass<false, 10>(Fre, Fim, tid); __syncthreads(); r16_pass<false, 6>(Fre, Fim, tid); __syncthreads(); r16_pass<false, 2>(Fre, Fim, tid); __syncthreads(); r4_pass<false>(Fre, Fim, tid);
}
__device__ __forceinline__ void fft_inv(LAS float* Fre, LAS float* Fim, int tid) {
    r4_pass<true>(Fre, Fim, tid); __syncthreads(); r16_pass<true, 2>(Fre, Fim, tid); __syncthreads(); r16_pass<true, 6>(Fre, Fim, tid); __syncthreads(); r16_pass<true, 10>(Fre, Fim, tid);
}
typedef _Float16 h8v __attribute__((ext_vector_type(8)));
__device__ __forceinline__ void sconv8(const bf16_t* row, int n0, float w0, float w1, float w2, float b, float (&out)[8]) {
    const u32x4 q = *(const u32x4*)(row + n0);
    float x[10];
    x[0] = n0 > 0 ? bf2f(row[n0 - 1]) : 0.f;
    x[9] = n0 + 8 < L ? bf2f(row[n0 + 8]) : 0.f;
#pragma unroll
    for (int i = 0; i < 4; ++i) { x[1 + 2 * i] = bf_lo(q[i]); x[2 + 2 * i] = bf_hi(q[i]); }
#pragma unroll
    for (int e = 0; e < 8; ++e) out[e] = b + w0 * x[e] + w1 * x[e + 1] + w2 * x[e + 2];
}
struct Raw8 { u32x4 q; unsigned short lo, hi; };
__device__ __forceinline__ Raw8 raw8_load(const bf16_t* row, int n0) {
    Raw8 r; r.q = *(const u32x4*)(row + n0);
    r.lo = n0 > 0 ? row[n0 - 1] : (unsigned short)0; r.hi = n0 + 8 < L ? row[n0 + 8] : (unsigned short)0;
    return r;
}
__device__ __forceinline__ void sconv8_raw(const Raw8& r, float w0, float w1, float w2, float b, float (&out)[8]) {
    float x[10];
    x[0] = bf2f(r.lo); x[9] = bf2f(r.hi);
#pragma unroll
    for (int i = 0; i < 4; ++i) { x[1 + 2 * i] = bf_lo(r.q[i]); x[2 + 2 * i] = bf_hi(r.q[i]); }
#pragma unroll
    for (int e = 0; e < 8; ++e) out[e] = b + w0 * x[e] + w1 * x[e + 1] + w2 * x[e + 2];
}
template <bool CONJ> __device__ __forceinline__ void tw8(int n0, float (&tr)[8], float (&ti)[8]) {
    const float rev = (float)n0 * (1.0f / (float)(2 * L));
    const float sr = 0.99999998161642933f, si = CONJ ? 1.9174759731070330e-4f : -1.9174759731070330e-4f;
    tr[0] = __builtin_amdgcn_cosf(rev); ti[0] = CONJ ? __builtin_amdgcn_sinf(rev) : -__builtin_amdgcn_sinf(rev);
#pragma unroll
    for (int e = 1; e < 8; ++e) { tr[e] = tr[e - 1] * sr - ti[e - 1] * si; ti[e] = tr[e - 1] * si + ti[e - 1] * sr; }
}
__device__ __forceinline__ void st8(LAS float* p, const float (&v)[8]) { *(LAS f32x4*)p = (f32x4){v[0], v[1], v[2], v[3]}; *(LAS f32x4*)(p + 4) = (f32x4){v[4], v[5], v[6], v[7]}; }
__device__ __forceinline__ void ld8(const LAS float* p, float (&v)[8]) { const f32x4 a = *(const LAS f32x4*)p, b = *(const LAS f32x4*)(p + 4);
#pragma unroll
    for (int e = 0; e < 4; ++e) { v[e] = a[e]; v[4 + e] = b[e]; } }
template <bool DRY> __device__ void fft_phase(const Args& a, bf16_t* pbT, LAS unsigned char* lds) {
    const int tid = opaque_tid(), lane = tid & 63, w = tid >> 6;
    LAS float* Fre = (LAS float*)lds; LAS float* Fim = Fre + 17408;
    LAS float* red = (LAS float*)(lds + 17408 * 8);
    const int po = fphys(8 * tid);
    const half_t* KT = (const half_t*)(a.ws + WS_KT);
    unsigned char* scr = a.ws + WS_ACT + PBT_BYTES + (size_t)blockIdx.x * FFTSCR_PER_BLOCK;
    float* ybuf = (float*)scr;
    float* z1buf = (float*)(scr + 2ull * L * 8);
    const float* sw = a.in[15]; const float* sb = a.in[16]; const float* skip = a.in[23];
    for (int ch = blockIdx.x; ch < 512; ch += gridDim.x) {
        const float vw0 = sw[ch], vw1 = sw[1536 + ch], vw2 = sw[3072 + ch], vb = sb[ch];
#pragma unroll 1
        for (int o = 0; o < 2; ++o) {
            const half_t* kf = KT + ((size_t)((o * 512 + ch) * 2) << 14); const half_t* kb = kf + L;
            const int xc = (o == 0 ? 512 : 1024) + ch;
            const float gw0 = sw[xc], gw1 = sw[1536 + xc], gw2 = sw[3072 + xc], gb = sb[xc];
            const float skp = skip[o * 512 + ch];
            float ss = 0.f;
#pragma unroll 1
            for (int g = 0; g < 4; ++g) {
                const int n0 = 8 * (tid + 512 * g);
                const h8v f = *(const h8v*)(kf + n0), bk = *(const h8v*)(kb + n0);
#pragma unroll
                for (int e = 0; e < 8; ++e) { const float ff = (float)f[e], bb = (n0 + e > 0) ? (float)bk[e] : 0.f; ss += ff * ff + bb * bb; }
            }
#pragma unroll
            for (int of = 32; of > 0; of >>= 1) ss += __shfl_xor(ss, of);
            __syncthreads();
            if (lane == 0) red[w] = ss;
            __syncthreads();
            float tot = 0.f;
#pragma unroll
            for (int ww = 0; ww < 8; ++ww) tot += red[ww];
            const float kscale = rsqrtf(tot + EPS) * (0.5f / (float)L);
#pragma unroll 1
            for (int br = 0; br < 2; ++br) {
                __syncthreads();
#pragma unroll 1
                for (int g = 0; g < 4; ++g) {
                    const int n0 = 8 * (tid + 512 * g);
                    const h8v f = *(const h8v*)(kf + n0), bc = *(const h8v*)(kb + (L - 8 - n0));
                    const float b0 = n0 > 0 ? (float)kb[L - n0] : 0.f;
                    float d[8], vr[8], vi[8];
#pragma unroll
                    for (int e = 0; e < 8; ++e) { const float bk = (e == 0) ? b0 : (float)bc[8 - e]; d[e] = (br == 0 ? (float)f[e] + bk : (float)f[e] - bk) * kscale; }
                    if (br == 0) {
#pragma unroll
                        for (int e = 0; e < 8; ++e) { vr[e] = d[e]; vi[e] = 0.f; }
                    } else {
                        float tr[8], ti[8]; tw8<false>(n0, tr, ti);
#pragma unroll
                        for (int e = 0; e < 8; ++e) { vr[e] = d[e] * tr[e]; vi[e] = d[e] * ti[e]; }
                    }
                    st8(Fre + po + 4352 * g, vr); st8(Fim + po + 4352 * g, vi);
                }
                __syncthreads();
                fft_fwd(Fre, Fim, tid);
                __syncthreads();
                float KrR[32], KrI[32];
#pragma unroll
                for (int g = 0; g < 4; ++g) {
                    const f32x4 r0 = *(const LAS f32x4*)(Fre + po + 4352 * g), r1 = *(const LAS f32x4*)(Fre + po + 4352 * g + 4), i0 = *(const LAS f32x4*)(Fim + po + 4352 * g), i1 = *(const LAS f32x4*)(Fim + po + 4352 * g + 4);
#pragma unroll
                    for (int e = 0; e < 4; ++e) { KrR[g * 8 + e] = r0[e]; KrR[g * 8 + 4 + e] = r1[e]; KrI[g * 8 + e] = i0[e]; KrI[g * 8 + 4 + e] = i1[e]; }
                }
#pragma unroll 1
                for (int pk = 0; pk < 2; ++pk) {
                    __syncthreads();
#pragma unroll 1
                    for (int g = 0; g < 4; ++g) {
                        const int n0 = 8 * (tid + 512 * g);
                        float re[8], im[8];
                        if (o == 0) {
                            sconv8(pbT + ((size_t)((2 * pk) * 1536 + ch) << 14), n0, vw0, vw1, vw2, vb, re);
                            if (pk == 0) sconv8(pbT + ((size_t)(1536 + ch) << 14), n0, vw0, vw1, vw2, vb, im);
                        } else {
                            const f32x4 r0 = *(const f32x4*)(z1buf + (2 * pk) * L + n0), r1 = *(const f32x4*)(z1buf + (2 * pk) * L + n0 + 4);
#pragma unroll
                            for (int e = 0; e < 4; ++e) { re[e] = r0[e]; re[4 + e] = r1[e]; }
                            if (pk == 0) { const f32x4 i0 = *(const f32x4*)(z1buf + L + n0), i1 = *(const f32x4*)(z1buf + L + n0 + 4);
#pragma unroll
                                for (int e = 0; e < 4; ++e) { im[e] = i0[e]; im[4 + e] = i1[e]; } }
                        }
                        if (pk == 1) {
#pragma unroll
                            for (int e = 0; e < 8; ++e) im[e] = 0.f;
                        }
                        if (br == 1) {
                            float tr[8], ti[8]; tw8<false>(n0, tr, ti);
#pragma unroll
                            for (int e = 0; e < 8; ++e) { const float xr = re[e] * tr[e] - im[e] * ti[e], xi = re[e] * ti[e] + im[e] * tr[e]; re[e] = xr; im[e] = xi; }
                        }
                        st8(Fre + po + 4352 * g, re); st8(Fim + po + 4352 * g, im);
                    }
                    __syncthreads();
                    fft_fwd(Fre, Fim, tid);
                    __syncthreads();
#pragma unroll
                    for (int g = 0; g < 4; ++g) {
                        float xr[8], xi[8], yr[8], yi[8];
                        ld8(Fre + po + 4352 * g, xr); ld8(Fim + po + 4352 * g, xi);
#pragma unroll
                        for (int e = 0; e < 8; ++e) { yr[e] = xr[e] * KrR[g * 8 + e] - xi[e] * KrI[g * 8 + e]; yi[e] = xr[e] * KrI[g * 8 + e] + xi[e] * KrR[g * 8 + e]; }
                        st8(Fre + po + 4352 * g, yr); st8(Fim + po + 4352 * g, yi);
                    }
                    __syncthreads();
                    fft_inv(Fre, Fim, tid);
                    __syncthreads();
#pragma unroll 1
                    for (int g = 0; g < 4; ++g) {
                        const int n0 = 8 * (tid + 512 * g);
                        float rr[8], ri[8];
                        ld8(Fre + po + 4352 * g, rr); ld8(Fim + po + 4352 * g, ri);
                        float* ybr = ybuf + (size_t)pk * 2 * L + n0; float* ybi = ybr + L;
                        if (br == 0) {
                            *(f32x4*)ybr = (f32x4){rr[0], rr[1], rr[2], rr[3]}; *(f32x4*)(ybr + 4) = (f32x4){rr[4], rr[5], rr[6], rr[7]};
                            *(f32x4*)ybi = (f32x4){ri[0], ri[1], ri[2], ri[3]}; *(f32x4*)(ybi + 4) = (f32x4){ri[4], ri[5], ri[6], ri[7]};
                        } else {
                            const f32x4 yr0 = *(const f32x4*)ybr, yr1 = *(const f32x4*)(ybr + 4), yi0 = *(const f32x4*)ybi, yi1 = *(const f32x4*)(ybi + 4);
                            const int s0 = 2 * pk;
                            Raw8 gt0 = raw8_load(pbT + ((size_t)(s0 * 1536 + xc) << 14), n0), gt1 = gt0, vt0 = gt0, vt1 = gt0;
                            f32x4 za0 = yr0, za1 = yr0, zb0 = yr0, zb1 = yr0;
                            if (pk == 0) gt1 = raw8_load(pbT + ((size_t)(1536 + xc) << 14), n0);
                            if (o == 0) { vt0 = raw8_load(pbT + ((size_t)(s0 * 1536 + ch) << 14), n0); if (pk == 0) vt1 = raw8_load(pbT + ((size_t)(1536 + ch) << 14), n0); }
                            else { za0 = *(const f32x4*)(z1buf + s0 * L + n0); za1 = *(const f32x4*)(z1buf + s0 * L + n0 + 4); if (pk == 0) { zb0 = *(const f32x4*)(z1buf + L + n0); zb1 = *(const f32x4*)(z1buf + L + n0 + 4); } }
                            float tr[8], ti[8]; tw8<true>(n0, tr, ti);
                            float yre[8], yim[8];
#pragma unroll
                            for (int e = 0; e < 8; ++e) {
                                yre[e] = (e < 4 ? yr0[e & 3] : yr1[e & 3]) + rr[e] * tr[e] - ri[e] * ti[e];
                                yim[e] = (e < 4 ? yi0[e & 3] : yi1[e & 3]) + rr[e] * ti[e] + ri[e] * tr[e];
                            }
                            const int nseq = (pk == 0) ? 2 : 1;
#pragma unroll
                            for (int q = 0; q < 2; ++q) if (q < nseq) {
                                const int s = 2 * pk + q;
                                float gate[8];
                                sconv8_raw(q == 0 ? gt0 : gt1, gw0, gw1, gw2, gb, gate);
                                float* zp = z1buf + s * L + n0;
                                float z[8];
                                if (o == 0) {
                                    float vv[8];
                                    sconv8_raw(q == 0 ? vt0 : vt1, vw0, vw1, vw2, vb, vv);
#pragma unroll
                                    for (int e = 0; e < 8; ++e) z[e] = gate[e] * ((q == 0 ? yre[e] : yim[e]) + vv[e] * skp);
                                    *(f32x4*)zp = (f32x4){z[0], z[1], z[2], z[3]}; *(f32x4*)(zp + 4) = (f32x4){z[4], z[5], z[6], z[7]};
                                } else {
                                    const f32x4 z0 = q == 0 ? za0 : zb0, z1 = q == 0 ? za1 : zb1;
#pragma unroll
                                    for (int e = 0; e < 8; ++e) z[e] = gate[e] * ((q == 0 ? yre[e] : yim[e]) + (e < 4 ? z0[e & 3] : z1[e & 3]) * skp);
                                    u32x4 wv; wv.x = pk_bf16(z[0], z[1]); wv.y = pk_bf16(z[2], z[3]); wv.z = pk_bf16(z[4], z[5]); wv.w = pk_bf16(z[6], z[7]);
                                    if (!DRY) *(u32x4*)(pbT + ((size_t)(s * 1536 + ch) << 14) + n0) = wv;
                                }
                            }
                        }
                    }
                }
            }
            __syncthreads();
        }
    }
    __syncthreads();
}

__device__ void ztrans_phase(const bf16_t* pbT, bf16_t* cat, LAS unsigned char* lds) {
    const int tid = opaque_tid();
    LAS unsigned* tl = (LAS unsigned*)lds;
    LAS bf16_t* tb = (LAS bf16_t*)lds;
    for (int tile0 = blockIdx.x * 2; tile0 < 6144; tile0 += gridDim.x * 2) {
        __syncthreads();
        u32x4 v[2];
#pragma unroll
        for (int k = 0; k < 2; ++k) { const int tile = tile0 + k; const int tt0 = (tile & 255) * 64, ct = (tile >> 8) & 7, s = tile >> 11; const int cc = tid >> 3, tk = (tid & 7) * 8;
            v[k] = *(const u32x4*)(pbT + ((size_t)(s * 1536 + ct * 64 + cc) << 14) + tt0 + tk); }
#pragma unroll
        for (int k = 0; k < 2; ++k) { const int cc = tid >> 3, tk = (tid & 7) * 8;
#pragma unroll
            for (int q = 0; q < 4; ++q) tl[k * 2112 + cc * 33 + (tk >> 1) + q] = v[k][q]; }
        __syncthreads();
#pragma unroll
        for (int k = 0; k < 2; ++k) { const int tile = tile0 + k; const int tt0 = (tile & 255) * 64, ct = (tile >> 8) & 7, s = tile >> 11;
            const int tt = tid >> 3, cg8 = (tid & 7) * 8; bf16_t e[8];
#pragma unroll
            for (int i = 0; i < 8; ++i) e[i] = tb[k * 4224 + (cg8 + i) * 66 + tt];
            u32x4 wv; wv.x = e[0] | ((unsigned)e[1] << 16); wv.y = e[2] | ((unsigned)e[3] << 16); wv.z = e[4] | ((unsigned)e[5] << 16); wv.w = e[6] | ((unsigned)e[7] << 16);
            *(u32x4*)(cat + (size_t)(s * L + tt0 + tt) * 1024 + 512 + ct * 64 + cg8) = wv; }
    }
    __syncthreads();
}

__device__ void attn_phase(const Args& a, const bf16_t* qkv, bf16_t* ao, LAS unsigned char* lds) {
    const int tid = opaque_tid(), lane = tid & 63, w = tid >> 6, l31 = lane & 31, hh = lane >> 5;
    LAS bf16_t* Ks = (LAS bf16_t*)lds;
    LAS bf16_t* VT = (LAS bf16_t*)(lds + 384 * 72 * 2);
    const float* sink = a.in[26];
    for (int item = blockIdx.x; item < 1536; item += gridDim.x) {
        const int kvh = item & 3, qb = (item >> 2) & 127, seq = item >> 9;
        const int kb0 = qb * 128 - 128;
        __syncthreads();
#pragma unroll 1
        for (int ib = 0; ib < 2; ++ib) {
            u32x4 kv[3], vv[3];
#pragma unroll
            for (int k = 0; k < 3; ++k) {
                const int idx = tid + 512 * (3 * ib + k); const int key = idx % 384, dc = idx / 384, kpos = kb0 + key;
                kv[k] = (u32x4){0u, 0u, 0u, 0u}; vv[k] = kv[k];
                if (kpos >= 0 && kpos < L) { const bf16_t* rp = qkv + (size_t)(seq * L + kpos) * 1536 + kvh * 64 + dc * 8; kv[k] = *(const u32x4*)(rp + 1024); vv[k] = *(const u32x4*)(rp + 1280); }
            }
#pragma unroll
            for (int k = 0; k < 3; ++k) {
                const int idx = tid + 512 * (3 * ib + k); const int key = idx % 384, dc = idx / 384;
                *(LAS u32x4*)(Ks + key * 72 + dc * 8) = kv[k];
#pragma unroll
                for (int i = 0; i < 8; ++i) VT[(dc * 8 + i) * 392 + key] = (bf16_t)((vv[k][i >> 1] >> (16 * (i & 1))) & 0xffffu);
            }
        }
        __syncthreads();
        for (int uu = 0; uu < 2; ++uu) {
            const int u = w + 8 * uu, g = u >> 2, qs = u & 3, h = kvh * 4 + g, q0 = qb * 128 + 32 * qs;
            bf16x8 qf[4];
            const bf16_t* qp = qkv + (size_t)(seq * L + q0 + l31) * 1536 + h * 64 + 8 * hh;
#pragma unroll
            for (int ks = 0; ks < 4; ++ks) qf[ks] = *(const bf16x8*)(qp + 16 * ks);
            const float LOG2E = 1.4426950408889634f;
            const float c1 = 0.125f * LOG2E, slope2 = exp2f(-0.5f * (float)(h + 1)) * LOG2E;
            float m = sink[h] * LOG2E, lsum = 1.0f;
            const bool edge = (qb == 0) || (qb == 127);
            f32x16 O0, O1;
#pragma unroll
            for (int r = 0; r < 16; ++r) { O0[r] = 0.f; O1[r] = 0.f; }
#pragma unroll 1
            for (int kt = 0; kt < 9; ++kt) {
                const int kl0 = 32 * qs + 32 * kt;
                f32x16 S;
#pragma unroll
                for (int r = 0; r < 16; ++r) S[r] = 0.f;
#pragma unroll
                for (int ks = 0; ks < 4; ++ks) { const bf16x8 af = *(const LAS bf16x8*)(Ks + (kl0 + l31) * 72 + 16 * ks + 8 * hh); S = __builtin_amdgcn_mfma_f32_32x32x16_bf16(af, qf[ks], S, 0, 0, 0); }
                float p[16]; float mt = -1e30f;
                const float dbase = (float)(32 * kt - 128 + 4 * hh - l31);
                if (kt == 0 || kt == 8 || edge) {
#pragma unroll
                    for (int r = 0; r < 16; ++r) {
                        const int i = 8 * (r >> 2) + 4 * hh + (r & 3);
                        const int kpos = q0 - 128 + 32 * kt + i;
                        const float ad = __builtin_fabsf(dbase + (float)(8 * (r >> 2) + (r & 3)));
                        const bool valid = (ad <= 128.0f) && (kpos >= 0) && (kpos < L);
                        p[r] = valid ? (S[r] * c1 - slope2 * ad) : -1e30f;
                        mt = fmaxf(mt, p[r]);
                    }
                } else {
#pragma unroll
                    for (int r = 0; r < 16; ++r) {
                        const float ad = __builtin_fabsf(dbase + (float)(8 * (r >> 2) + (r & 3)));
                        p[r] = S[r] * c1 - slope2 * ad;
                        mt = fmaxf(mt, p[r]);
                    }
                }
                mt = fmaxf(mt, __shfl_xor(mt, 32));
                const float mnew = fmaxf(m, mt);
                if (__builtin_amdgcn_ballot_w64(mnew != m) != 0ull) {
                    const float alpha = __builtin_amdgcn_exp2f(m - mnew);
                    lsum *= alpha;
#pragma unroll
                    for (int r = 0; r < 16; ++r) { O0[r] *= alpha; O1[r] *= alpha; }
                    m = mnew;
                }
                float rs = 0.f;
#pragma unroll
                for (int r = 0; r < 16; ++r) { p[r] = __builtin_amdgcn_exp2f(p[r] - m); rs += p[r]; }
                rs += __shfl_xor(rs, 32);
                lsum += rs;
#pragma unroll
                for (int kk = 0; kk < 2; ++kk) {
                    u32x4 pw; pw.x = pk_bf16(p[8 * kk], p[8 * kk + 1]); pw.y = pk_bf16(p[8 * kk + 2], p[8 * kk + 3]); pw.z = pk_bf16(p[8 * kk + 4], p[8 * kk + 5]); pw.w = pk_bf16(p[8 * kk + 6], p[8 * kk + 7]);
                    const bf16x8 pf = __builtin_bit_cast(bf16x8, pw);
#pragma unroll
                    for (int dt = 0; dt < 2; ++dt) {
                        const LAS bf16_t* vp = VT + (32 * dt + l31) * 392 + kl0 + 16 * kk + 4 * hh;
                        const u32x2 lo = *(const LAS u32x2*)vp, hi = *(const LAS u32x2*)(vp + 8);
                        const bf16x8 vf = __builtin_bit_cast(bf16x8, (u32x4){lo.x, lo.y, hi.x, hi.y});
                        if (dt == 0) O0 = __builtin_amdgcn_mfma_f32_32x32x16_bf16(vf, pf, O0, 0, 0, 0);
                        else O1 = __builtin_amdgcn_mfma_f32_32x32x16_bf16(vf, pf, O1, 0, 0, 0);
                    }
                }
            }
            const float inv = 1.0f / lsum;
            bf16_t* op = ao + (size_t)(seq * L + q0 + l31) * 1024 + h * 64 + 4 * hh;
#pragma unroll
            for (int b = 0; b < 4; ++b) {
                u32x2 o0; o0.x = pk_bf16(O0[4 * b] * inv, O0[4 * b + 1] * inv); o0.y = pk_bf16(O0[4 * b + 2] * inv, O0[4 * b + 3] * inv);
                u32x2 o1; o1.x = pk_bf16(O1[4 * b] * inv, O1[4 * b + 1] * inv); o1.y = pk_bf16(O1[4 * b + 2] * inv, O1[4 * b + 3] * inv);
                *(u32x2*)(op + 8 * b) = o0; *(u32x2*)(op + 32 + 8 * b) = o1;
            }
        }
    }
    __syncthreads();
}

__global__ void __launch_bounds__(512, 2) mega(Args a) {
    extern __shared__ __attribute__((aligned(16))) unsigned char lds_raw[];
    LAS unsigned char* lds = (LAS unsigned char*)lds_raw;
    unsigned char* ws = a.ws;
    const int lo = a.ph_lo, hi = a.ph_hi;
    bf16_t* XB = (bf16_t*)(ws + WS_H);
    const float* mod = (const float*)(ws + WS_MOD);
    bf16_t* H = (bf16_t*)a.out;
    bf16_t* ACT = (bf16_t*)(ws + WS_ACT);
    bf16_t* PBT = ACT;
    bf16_t* PA = (bf16_t*)(ws + WS_ACT + PBT_BYTES);
    const int G = gridDim.x, bx = blockIdx.x;
    volatile LAS unsigned* bst = (volatile LAS unsigned*)(lds + LDS_BYTES - 16);
    if (threadIdx.x < 4) bst[threadIdx.x] = 0u;
    __syncthreads();
    const XcdBarrier xbar = xcd_barrier_post((unsigned*)(ws + WS_BAR), bst);
#define GSYNC() xcd_barrier(xbar)
#define IN(k) (lo <= (k) && (k) < hi)
#define SEAM(k) do { if (IN(k) && IN((k) + 1)) { GSYNC(); if ((RM >> 15) & 1) GSYNC(); } } while (0)
    int ph = 0;
    if (IN(0)) REP(0) { if (EN(0)) convert_weights(a, (LAS float*)lds); if (EN(1)) ada_phase(a, (LAS float*)lds); if (EN(2)) filter_phase(a, (LAS float*)lds); }
    if (IN(0) && IN(1)) cg::this_grid().sync();
    ph = 1;
#pragma unroll 1
    for (int layer = 0; layer < 2; ++layer) {
        const float* ml = mod + (size_t)layer * 3 * 9216;
        const float* ng = a.in[6] + layer * 3 * 1024;
#pragma unroll 1
        for (int sub = 0; sub < 3; ++sub) {
            const bool first = (layer == 0 && sub == 0);
            const float* xs0 = a.in[0]; const float* xs1 = a.in[1];
            const float* shp = ml + (3 * sub) * 1024; const float* scp = shp + 1024; const float* gp = shp + 2048;
            if (EN(3) && IN(ph)) REP(3) { if (first) norm_phase<true>(xs0, xs1, XB, ng + sub * 1024, shp, scp, H); else norm_phase<false>(xs0, xs1, XB, ng + sub * 1024, shp, scp, H); }
            SEAM(ph); ++ph;
            if (sub != 1) {
                const int fi = layer * 2 + (sub == 2 ? 1 : 0);
                if (EN(4) && IN(ph)) REP(4) { pg8::Gemm g{H, (const bf16_t*)(ws + WS_WIN) + (size_t)fi * 5632 * 1024, T, 5632, 1024}; pg8::StaticOrder S; S.init(T, 5632, G, bx);
                    EpiSwiglu E{ACT}; pg8::gemm_phase<EpiSwiglu>(lds, g, S, E); }
                if (layer == 0 && IN(ph)) convert_tail(a, (LAS float*)lds, sub == 0 ? 0 : 2, 4224);
                SEAM(ph); ++ph;
                if (EN(5) && IN(ph)) { pg8::Gemm g{ACT, (const bf16_t*)(ws + WS_WOUT) + (size_t)fi * 1024 * 2816, T, 1024, DFF}; pg8::StaticOrder S; S.init(T, 1024, G, bx);
                    if (first) { EpiResid<true> E{xs0, xs1, XB, XB, gp, 0.5f}; pg8::gemm_phase<EpiResid<true>>(lds, g, S, E); } else { EpiResid<false> E{xs0, xs1, XB, XB, gp, 0.5f}; pg8::gemm_phase<EpiResid<false>>(lds, g, S, E); } }
                SEAM(ph); ++ph;
            } else if (layer == 0) {
                if (EN(6) && IN(ph)) REP(6) { pg8::Gemm g{H, (const bf16_t*)(ws + WS_WABIN), T, 2560, 1024}; pg8::StaticOrder S; S.init(T, 2560, G, bx);
                    EpiProj E{PA, PBT}; pg8::gemm_phase<EpiProj>(lds, g, S, E); }
                if (IN(ph)) convert_tail(a, (LAS float*)lds, 1, 1920);
                SEAM(ph); ++ph;
                if (IN(ph)) { if (EN(7)) REP(7) conva_phase(a, PA, H, lds); GSYNC(); if ((RM >> 8) & 1) fft_phase<true>(a, PBT, lds); if (EN(8)) fft_phase<false>(a, PBT, lds); }
                SEAM(ph); ++ph;
                if (EN(9) && IN(ph)) REP(9) ztrans_phase(PBT, H, lds);
                SEAM(ph); ++ph;
                if (EN(5) && IN(ph)) { pg8::Gemm g{H, (const bf16_t*)(ws + WS_WABOUT), T, 1024, 1024}; pg8::StaticOrder S; S.init(T, 1024, G, bx);
                    EpiResid<false> E{xs0, xs1, XB, XB, gp, 1.0f}; pg8::gemm_phase<EpiResid<false>>(lds, g, S, E); }
                SEAM(ph); ++ph;
            } else {
                if (EN(10) && IN(ph)) REP(10) { pg8::Gemm g{H, (const bf16_t*)(ws + WS_WQKV), T, 1536, 1024}; pg8::StaticOrder S; S.init(T, 1536, G, bx);
                    EpiBf16 E{ACT, 1536}; pg8::gemm_phase<EpiBf16>(lds, g, S, E); }
                SEAM(ph); ++ph;
                if (EN(11) && IN(ph)) REP(11) attn_phase(a, ACT, H, lds);
                SEAM(ph); ++ph;
                if (EN(5) && IN(ph)) { pg8::Gemm g{H, (const bf16_t*)(ws + WS_WATTO), T, 1024, 1024}; pg8::StaticOrder S; S.init(T, 1024, G, bx);
                    EpiResid<false> E{xs0, xs1, XB, XB, gp, 1.0f}; pg8::gemm_phase<EpiResid<false>>(lds, g, S, E); }
                SEAM(ph); ++ph;
            }
        }
    }
    if (EN(12) && IN(ph)) final_norm_phase(XB, a.out, a.in[9]);
#undef IN
#undef SEAM
}

extern "C" void kernel_launch(void* const* d_in, const int* in_sizes, int n_in, void* d_out, int out_size, void* d_ws, size_t ws_size, hipStream_t stream) {
    static int grid = 0;
    if (grid == 0) {
        int dev = 0, cus = 0, per_cu = 0;
        (void)hipGetDevice(&dev);
        (void)hipDeviceGetAttribute(&cus, hipDeviceAttributeMultiprocessorCount, dev);
        (void)hipFuncSetAttribute((const void*)mega, hipFuncAttributeMaxDynamicSharedMemorySize, LDS_BYTES);
        (void)hipOccupancyMaxActiveBlocksPerMultiprocessor(&per_cu, (const void*)mega, 512, LDS_BYTES);
        if (per_cu < 1) per_cu = 1;
        grid = cus * per_cu;
        if (grid > 256) grid = 256;
        if (ws_size < WS_END) { fprintf(stderr, "workspace too small: %zu < %zu\n", ws_size, (size_t)WS_END); grid = -1; }
    }
    if (grid < 0) return;
    Args a{};
    for (int i = 0; i < 28; ++i) a.in[i] = (const float*)d_in[i];
    a.out = (float*)d_out; a.ws = (unsigned char*)d_ws;
    (void)hipMemsetAsync((unsigned char*)d_ws + WS_BAR, 0, XCD_BAR_WORDS * 4, stream);
#if N_LAUNCH_MODE == 1
    a.ph_lo = 0; a.ph_hi = NPH;
    void* args[] = {&a};
    hipError_t e = hipLaunchCooperativeKernel((const void*)mega, dim3(grid), dim3(512), args, LDS_BYTES, stream);
    if (e != hipSuccess) fprintf(stderr, "cooperative launch failed: %s (grid %d)\n", hipGetErrorString(e), grid);
#else
    for (int p = 0; p < NPH; ++p) { a.ph_lo = p; a.ph_hi = p + 1; hipLaunchKernelGGL(mega, dim3(grid), dim3(512), LDS_BYTES, stream, a); }
#endif
}
```

```cpp
#include <hip/hip_runtime.h>
#include <hip/hip_cooperative_groups.h>
#include <cstdio>
namespace cg = cooperative_groups;

#ifndef PM
#define PM 0xffff
#endif
#define EN(b) ((PM >> (b)) & 1)
#ifndef RM
#define RM 0
#endif
#define REP(b) for (int rep_ = 0; rep_ < 1 + ((RM >> (b)) & 1); ++rep_)
#ifndef N_LAUNCH_MODE
#define N_LAUNCH_MODE 1
#endif

#define LAS __attribute__((address_space(3)))
typedef unsigned short bf16_t;
typedef short bf16x8 __attribute__((ext_vector_type(8)));
typedef float f32x4 __attribute__((ext_vector_type(4)));
typedef float f32x16 __attribute__((ext_vector_type(16)));
typedef unsigned u32x4 __attribute__((ext_vector_type(4)));
typedef unsigned u32x2 __attribute__((ext_vector_type(2)));
typedef __bf16 bf16x2v __attribute__((ext_vector_type(2)));
typedef float f32x2v __attribute__((ext_vector_type(2)));
typedef _Float16 half_t;

constexpr int T = 49152, D = 1024, L = 16384, DFF = 2816, NPH = 23;
constexpr float EPS = 1e-6f;
constexpr int LDS_BYTES = 147456;

constexpr size_t WS_WIN = 0;
constexpr size_t WS_WOUT = WS_WIN + 4ull * 5632 * 1024 * 2;
constexpr size_t WS_WABIN = WS_WOUT + 4ull * 1024 * 2816 * 2;
constexpr size_t WS_WABOUT = WS_WABIN + 2560ull * 1024 * 2;
constexpr size_t WS_WQKV = WS_WABOUT + 1024ull * 1024 * 2;
constexpr size_t WS_WATTO = WS_WQKV + 1536ull * 1024 * 2;
constexpr size_t WS_MOD = WS_WATTO + 1024ull * 1024 * 2;
constexpr size_t WS_BAR = WS_MOD + 221184;
constexpr size_t WS_H = WS_MOD + 262144;
constexpr size_t WS_ACT = WS_H + (size_t)T * 1024 * 2;
constexpr size_t WS_KT = WS_ACT + (size_t)T * DFF * 2;
constexpr size_t WS_END = WS_KT + 2ull * 512 * 2 * L * 2;
constexpr size_t PBT_BYTES = 3ull * 1536 * L * 2;
constexpr size_t FFTSCR_PER_BLOCK = 2ull * L * 8 + 3ull * L * 4;

__device__ __forceinline__ unsigned pk_bf16(float a, float b) { f32x2v f = {a, b}; bf16x2v r = __builtin_convertvector(f, bf16x2v); return __builtin_bit_cast(unsigned, r); }
__device__ __forceinline__ float bf_lo(unsigned v) { return __uint_as_float(v << 16); }
__device__ __forceinline__ float bf_hi(unsigned v) { return __uint_as_float(v & 0xffff0000u); }
__device__ __forceinline__ float bf2f(bf16_t v) { return __uint_as_float((unsigned)v << 16); }
__device__ __forceinline__ bf16_t f2bf(float f) { return (bf16_t)(pk_bf16(f, 0.f) & 0xffffu); }
__device__ __forceinline__ float fsigmoid(float x) { return __builtin_amdgcn_rcpf(1.0f + __expf(-x)); }
__device__ __forceinline__ float hw_sin(float x) { return __builtin_amdgcn_sinf(x * 0.15915494309189535f); }

__device__ __forceinline__ int opaque_tid() { int t = threadIdx.x; asm volatile("" : "+v"(t)); return t; }

#define XB_TMO      128
#define XB_XCNT(j)  (256  + 64 * (j))
#define XB_XSUB(j)  (1280 + 64 * (j))
#define XB_XGEN(j)  (2304 + 64 * (j))
#define XB_TOP      3328
#define XB_TOPGEN   3392
#define XCD_BAR_WORDS 3456
#define XB_SPIN_CAP (1u << 22)
__device__ __forceinline__ unsigned xb_ld(unsigned* p)              { return __hip_atomic_load(p, __ATOMIC_RELAXED, __HIP_MEMORY_SCOPE_AGENT); }
__device__ __forceinline__ unsigned xb_add(unsigned* p, unsigned v) { return __hip_atomic_fetch_add(p, v, __ATOMIC_RELAXED, __HIP_MEMORY_SCOPE_AGENT); }
__device__ __forceinline__ unsigned xb_xcc_id() { return (unsigned)__builtin_amdgcn_s_getreg((3 << 11) | 20) & 0xFu; }
#define XB_SPIN(cond, bar) do { unsigned _sp = 0; while (cond) { __builtin_amdgcn_s_sleep(1); \
    if ((++_sp & 255u) == 0u) { if (xb_ld(&(bar)[XB_TMO])) break; if (_sp > XB_SPIN_CAP) { atomicAdd(&(bar)[XB_TMO], 1u); break; } } } } while (0)
struct XcdBarrier { unsigned* bar; unsigned x; volatile LAS unsigned* st; };
__device__ __forceinline__ XcdBarrier xcd_barrier_post(unsigned* bar, volatile LAS unsigned* st) {
    XcdBarrier b; b.bar = bar; b.x = xb_xcc_id(); b.st = st;
    if (threadIdx.x == 0) (void)xb_add(&bar[XB_XCNT(b.x)], 1u);
    return b;
}
__device__ __forceinline__ void xcd_barrier_complete(unsigned* bar, unsigned x, unsigned& nloc, unsigned& nx) {
    const unsigned G = gridDim.x * gridDim.y * gridDim.z;
    unsigned sum, cnt, mine, sp = 0u;
    for (;;) {
        sum = 0u; cnt = 0u; mine = 0u;
#pragma unroll
        for (unsigned j = 0; j < 16; ++j) { const unsigned c = xb_ld(&bar[XB_XCNT(j)]); sum += c; cnt += (c > 0u) ? 1u : 0u; mine = (j == x) ? c : mine; }
        if (sum == G) break;
        __builtin_amdgcn_s_sleep(1);
        if ((++sp & 255u) == 0u) { if (xb_ld(&bar[XB_TMO])) break; if (sp > XB_SPIN_CAP) { atomicAdd(&bar[XB_TMO], 1u); break; } }
    }
    nloc = mine > 0u ? mine : 1u; nx = cnt > 0u ? cnt : 1u;
}
__device__ __forceinline__ void xcd_barrier(const XcdBarrier& b) {
    asm volatile("s_waitcnt vmcnt(0)" ::: "memory");
    __syncthreads();
    if (threadIdx.x == 0) {
        unsigned* bar = b.bar;
        __builtin_amdgcn_s_waitcnt(0);
        unsigned nloc = b.st[0], nx = b.st[1];
        if (nloc == 0u) { xcd_barrier_complete(bar, b.x, nloc, nx); b.st[0] = nloc; b.st[1] = nx; }
        const unsigned old = xb_add(&bar[XB_XSUB(b.x)], 1u);
        const unsigned gen = old / nloc;
        if (old + 1u == (gen + 1u) * nloc) {
            __builtin_amdgcn_fence(__ATOMIC_RELEASE, "agent");
            asm volatile("s_waitcnt vmcnt(0)" ::: "memory");
            const unsigned og = xb_add(&bar[XB_TOP], 1u);
            const unsigned tg = og / nx;
            if (og + 1u == (tg + 1u) * nx) xb_add(&bar[XB_TOPGEN], 1u);
            else XB_SPIN(xb_ld(&bar[XB_TOPGEN]) == tg, bar);
            __builtin_amdgcn_fence(__ATOMIC_ACQUIRE, "agent");
            xb_add(&bar[XB_XGEN(b.x)], 1u);
            asm volatile("s_waitcnt vmcnt(0)" ::: "memory");
        } else {
            XB_SPIN(xb_ld(&bar[XB_XGEN(b.x)]) == gen, bar);
            __builtin_amdgcn_fence(__ATOMIC_ACQUIRE, "agent");
            asm volatile("s_waitcnt vmcnt(0)" ::: "memory");
        }
    }
    __syncthreads();
}

struct Args { const float* in[28]; float* out; unsigned char* ws; int ph_lo, ph_hi; };

namespace pg8 {
constexpr int BM = 256, BK = 64, HALF = 128, HTB = HALF * BK * 2, STAGE_BYTES = 8 * HTB, NXCD = 8, WGM = 8;
__device__ __forceinline__ int lds_byte(int r, int c) { const int st = (r >> 4) * 2 + (c >> 5), rr = r & 15, cc = c & 31, ob = rr * 64 + cc * 2; return st * 1024 + (ob ^ (((ob >> 9) & 1) << 5)); }
__device__ __forceinline__ void stage_rc(int b, int& R, int& C) { const int st = b / 1024, sb = b % 1024, swz = sb ^ (((sb >> 9) & 1) << 5); R = (st >> 1) * 16 + swz / 64; C = (st & 1) * 32 + (swz % 64) / 2; }
__device__ __forceinline__ int perm32(int rho) { const int n = rho >> 4, i = rho & 15; return 8 * (i >> 2) + 4 * n + (i & 3); }
struct Unit { int pm, pn; };
struct Gemm { const bf16_t* A; const bf16_t* Bt; int M, N, K; };
struct StaticOrder {
    int nM, nN, nwg, G, c;
    __device__ void init(int M, int N, int G_, int c_) { nM = M / BM; nN = N / BM; nwg = nM * nN; G = G_; c = c_; }
    __device__ bool next(int i, Unit& u) const {
        const long Lx = (long)i * G + c; if (Lx >= nwg) return false;
        int wgid = (int)Lx; { const int q = nwg / NXCD, r = nwg % NXCD, xcd = wgid % NXCD, off = wgid / NXCD; wgid = (xcd < r ? xcd * (q + 1) : r * (q + 1) + (xcd - r) * q) + off; }
        const int nig = WGM * nN, gid = wgid / nig, fm = gid * WGM, gsz = (nM - fm) < WGM ? (nM - fm) : WGM;
        u.pm = fm + ((wgid % nig) % gsz); u.pn = (wgid % nig) / gsz; return true;
    }
};

template <class Epi>
__device__ __forceinline__ void gemm_phase(LAS unsigned char* lds, const Gemm g, const StaticOrder& S, const Epi& E) {
    const int tid = opaque_tid(), wid = __builtin_amdgcn_readfirstlane(tid >> 6), lane = tid & 63, wr = wid >> 2, wc = wid & 3, fr = lane & 15, fq = lane >> 4;
    const int K = g.K, nt = K / BK;
    unsigned voffA[2], voffB[2];
#pragma unroll
    for (int i = 0; i < 2; ++i) { int R, C; stage_rc(tid * 16 + i * 8192, R, C); const int Rb = Epi::PERM ? ((R & ~31) + perm32(R & 31)) : R;
        voffA[i] = (unsigned)(R * K + C) * 2u; voffB[i] = (unsigned)(Rb * K + C) * 2u; }
    const size_t kstep = (size_t)(BK * 2);
    const size_t hstep = (size_t)HALF * K * 2;
    const size_t tstep = 2 * hstep;
    const unsigned ldsw = (unsigned)wid * 1024u;
    const int aoff = lds_byte(wr * 64 + fr, fq * 8), boff = lds_byte(wc * 32 + fr, fq * 8);
#define PG8_SA(b, h) (((b) * 2 + (h)) * HTB)
#define PG8_SB(b, h) ((4 + (b) * 2 + (h)) * HTB)
#define PG8_STAGE(bufoff, gbase, voff) do { _Pragma("unroll") for (int _i = 0; _i < 2; ++_i) \
        __builtin_amdgcn_global_load_lds((const unsigned*)((const char*)(gbase) + (voff)[_i]), (LAS unsigned*)(lds + (bufoff) + ldsw + _i * 8192), 16, 0, 0); } while (0)
#define PG8_LDA(dst, b, h) do { _Pragma("unroll") for (int m = 0; m < 4; ++m) _Pragma("unroll") for (int k = 0; k < 2; ++k) dst[m][k] = *(const LAS bf16x8*)(lds + PG8_SA(b, h) + aoff + m * 2048 + k * 1024); } while (0)
#define PG8_LDB(dst, b, h) do { _Pragma("unroll") for (int n = 0; n < 2; ++n) _Pragma("unroll") for (int k = 0; k < 2; ++k) dst[n][k] = *(const LAS bf16x8*)(lds + PG8_SB(b, h) + boff + n * 2048 + k * 1024); } while (0)
#define PG8_MMA(ai, bj, At, Bt) do { __builtin_amdgcn_s_setprio(1); _Pragma("unroll") for (int m = 0; m < 4; ++m) _Pragma("unroll") for (int n = 0; n < 2; ++n) _Pragma("unroll") for (int k = 0; k < 2; ++k) \
        acc[ai][bj][m][n] = __builtin_amdgcn_mfma_f32_16x16x32_bf16(Bt[n][k], At[m][k], acc[ai][bj][m][n], 0, 0, 0); __builtin_amdgcn_s_setprio(0); } while (0)
#define PG8_WAIT_V(n) asm volatile("s_waitcnt vmcnt(" #n ")" ::: "memory")
#define PG8_WAIT_L(n) asm volatile("s_waitcnt lgkmcnt(" #n ")" ::: "memory")
#define PG8_BAR __builtin_amdgcn_s_barrier()
#define PG8_SCHED __builtin_amdgcn_sched_barrier(0)
    Unit cur, nxt; int ui = 0;
    if (!S.next(0, cur)) return;
    f32x4 acc[2][2][4][2];
#pragma unroll
    for (int a = 0; a < 2; ++a)
#pragma unroll
        for (int b = 0; b < 2; ++b)
#pragma unroll
            for (int m = 0; m < 4; ++m)
#pragma unroll
                for (int n = 0; n < 2; ++n) acc[a][b][m][n] = (f32x4){0.f, 0.f, 0.f, 0.f};
    bf16x8 At[4][2], B0[2][2], B1[2][2];
    const char* cA = (const char*)g.A + (size_t)cur.pm * tstep; const char* cB = (const char*)g.Bt + (size_t)cur.pn * tstep;
    PG8_STAGE(PG8_SB(0, 0), cB, voffB); PG8_STAGE(PG8_SA(0, 0), cA, voffA); PG8_STAGE(PG8_SB(0, 1), cB + hstep, voffB); PG8_STAGE(PG8_SA(0, 1), cA + hstep, voffA);
    if (wr == 1) PG8_BAR;
    PG8_WAIT_V(4); PG8_BAR;
    PG8_STAGE(PG8_SB(1, 0), cB + kstep, voffB); PG8_STAGE(PG8_SA(1, 0), cA + kstep, voffA); PG8_STAGE(PG8_SB(1, 1), cB + hstep + kstep, voffB);
    PG8_WAIT_V(6); PG8_BAR;
    for (;;) {
        const bool has_next = S.next(ui + 1, nxt);
        const char* nA = has_next ? (const char*)g.A + (size_t)nxt.pm * tstep : cA; const char* nB = has_next ? (const char*)g.Bt + (size_t)nxt.pn * tstep : cB;
        for (int t = 0; t < nt; t += 2) {
            const bool last = (t == nt - 2);
            const char* a1 = cA + (size_t)(t + 1) * kstep;
            const char* a2 = last ? nA : cA + (size_t)(t + 2) * kstep; const char* b2 = last ? nB : cB + (size_t)(t + 2) * kstep;
            const char* a3 = a2 + kstep; const char* b3 = b2 + kstep;
            PG8_LDB(B0, 0, 0); PG8_SCHED; PG8_LDA(At, 0, 0); PG8_STAGE(PG8_SA(1, 1), a1 + hstep, voffA);
            PG8_WAIT_L(8); PG8_BAR; PG8_WAIT_L(0); PG8_MMA(0, 0, At, B0); PG8_BAR; PG8_SCHED;
            PG8_LDB(B1, 0, 1); PG8_STAGE(PG8_SB(0, 0), b2, voffB);
            PG8_BAR; PG8_WAIT_L(0); PG8_MMA(0, 1, At, B1); PG8_BAR;
            PG8_LDA(At, 0, 1); PG8_STAGE(PG8_SA(0, 0), a2, voffA);
            PG8_BAR; PG8_WAIT_L(0); PG8_MMA(1, 0, At, B0); PG8_BAR; PG8_SCHED;
            PG8_STAGE(PG8_SB(0, 1), b2 + hstep, voffB);
            PG8_WAIT_V(6); PG8_BAR; PG8_MMA(1, 1, At, B1); PG8_BAR;
            PG8_LDB(B0, 1, 0); PG8_SCHED; PG8_LDA(At, 1, 0); PG8_STAGE(PG8_SA(0, 1), a2 + hstep, voffA);
            PG8_WAIT_L(8); PG8_BAR; PG8_WAIT_L(0); PG8_MMA(0, 0, At, B0); PG8_BAR; PG8_SCHED;
            PG8_LDB(B1, 1, 1); PG8_STAGE(PG8_SB(1, 0), b3, voffB);
            PG8_BAR; PG8_WAIT_L(0); PG8_MMA(0, 1, At, B1); PG8_BAR;
            PG8_LDA(At, 1, 1); PG8_STAGE(PG8_SA(1, 0), a3, voffA);
            PG8_BAR; PG8_WAIT_L(0); PG8_MMA(1, 0, At, B0); PG8_BAR; PG8_SCHED;
            PG8_STAGE(PG8_SB(1, 1), b3 + hstep, voffB);
            PG8_WAIT_V(6); PG8_BAR; PG8_MMA(1, 1, At, B1); PG8_BAR;
        }
        E(acc, cur, wr, wc, fr, fq);
        if (!has_next) break;
#pragma unroll
        for (int a = 0; a < 2; ++a)
#pragma unroll
            for (int b = 0; b < 2; ++b)
#pragma unroll
                for (int m = 0; m < 4; ++m)
#pragma unroll
                    for (int n = 0; n < 2; ++n) acc[a][b][m][n] = (f32x4){0.f, 0.f, 0.f, 0.f};
        cur = nxt; cA = nA; cB = nB; ++ui;
    }
    PG8_WAIT_V(0);
    if (wr == 0) PG8_BAR;
    PG8_BAR;
#undef PG8_SA
#undef PG8_SB
#undef PG8_STAGE
#undef PG8_LDA
#undef PG8_LDB
#undef PG8_MMA
#undef PG8_WAIT_V
#undef PG8_WAIT_L
#undef PG8_BAR
#undef PG8_SCHED
}
}

struct EpiSwiglu {
    static constexpr bool PERM = true;
    bf16_t* O;
    __device__ __forceinline__ void operator()(const f32x4 (&acc)[2][2][4][2], const pg8::Unit& u, int wr, int wc, int fr, int fq) const {
        const int row0 = u.pm * 256 + wr * 64 + fr, col0 = u.pn * 128 + wc * 32 + 8 * fq;
#pragma unroll
        for (int ai = 0; ai < 2; ++ai)
#pragma unroll
            for (int m = 0; m < 4; ++m) {
                bf16_t* rowp = O + (size_t)(row0 + ai * 128 + m * 16) * DFF + col0;
                float v[8];
#pragma unroll
                for (int n = 0; n < 2; ++n)
#pragma unroll
                    for (int j = 0; j < 4; ++j) { const float gg = acc[ai][0][m][n][j], uu = acc[ai][1][m][n][j]; v[n * 4 + j] = gg * fsigmoid(gg) * uu; }
                u32x4 w; w.x = pk_bf16(v[0], v[1]); w.y = pk_bf16(v[2], v[3]); w.z = pk_bf16(v[4], v[5]); w.w = pk_bf16(v[6], v[7]);
                *(u32x4*)rowp = w;
            }
    }
};
struct EpiBf16 {
    static constexpr bool PERM = true;
    bf16_t* O; int ldc;
    __device__ __forceinline__ void operator()(const f32x4 (&acc)[2][2][4][2], const pg8::Unit& u, int wr, int wc, int fr, int fq) const {
        const int row0 = u.pm * 256 + wr * 64 + fr, col0 = u.pn * 256 + wc * 32 + 8 * fq;
#pragma unroll
        for (int ai = 0; ai < 2; ++ai)
#pragma unroll
            for (int m = 0; m < 4; ++m) {
                bf16_t* rowp = O + (size_t)(row0 + ai * 128 + m * 16) * ldc + col0;
#pragma unroll
                for (int bj = 0; bj < 2; ++bj) {
                    const f32x4 v0 = acc[ai][bj][m][0], v1 = acc[ai][bj][m][1];
                    u32x4 w; w.x = pk_bf16(v0[0], v0[1]); w.y = pk_bf16(v0[2], v0[3]); w.z = pk_bf16(v1[0], v1[1]); w.w = pk_bf16(v1[2], v1[3]);
                    *(u32x4*)(rowp + bj * 128) = w;
                }
            }
    }
};
struct EpiProj {
    static constexpr bool PERM = true;
    bf16_t* Oa; bf16_t* ObT;
    __device__ __forceinline__ void operator()(const f32x4 (&acc)[2][2][4][2], const pg8::Unit& u, int wr, int wc, int fr, int fq) const {
        const int row0 = u.pm * 256 + wr * 64 + fr;
        if (u.pn < 4) {
            const int col0 = u.pn * 256 + wc * 32 + 8 * fq;
#pragma unroll
            for (int ai = 0; ai < 2; ++ai)
#pragma unroll
                for (int m = 0; m < 4; ++m) {
                    bf16_t* rowp = Oa + (size_t)(row0 + ai * 128 + m * 16) * 1024 + col0;
#pragma unroll
                    for (int bj = 0; bj < 2; ++bj) {
                        const f32x4 v0 = acc[ai][bj][m][0], v1 = acc[ai][bj][m][1];
                        u32x4 w; w.x = pk_bf16(v0[0], v0[1]); w.y = pk_bf16(v0[2], v0[3]); w.z = pk_bf16(v1[0], v1[1]); w.w = pk_bf16(v1[2], v1[3]);
                        *(u32x4*)(rowp + bj * 128) = w;
                    }
                }
        } else {
            const int seq = (u.pm * 256) >> 14;
            const int c0 = (u.pn - 4) * 256 + wc * 32 + 8 * fq;
#pragma unroll
            for (int ai = 0; ai < 2; ++ai)
#pragma unroll
                for (int m = 0; m < 4; ++m) {
                    const int nn = (row0 + ai * 128 + m * 16) & (L - 1);
#pragma unroll
                    for (int bj = 0; bj < 2; ++bj)
#pragma unroll
                        for (int n = 0; n < 2; ++n)
#pragma unroll
                            for (int j = 0; j < 4; ++j)
                                ObT[((size_t)(seq * 1536 + c0 + bj * 128 + 4 * n + j) << 14) + nn] = f2bf(acc[ai][bj][m][n][j]);
                }
        }
    }
};
template <bool SRC_F32> struct EpiResid {
    static constexpr bool PERM = true;
    const float* xs0; const float* xs1; const bf16_t* xbs; bf16_t* xbo; const float* gate; float scale;
    __device__ __forceinline__ void operator()(const f32x4 (&acc)[2][2][4][2], const pg8::Unit& u, int wr, int wc, int fr, int fq) const {
        const int row0 = u.pm * 256 + wr * 64 + fr, col0 = u.pn * 256 + wc * 32 + 8 * fq;
        const int seq = (u.pm * 256) >> 14;
        const float* gb = gate + seq * 9216 + col0;
        const float* sf = (seq < 2 ? xs0 + (size_t)row0 * 1024 : xs1 + (size_t)(row0 - 32768) * 1024) + col0;
        const size_t ob = (size_t)row0 * 1024 + col0;
#pragma unroll
        for (int bj = 0; bj < 2; ++bj) {
            const f32x4 g0 = *(const f32x4*)(gb + bj * 128) * scale, g1 = *(const f32x4*)(gb + bj * 128 + 4) * scale;
            f32x4 x0[2][4], x1[2][4]; u32x4 q[2][4];
#pragma unroll
            for (int ai = 0; ai < 2; ++ai)
#pragma unroll
                for (int m = 0; m < 4; ++m) {
                    const size_t off = (size_t)(ai * 128 + m * 16) * 1024 + bj * 128;
                    if (SRC_F32) { x0[ai][m] = *(const f32x4*)(sf + off); x1[ai][m] = *(const f32x4*)(sf + off + 4); }
                    else q[ai][m] = *(const u32x4*)(xbs + ob + off);
                }
#pragma unroll
            for (int ai = 0; ai < 2; ++ai)
#pragma unroll
                for (int m = 0; m < 4; ++m) {
                    const size_t off = (size_t)(ai * 128 + m * 16) * 1024 + bj * 128;
                    f32x4 a0, a1;
                    if (SRC_F32) { a0 = x0[ai][m]; a1 = x1[ai][m]; }
                    else { const u32x4 t = q[ai][m]; a0 = (f32x4){bf_lo(t.x), bf_hi(t.x), bf_lo(t.y), bf_hi(t.y)}; a1 = (f32x4){bf_lo(t.z), bf_hi(t.z), bf_lo(t.w), bf_hi(t.w)}; }
                    const f32x4 y0 = a0 + g0 * acc[ai][bj][m][0], y1 = a1 + g1 * acc[ai][bj][m][1];
                    u32x4 w; w.x = pk_bf16(y0[0], y0[1]); w.y = pk_bf16(y0[2], y0[3]); w.z = pk_bf16(y1[0], y1[1]); w.w = pk_bf16(y1[2], y1[3]);
                    *(u32x4*)(xbo + ob + off) = w;
                }
        }
    }
};

struct WTile { const float* src; bf16_t* dst; int K, N, k0, np0, n0; };
__device__ __forceinline__ WTile wtile_desc(const Args& a, int ti) {
    unsigned char* ws = a.ws;
    WTile t; int mode = 0, lt;
    if (ti < 5632) { const int mi = ti / 1408; lt = ti % 1408; t.src = a.in[7] + (size_t)mi * 1024 * 5632; t.dst = (bf16_t*)(ws + WS_WIN) + (size_t)mi * 5632 * 1024; t.K = 1024; t.N = 5632; mode = 1; }
    else if (ti < 8448) { const int mi = (ti - 5632) / 704; lt = (ti - 5632) % 704; t.src = a.in[8] + (size_t)mi * 2816 * 1024; t.dst = (bf16_t*)(ws + WS_WOUT) + (size_t)mi * 1024 * 2816; t.K = 2816; t.N = 1024; }
    else if (ti < 9088) { lt = ti - 8448; t.src = a.in[10]; t.dst = (bf16_t*)(ws + WS_WABIN); t.K = 1024; t.N = 2560; }
    else if (ti < 9344) { lt = ti - 9088; t.src = a.in[24]; t.dst = (bf16_t*)(ws + WS_WABOUT); t.K = 1024; t.N = 1024; }
    else if (ti < 9728) { lt = ti - 9344; t.src = a.in[25]; t.dst = (bf16_t*)(ws + WS_WQKV); t.K = 1024; t.N = 1536; }
    else { lt = ti - 9728; t.src = a.in[27]; t.dst = (bf16_t*)(ws + WS_WATTO); t.K = 1024; t.N = 1024; }
    const int nkt = t.K / 64;
    const int kt = lt % nkt, ntp = lt / nkt;
    t.k0 = kt * 64; t.np0 = ntp * 64; t.n0 = t.np0;
    if (mode == 1) { const int pn = t.np0 >> 8, bj = (t.np0 >> 7) & 1, c0 = t.np0 & 127; t.n0 = bj * DFF + 128 * pn + c0; }
    return t;
}
__device__ void convert_span(const Args& a, LAS float* tile, int lo, int hi, int bi, int nb) {
    const int tid = opaque_tid();
    for (int base = lo + bi; base < hi; base += 4 * nb) {
        __syncthreads();
        float v[4][8];
#pragma unroll
        for (int q = 0; q < 4; ++q) {
            const int ti = base + q * nb;
            if (ti < hi) { const WTile t = wtile_desc(a, ti);
#pragma unroll
                for (int i = 0; i < 8; ++i) { const int k = (tid >> 6) + 8 * i, n = tid & 63; v[q][i] = t.src[(size_t)(t.k0 + k) * t.N + t.n0 + n]; } }
        }
#pragma unroll
        for (int q = 0; q < 4; ++q)
#pragma unroll
            for (int i = 0; i < 8; ++i) { const int k = (tid >> 6) + 8 * i, n = tid & 63; tile[q * 4160 + k * 65 + n] = v[q][i]; }
        __syncthreads();
#pragma unroll
        for (int q = 0; q < 4; ++q) {
            const int ti = base + q * nb;
            if (ti < hi) { const WTile t = wtile_desc(a, ti);
                const int nn = tid >> 3, kk = (tid & 7) * 8;
                float x[8];
#pragma unroll
                for (int j = 0; j < 8; ++j) x[j] = tile[q * 4160 + (kk + j) * 65 + nn];
                u32x4 w; w.x = pk_bf16(x[0], x[1]); w.y = pk_bf16(x[2], x[3]); w.z = pk_bf16(x[4], x[5]); w.w = pk_bf16(x[6], x[7]);
                *(u32x4*)(t.dst + (size_t)(t.np0 + nn) * t.K + t.k0 + kk) = w; }
        }
    }
    __syncthreads();
}
__device__ void convert_weights(const Args& a, LAS float* tile) {
    const int G = gridDim.x, bx = blockIdx.x;
#pragma unroll 1
    for (int r = 0; r < 3; ++r) { const int lo = r == 0 ? 0 : r == 1 ? 5632 : 8448, hi = r == 0 ? 2816 : r == 1 ? 7040 : 9344; convert_span(a, tile, lo, hi, bx, G); }
}
__device__ void convert_tail(const Args& a, LAS float* tile, int which, int nwg) {
    const int G = gridDim.x, bx = blockIdx.x, rem = nwg % G;
    int bi = bx, nb = G;
    if (rem != 0) { if (bx < rem) return; bi = bx - rem; nb = G - rem; }
#pragma unroll 1
    for (int r = 0; r < 2; ++r) {
        int lo, hi;
        if (which == 0) { lo = r == 0 ? 2816 : 0; hi = r == 0 ? 4736 : 0; }
        else if (which == 1) { lo = r == 0 ? 4736 : 7040; hi = r == 0 ? 5632 : 8064; }
        else { lo = r == 0 ? 8064 : 9344; hi = r == 0 ? 8448 : 9984; }
        convert_span(a, tile, lo, hi, bi, nb);
    }
}

__device__ void ada_phase(const Args& a, LAS float* lf) {
    const int tid = opaque_tid(), lane = tid & 63, w = tid >> 6;
    LAS float* cs = lf; LAS float* red = lf + 3072;
    float* mod = (float*)(a.ws + WS_MOD);
    __syncthreads();
    for (int i = tid; i < 3072; i += 512) { const int s = i >> 10, k = i & 1023; const float c = s < 2 ? a.in[2][s * 1024 + k] : a.in[3][k]; cs[i] = c * fsigmoid(c); }
    __syncthreads();
    for (int item = blockIdx.x; item < 1152; item += gridDim.x) {
        const int layer = item / 576, cgp = item % 576, cl = lane & 15, ks = lane >> 4, col = cgp * 16 + cl;
        const float* W = a.in[4] + (size_t)layer * 1024 * 9216 + col;
        const int kb = (w * 4 + ks) * 32;
        float a0 = 0.f, a1 = 0.f, a2 = 0.f;
#pragma unroll 16
        for (int k = kb; k < kb + 32; ++k) { const float wv = W[(size_t)k * 9216]; a0 += cs[k] * wv; a1 += cs[1024 + k] * wv; a2 += cs[2048 + k] * wv; }
        a0 += __shfl_xor(a0, 16); a0 += __shfl_xor(a0, 32); a1 += __shfl_xor(a1, 16); a1 += __shfl_xor(a1, 32); a2 += __shfl_xor(a2, 16); a2 += __shfl_xor(a2, 32);
        if (lane < 16) { red[(w * 3 + 0) * 16 + cl] = a0; red[(w * 3 + 1) * 16 + cl] = a1; red[(w * 3 + 2) * 16 + cl] = a2; }
        __syncthreads();
        if (tid < 48) { const int s = tid >> 4, c = tid & 15; float sum = 0.f;
#pragma unroll
            for (int ww = 0; ww < 8; ++ww) sum += red[(ww * 3 + s) * 16 + c];
            mod[(size_t)(layer * 3 + s) * 9216 + cgp * 16 + c] = sum + a.in[5][layer * 9216 + cgp * 16 + c]; }
        __syncthreads();
    }
}

__device__ void filter_phase(const Args& a, LAS float* lf) {
    const int tid = opaque_tid();
    LAS float* feats = lf;
    LAS float* h1 = lf + 64 * 33;
    LAS float* h2T = h1 + 64 * 65;
    const float* w1 = a.in[17]; const float* b1 = a.in[18]; const float* w2 = a.in[19]; const float* b2 = a.in[20]; const float* w3 = a.in[21]; const float* fr = a.in[22];
    half_t* KT = (half_t*)(a.ws + WS_KT);
    for (int item = blockIdx.x; item < 256; item += gridDim.x) {
        const int p0 = item * 64;
        __syncthreads();
        for (int idx = tid; idx < 64 * 33; idx += 512) {
            const int pos = idx / 33, f = idx % 33, n = p0 + pos; float v;
            if (f == 0) v = (float)n / (float)(L - 1);
            else { const int b = (f - 1) & 15; const double band = 1e-4 + (double)b * ((15.0 - 1e-4) / 15.0); double rev = (double)n * band / (double)L; rev -= floor(rev);
                   v = (f <= 16) ? __builtin_amdgcn_cosf((float)rev) : -__builtin_amdgcn_sinf((float)rev); }
            feats[idx] = v;
        }
        __syncthreads();
        { const int pos = tid >> 3, j0 = (tid & 7) * 8; float acc[8];
#pragma unroll
          for (int j = 0; j < 8; ++j) acc[j] = b1[j0 + j];
#pragma unroll 3
          for (int f = 0; f < 33; ++f) { const float x = feats[pos * 33 + f];
#pragma unroll
              for (int j = 0; j < 8; ++j) acc[j] += x * w1[f * 64 + j0 + j]; }
#pragma unroll
          for (int j = 0; j < 8; ++j) h1[pos * 65 + j0 + j] = hw_sin(fr[j0 + j] * acc[j]); }
        __syncthreads();
        { const int pos = tid >> 3, j0 = (tid & 7) * 8; float acc[8];
#pragma unroll
          for (int j = 0; j < 8; ++j) acc[j] = b2[j0 + j];
#pragma unroll 4
          for (int i = 0; i < 64; ++i) { const float x = h1[pos * 65 + i];
#pragma unroll
              for (int j = 0; j < 8; ++j) acc[j] += x * w2[i * 64 + j0 + j]; }
#pragma unroll
          for (int j = 0; j < 8; ++j) h2T[(j0 + j) * 64 + pos] = hw_sin(fr[j0 + j] * acc[j]); }
        __syncthreads();
        const int col0 = tid * 4;
        const int dir = col0 >> 10, ord = (col0 >> 9) & 1, ch0 = col0 & 511;
#pragma unroll 1
        for (int chunk = 0; chunk < 4; ++chunk) {
            float acc[16][4];
#pragma unroll
            for (int p = 0; p < 16; ++p)
#pragma unroll
                for (int c = 0; c < 4; ++c) acc[p][c] = 0.f;
#pragma unroll 2
            for (int j = 0; j < 64; ++j) {
                const f32x4 wv = *(const f32x4*)(w3 + j * 2048 + col0);
                f32x4 hv[4];
#pragma unroll
                for (int q = 0; q < 4; ++q) hv[q] = *(const LAS f32x4*)(h2T + j * 64 + chunk * 16 + q * 4);
#pragma unroll
                for (int p = 0; p < 16; ++p)
#pragma unroll
                    for (int c = 0; c < 4; ++c) acc[p][c] += hv[p >> 2][p & 3] * wv[c];
            }
#pragma unroll
            for (int c = 0; c < 4; ++c) {
                const int ch = ch0 + c;
                const float delta = 3.0701134573253945f + (float)ch * (12.280453829301578f / 511.0f);
                half_t* dstp = KT + ((size_t)((ord * 512 + ch) * 2 + dir) << 14) + p0 + chunk * 16;
                unsigned pk[8];
#pragma unroll
                for (int p = 0; p < 16; p += 2) {
                    const float t0 = (float)(p0 + chunk * 16 + p) / (float)(L - 1), t1 = (float)(p0 + chunk * 16 + p + 1) / (float)(L - 1);
                    const half_t x0 = (half_t)(acc[p][c] * __expf(-t0 * delta)), x1 = (half_t)(acc[p + 1][c] * __expf(-t1 * delta));
                    pk[p >> 1] = (unsigned)__builtin_bit_cast(unsigned short, x0) | ((unsigned)__builtin_bit_cast(unsigned short, x1) << 16);
                }
                *(u32x4*)dstp = (u32x4){pk[0], pk[1], pk[2], pk[3]};
                *(u32x4*)(dstp + 8) = (u32x4){pk[4], pk[5], pk[6], pk[7]};
            }
        }
    }
    __syncthreads();
}

template <bool SRC_F32> __device__ void norm_phase(const float* xs0, const float* xs1, const bf16_t* xb, const float* g, const float* sh, const float* sc, bf16_t* h) {
    constexpr int NR = SRC_F32 ? 2 : 4;
    const int tid_ = opaque_tid(); const int lane = tid_ & 63, w = tid_ >> 6;
    f32x4 gg[2][2];
#pragma unroll
    for (int i = 0; i < 2; ++i) { gg[i][0] = *(const f32x4*)(g + i * 512 + lane * 8); gg[i][1] = *(const f32x4*)(g + i * 512 + lane * 8 + 4); }
    for (int rb = (blockIdx.x * 8 + w) * NR; rb < T; rb += gridDim.x * 8 * NR) {
        const int seq = rb >> 14;
        f32x4 v[NR][2][2]; u32x4 q[NR][2];
#pragma unroll
        for (int r = 0; r < NR; ++r) {
            const int row = rb + r;
            if (SRC_F32) {
                const float* xr = seq < 2 ? xs0 + (size_t)row * 1024 : xs1 + (size_t)(row - 32768) * 1024;
#pragma unroll
                for (int i = 0; i < 2; ++i) { v[r][i][0] = *(const f32x4*)(xr + i * 512 + lane * 8); v[r][i][1] = *(const f32x4*)(xr + i * 512 + lane * 8 + 4); }
            } else {
#pragma unroll
                for (int i = 0; i < 2; ++i) q[r][i] = *(const u32x4*)(xb + (size_t)row * 1024 + i * 512 + lane * 8);
            }
        }
        f32x4 s1[2][2], s0[2][2];
#pragma unroll
        for (int i = 0; i < 2; ++i)
#pragma unroll
            for (int k = 0; k < 2; ++k) { s1[i][k] = *(const f32x4*)(sc + seq * 9216 + i * 512 + lane * 8 + 4 * k) + 1.0f; s0[i][k] = *(const f32x4*)(sh + seq * 9216 + i * 512 + lane * 8 + 4 * k); }
#pragma unroll
        for (int r = 0; r < NR; ++r) {
            const int row = rb + r;
            if (!SRC_F32) {
#pragma unroll
                for (int i = 0; i < 2; ++i) { const u32x4 t = q[r][i]; v[r][i][0] = (f32x4){bf_lo(t.x), bf_hi(t.x), bf_lo(t.y), bf_hi(t.y)}; v[r][i][1] = (f32x4){bf_lo(t.z), bf_hi(t.z), bf_lo(t.w), bf_hi(t.w)}; }
            }
            float ss = 0.f;
#pragma unroll
            for (int i = 0; i < 2; ++i)
#pragma unroll
                for (int k = 0; k < 2; ++k) ss += v[r][i][k][0] * v[r][i][k][0] + v[r][i][k][1] * v[r][i][k][1] + v[r][i][k][2] * v[r][i][k][2] + v[r][i][k][3] * v[r][i][k][3];
#pragma unroll
            for (int o = 32; o > 0; o >>= 1) ss += __shfl_xor(ss, o);
            const float rstd = rsqrtf(ss * (1.0f / 1024.0f) + EPS);
#pragma unroll
            for (int i = 0; i < 2; ++i) {
                const f32x4 y0 = v[r][i][0] * rstd * gg[i][0] * s1[i][0] + s0[i][0], y1 = v[r][i][1] * rstd * gg[i][1] * s1[i][1] + s0[i][1];
                u32x4 o; o.x = pk_bf16(y0[0], y0[1]); o.y = pk_bf16(y0[2], y0[3]); o.z = pk_bf16(y1[0], y1[1]); o.w = pk_bf16(y1[2], y1[3]);
                *(u32x4*)(h + (size_t)row * 1024 + i * 512 + lane * 8) = o;
            }
        }
    }
}
__device__ void final_norm_phase(const bf16_t* xb, float* out, const float* g) {
    constexpr int NR = 4;
    const int tid_ = opaque_tid(); const int lane = tid_ & 63, w = tid_ >> 6;
    f32x4 gg[2][2];
#pragma unroll
    for (int i = 0; i < 2; ++i) { gg[i][0] = *(const f32x4*)(g + i * 512 + lane * 8); gg[i][1] = *(const f32x4*)(g + i * 512 + lane * 8 + 4); }
    for (int rb = (blockIdx.x * 8 + w) * NR; rb < T; rb += gridDim.x * 8 * NR) {
        u32x4 q[NR][2];
#pragma unroll
        for (int r = 0; r < NR; ++r)
#pragma unroll
            for (int i = 0; i < 2; ++i) q[r][i] = *(const u32x4*)(xb + (size_t)(rb + r) * 1024 + i * 512 + lane * 8);
#pragma unroll
        for (int r = 0; r < NR; ++r) {
            f32x4 v[2][2]; float ss = 0.f;
#pragma unroll
            for (int i = 0; i < 2; ++i) { const u32x4 t = q[r][i]; v[i][0] = (f32x4){bf_lo(t.x), bf_hi(t.x), bf_lo(t.y), bf_hi(t.y)}; v[i][1] = (f32x4){bf_lo(t.z), bf_hi(t.z), bf_lo(t.w), bf_hi(t.w)}; }
#pragma unroll
            for (int i = 0; i < 2; ++i)
#pragma unroll
                for (int k = 0; k < 2; ++k) ss += v[i][k][0] * v[i][k][0] + v[i][k][1] * v[i][k][1] + v[i][k][2] * v[i][k][2] + v[i][k][3] * v[i][k][3];
#pragma unroll
            for (int o = 32; o > 0; o >>= 1) ss += __shfl_xor(ss, o);
            const float rstd = rsqrtf(ss * (1.0f / 1024.0f) + EPS);
#pragma unroll
            for (int i = 0; i < 2; ++i)
#pragma unroll
                for (int k = 0; k < 2; ++k) *(f32x4*)(out + (size_t)(rb + r) * 1024 + i * 512 + lane * 8 + 4 * k) = v[i][k] * rstd * gg[i][k];
        }
    }
}

__device__ void conva_phase(const Args& a, const bf16_t* pa, bf16_t* cat, LAS unsigned char* lds) {
    const int tid = opaque_tid(), lane = tid & 63, w = tid >> 6;
    LAS bf16_t* glu = (LAS bf16_t*)lds;
    LAS float* stage = (LAS float*)(lds + 94 * 512 * 2);
    const float* cw = a.in[11]; const float* cb = a.in[12]; const float* lg = a.in[13]; const float* lb = a.in[14];
    float wt[31];
#pragma unroll
    for (int j = 0; j < 31; ++j) wt[j] = cw[j * 512 + tid];
    const float bias = cb[tid];
    float lgv[8], lbv[8];
#pragma unroll
    for (int i = 0; i < 8; ++i) { lgv[i] = lg[lane + 64 * i]; lbv[i] = lb[lane + 64 * i]; }
    for (int tile = blockIdx.x; tile < 768; tile += gridDim.x) {
        const int seq = tile >> 8, t0 = (tile & 255) * 64;
        __syncthreads();
#pragma unroll 1
        for (int ib = 0; ib < 3; ++ib) {
            u32x4 x1[4], x2[4];
#pragma unroll
            for (int k = 0; k < 4; ++k) {
                const int idx = tid + 512 * (4 * ib + k); const int r = idx >> 6, cc = idx & 63, t = t0 - 15 + r;
                x1[k] = (u32x4){0u, 0u, 0u, 0u}; x2[k] = x1[k];
                if (idx < 94 * 64 && t >= 0 && t < L) { const bf16_t* rp = pa + (size_t)(seq * L + t) * 1024 + cc * 8; x1[k] = *(const u32x4*)rp; x2[k] = *(const u32x4*)(rp + 512); }
            }
#pragma unroll
            for (int k = 0; k < 4; ++k) {
                const int idx = tid + 512 * (4 * ib + k); const int r = idx >> 6, cc = idx & 63;
                u32x4 res;
#pragma unroll
                for (int q = 0; q < 4; ++q) res[q] = pk_bf16(bf_lo(x1[k][q]) * fsigmoid(bf_lo(x2[k][q])), bf_hi(x1[k][q]) * fsigmoid(bf_hi(x2[k][q])));
                if (idx < 94 * 64) *(LAS u32x4*)(glu + r * 512 + cc * 8) = res;
            }
        }
        __syncthreads();
        for (int chunk = 0; chunk < 8; ++chunk) {
            float o[8];
#pragma unroll
            for (int tt = 0; tt < 8; ++tt) o[tt] = bias;
#pragma unroll
            for (int i = 0; i < 38; ++i) {
                const float x = bf2f(glu[(chunk * 8 + i) * 512 + tid]);
#pragma unroll
                for (int tt = 0; tt < 8; ++tt) { const int j = i - tt; if (j >= 0 && j < 31) o[tt] += wt[j] * x; }
            }
#pragma unroll
            for (int tt = 0; tt < 8; ++tt) stage[tt * 512 + tid] = o[tt];
            __syncthreads();
            {
                float v[8]; float s = 0.f;
#pragma unroll
                for (int i = 0; i < 8; ++i) { v[i] = stage[w * 512 + lane + 64 * i]; s += v[i]; }
#pragma unroll
                for (int of = 32; of > 0; of >>= 1) s += __shfl_xor(s, of);
                const float mean = s * (1.0f / 512.0f);
                float q = 0.f;
#pragma unroll
                for (int i = 0; i < 8; ++i) { const float d = v[i] - mean; q += d * d; }
#pragma unroll
                for (int of = 32; of > 0; of >>= 1) q += __shfl_xor(q, of);
                const float rstd = rsqrtf(q * (1.0f / 512.0f) + EPS);
                bf16_t* op = cat + (size_t)(seq * L + t0 + chunk * 8 + w) * 1024;
#pragma unroll
                for (int i = 0; i < 8; ++i) { const float y = (v[i] - mean) * rstd * lgv[i] + lbv[i]; op[lane + 64 * i] = f2bf(y * fsigmoid(y)); }
            }
            __syncthreads();
        }
    }
    __syncthreads();
}

typedef float v2 __attribute__((ext_vector_type(2)));
__device__ __forceinline__ int fphys(int i) { return i + ((i >> 6) << 2); }
struct C2 { v2 r, i; };
__device__ __forceinline__ C2 cmul2(const C2& a, const C2& b) { C2 o; o.r = a.r * b.r - a.i * b.i; o.i = a.r * b.i + a.i * b.r; return o; }
__device__ __forceinline__ C2 cmulc(const C2& a, float cr, float ci) { C2 o; o.r = a.r * cr - a.i * ci; o.i = a.r * ci + a.i * cr; return o; }
template <bool INV> __device__ __forceinline__ void bf4(C2& a, C2& b, C2& c, C2& d) {
    C2 t0, t1, t2, e, t3;
    t0.r = a.r + c.r; t0.i = a.i + c.i; t1.r = a.r - c.r; t1.i = a.i - c.i; t2.r = b.r + d.r; t2.i = b.i + d.i; e.r = b.r - d.r; e.i = b.i - d.i;
    if (INV) { t3.r = -e.i; t3.i = e.r; } else { t3.r = e.i; t3.i = -e.r; }
    a.r = t0.r + t2.r; a.i = t0.i + t2.i; b.r = t1.r + t3.r; b.i = t1.i + t3.i; c.r = t0.r - t2.r; c.i = t0.i - t2.i; d.r = t1.r - t3.r; d.i = t1.i - t3.i;
}
template <bool INV, int K16> __device__ __forceinline__ C2 mulc16(const C2& a) {
    constexpr float cs[10] = {1.0f, 0.92387953251128674f, 0.70710678118654752f, 0.38268343236508977f, 0.0f, -0.38268343236508977f, -0.70710678118654752f, -0.92387953251128674f, -1.0f, -0.92387953251128674f};
    constexpr float sn[10] = {0.0f, 0.38268343236508977f, 0.70710678118654752f, 0.92387953251128674f, 1.0f, 0.92387953251128674f, 0.70710678118654752f, 0.38268343236508977f, 0.0f, -0.38268343236508977f};
    if (K16 == 4) { C2 o; if (INV) { o.r = -a.i; o.i = a.r; } else { o.r = a.i; o.i = -a.r; } return o; }
    return cmulc(a, cs[K16], INV ? sn[K16] : -sn[K16]);
}
template <bool INV, int LOGQ> __device__ __forceinline__ void r16_pass(LAS float* Fre, LAS float* Fim, int tid) {
    constexpr int Q = 1 << LOGQ;
    constexpr int PSTR = (Q >= 64) ? (Q + (Q >> 4)) : Q;
    const int b0 = 2 * tid, pos0 = b0 & (Q - 1), grp = b0 >> LOGQ, base = (grp << (LOGQ + 4)) + pos0;
    const int p = fphys(base);
    C2 x[16];
#pragma unroll
    for (int r = 0; r < 16; ++r) { x[r].r = *(const LAS v2*)(Fre + p + r * PSTR); x[r].i = *(const LAS v2*)(Fim + p + r * PSTR); }
    int posv = pos0; asm volatile("" : "+v"(posv));
    const float rev0 = (float)posv * (1.0f / (float)(16 * Q)), rev1 = (float)(posv + 1) * (1.0f / (float)(16 * Q));
    C2 w1; w1.r = (v2){__builtin_amdgcn_cosf(rev0), __builtin_amdgcn_cosf(rev1)};
    { const v2 sn = (v2){__builtin_amdgcn_sinf(rev0), __builtin_amdgcn_sinf(rev1)}; w1.i = INV ? sn : -sn; }
    const C2 w2 = cmul2(w1, w1), w3 = cmul2(w2, w1), w4 = cmul2(w2, w2), w8 = cmul2(w4, w4), w12 = cmul2(w8, w4);
    if (!INV) {
#pragma unroll
        for (int j = 0; j < 4; ++j) {
            bf4<false>(x[j], x[j + 4], x[j + 8], x[j + 12]);
            x[j + 4] = cmul2(x[j + 4], w1); x[j + 8] = cmul2(x[j + 8], w2); x[j + 12] = cmul2(x[j + 12], w3);
        }
        x[5] = mulc16<false, 1>(x[5]); x[9] = mulc16<false, 2>(x[9]); x[13] = mulc16<false, 3>(x[13]);
        x[6] = mulc16<false, 2>(x[6]); x[10] = mulc16<false, 4>(x[10]); x[14] = mulc16<false, 6>(x[14]);
        x[7] = mulc16<false, 3>(x[7]); x[11] = mulc16<false, 6>(x[11]); x[15] = mulc16<false, 9>(x[15]);
#pragma unroll
        for (int r = 0; r < 4; ++r) {
            bf4<false>(x[4 * r], x[4 * r + 1], x[4 * r + 2], x[4 * r + 3]);
            x[4 * r + 1] = cmul2(x[4 * r + 1], w4); x[4 * r + 2] = cmul2(x[4 * r + 2], w8); x[4 * r + 3] = cmul2(x[4 * r + 3], w12);
        }
    } else {
#pragma unroll
        for (int r = 0; r < 4; ++r) {
            x[4 * r + 1] = cmul2(x[4 * r + 1], w4); x[4 * r + 2] = cmul2(x[4 * r + 2], w8); x[4 * r + 3] = cmul2(x[4 * r + 3], w12);
            bf4<true>(x[4 * r], x[4 * r + 1], x[4 * r + 2], x[4 * r + 3]);
        }
        x[5] = mulc16<true, 1>(x[5]); x[9] = mulc16<true, 2>(x[9]); x[13] = mulc16<true, 3>(x[13]);
        x[6] = mulc16<true, 2>(x[6]); x[10] = mulc16<true, 4>(x[10]); x[14] = mulc16<true, 6>(x[14]);
        x[7] = mulc16<true, 3>(x[7]); x[11] = mulc16<true, 6>(x[11]); x[15] = mulc16<true, 9>(x[15]);
#pragma unroll
        for (int j = 0; j < 4; ++j) {
            x[j + 4] = cmul2(x[j + 4], w1); x[j + 8] = cmul2(x[j + 8], w2); x[j + 12] = cmul2(x[j + 12], w3);
            bf4<true>(x[j], x[j + 4], x[j + 8], x[j + 12]);
        }
    }
#pragma unroll
    for (int r = 0; r < 16; ++r) { *(LAS v2*)(Fre + p + r * PSTR) = x[r].r; *(LAS v2*)(Fim + p + r * PSTR) = x[r].i; }
}
template <bool INV> __device__ __forceinline__ void r4_pass(LAS float* Fre, LAS float* Fim, int tid) {
#pragma unroll 2
    for (int bi = 0; bi < 4; ++bi) {
        const int p = fphys(8 * (tid + 512 * bi));
        const f32x4 ra = *(const LAS f32x4*)(Fre + p), rb = *(const LAS f32x4*)(Fre + p + 4), ia = *(const LAS f32x4*)(Fim + p), ib = *(const LAS f32x4*)(Fim + p + 4);
        C2 x0, x1, x2, x3;
        x0.r = (v2){ra[0], rb[0]}; x1.r = (v2){ra[1], rb[1]}; x2.r = (v2){ra[2], rb[2]}; x3.r = (v2){ra[3], rb[3]};
        x0.i = (v2){ia[0], ib[0]}; x1.i = (v2){ia[1], ib[1]}; x2.i = (v2){ia[2], ib[2]}; x3.i = (v2){ia[3], ib[3]};
        bf4<INV>(x0, x1, x2, x3);
        *(LAS f32x4*)(Fre + p) = (f32x4){x0.r[0], x1.r[0], x2.r[0], x3.r[0]}; *(LAS f32x4*)(Fre + p + 4) = (f32x4){x0.r[1], x1.r[1], x2.r[1], x3.r[1]};
        *(LAS f32x4*)(Fim + p) = (f32x4){x0.i[0], x1.i[0], x2.i[0], x3.i[0]}; *(LAS f32x4*)(Fim + p + 4) = (f32x4){x0.i[1], x1.i[1], x2.i[1], x3.i[1]};
    }
}
__device__ __forceinline__ void fft_fwd(LAS float* Fre, LAS float* Fim, int tid) {
    r16_pass<false, 10>(Fre, Fim, tid); __syncthreads(); r16_pass<false, 6>(Fre, Fim, tid); __syncthreads(); r16_pass<false, 2>(Fre, Fim, tid); __syncthreads(); r4_pass<false>(Fre, Fim, tid);
}
__device__ __forceinline__ void fft_inv(LAS float* Fre, LAS float* Fim, int tid) {
    r4_pass<true>(Fre, Fim, tid); __syncthreads(); r16_pass<true, 2>(Fre, Fim, tid); __syncthreads(); r16_pass<true, 6>(Fre, Fim, tid); __syncthreads(); r16_pass<true, 10>(Fre, Fim, tid);
}
typedef _Float16 h8v __attribute__((ext_vector_type(8)));
__device__ __forceinline__ void sconv8(const bf16_t* row, int n0, float w0, float w1, float w2, float b, float (&out)[8]) {
    const u32x4 q = *(const u32x4*)(row + n0);
    float x[10];
    x[0] = n0 > 0 ? bf2f(row[n0 - 1]) : 0.f;
    x[9] = n0 + 8 < L ? bf2f(row[n0 + 8]) : 0.f;
#pragma unroll
    for (int i = 0; i < 4; ++i) { x[1 + 2 * i] = bf_lo(q[i]); x[2 + 2 * i] = bf_hi(q[i]); }
#pragma unroll
    for (int e = 0; e < 8; ++e) out[e] = b + w0 * x[e] + w1 * x[e + 1] + w2 * x[e + 2];
}
struct Raw8 { u32x4 q; unsigned short lo, hi; };
__device__ __forceinline__ Raw8 raw8_load(const bf16_t* row, int n0) {
    Raw8 r; r.q = *(const u32x4*)(row + n0);
    r.lo = n0 > 0 ? row[n0 - 1] : (unsigned short)0; r.hi = n0 + 8 < L ? row[n0 + 8] : (unsigned short)0;
    return r;
}
__device__ __forceinline__ void sconv8_raw(const Raw8& r, float w0, float w1, float w2, float b, float (&out)[8]) {
    float x[10];
    x[0] = bf2f(r.lo); x[9] = bf2f(r.hi);
#pragma unroll
    for (int i = 0; i < 4; ++i) { x[1 + 2 * i] = bf_lo(r.q[i]); x[2 + 2 * i] = bf_hi(r.q[i]); }
#pragma unroll
    for (int e = 0; e < 8; ++e) out[e] = b + w0 * x[e] + w1 * x[e + 1] + w2 * x[e + 2];
}
template <bool CONJ> __device__ __forceinline__ void tw8(int n0, float (&tr)[8], float (&ti)[8]) {
    const float rev = (float)n0 * (1.0f / (float)(2 * L));
    const float sr = 0.99999998161642933f, si = CONJ ? 1.9174759731070330e-4f : -1.9174759731070330e-4f;
    tr[0] = __builtin_amdgcn_cosf(rev); ti[0] = CONJ ? __builtin_amdgcn_sinf(rev) : -__builtin_amdgcn_sinf(rev);
#pragma unroll
    for (int e = 1; e < 8; ++e) { tr[e] = tr[e - 1] * sr - ti[e - 1] * si; ti[e] = tr[e - 1] * si + ti[e - 1] * sr; }
}
__device__ __forceinline__ void st8(LAS float* p, const float (&v)[8]) { *(LAS f32x4*)p = (f32x4){v[0], v[1], v[2], v[3]}; *(LAS f32x4*)(p + 4) = (f32x4){v[4], v[5], v[6], v[7]}; }
__device__ __forceinline__ void ld8(const LAS float* p, float (&v)[8]) { const f32x4 a = *(const LAS f32x4*)p, b = *(const LAS f32x4*)(p + 4);
#pragma unroll
    for (int e = 0; e < 4; ++e) { v[e] = a[e]; v[4 + e] = b[e]; } }
template <bool DRY> __device__ void fft_phase(const Args& a, bf16_t* pbT, LAS unsigned char* lds) {
    const int tid = opaque_tid(), lane = tid & 63, w = tid >> 6;
    LAS float* Fre = (LAS float*)lds; LAS float* Fim = Fre + 17408;
    LAS float* red = (LAS float*)(lds + 17408 * 8);
    const int po = fphys(8 * tid);
    const half_t* KT = (const half_t*)(a.ws + WS_KT);
    unsigned char* scr = a.ws + WS_ACT + PBT_BYTES + (size_t)blockIdx.x * FFTSCR_PER_BLOCK;
    float* ybuf = (float*)scr;
    float* z1buf = (float*)(scr + 2ull * L * 8);
    const float* sw = a.in[15]; const float* sb = a.in[16]; const float* skip = a.in[23];
    for (int ch = blockIdx.x; ch < 512; ch += gridDim.x) {
        const float vw0 = sw[ch], vw1 = sw[1536 + ch], vw2 = sw[3072 + ch], vb = sb[ch];
#pragma unroll 1
        for (int o = 0; o < 2; ++o) {
            const half_t* kf = KT + ((size_t)((o * 512 + ch) * 2) << 14); const half_t* kb = kf + L;
            const int xc = (o == 0 ? 512 : 1024) + ch;
            const float gw0 = sw[xc], gw1 = sw[1536 + xc], gw2 = sw[3072 + xc], gb = sb[xc];
            const float skp = skip[o * 512 + ch];
            float ss = 0.f;
#pragma unroll 1
            for (int g = 0; g < 4; ++g) {
                const int n0 = 8 * (tid + 512 * g);
                const h8v f = *(const h8v*)(kf + n0), bk = *(const h8v*)(kb + n0);
#pragma unroll
                for (int e = 0; e < 8; ++e) { const float ff = (float)f[e], bb = (n0 + e > 0) ? (float)bk[e] : 0.f; ss += ff * ff + bb * bb; }
            }
#pragma unroll
            for (int of = 32; of > 0; of >>= 1) ss += __shfl_xor(ss, of);
            __syncthreads();
            if (lane == 0) red[w] = ss;
            __syncthreads();
            float tot = 0.f;
#pragma unroll
            for (int ww = 0; ww < 8; ++ww) tot += red[ww];
            const float kscale = rsqrtf(tot + EPS) * (0.5f / (float)L);
#pragma unroll 1
            for (int br = 0; br < 2; ++br) {
                __syncthreads();
#pragma unroll 1
                for (int g = 0; g < 4; ++g) {
                    const int n0 = 8 * (tid + 512 * g);
                    const h8v f = *(const h8v*)(kf + n0), bc = *(const h8v*)(kb + (L - 8 - n0));
                    const float b0 = n0 > 0 ? (float)kb[L - n0] : 0.f;
                    float d[8], vr[8], vi[8];
#pragma unroll
                    for (int e = 0; e < 8; ++e) { const float bk = (e == 0) ? b0 : (float)bc[8 - e]; d[e] = (br == 0 ? (float)f[e] + bk : (float)f[e] - bk) * kscale; }
                    if (br == 0) {
#pragma unroll
                        for (int e = 0; e < 8; ++e) { vr[e] = d[e]; vi[e] = 0.f; }
                    } else {
                        float tr[8], ti[8]; tw8<false>(n0, tr, ti);
#pragma unroll
                        for (int e = 0; e < 8; ++e) { vr[e] = d[e] * tr[e]; vi[e] = d[e] * ti[e]; }
                    }
                    st8(Fre + po + 4352 * g, vr); st8(Fim + po + 4352 * g, vi);
                }
                __syncthreads();
                fft_fwd(Fre, Fim, tid);
                __syncthreads();
                float KrR[32], KrI[32];
#pragma unroll
                for (int g = 0; g < 4; ++g) {
                    const f32x4 r0 = *(const LAS f32x4*)(Fre + po + 4352 * g), r1 = *(const LAS f32x4*)(Fre + po + 4352 * g + 4), i0 = *(const LAS f32x4*)(Fim + po + 4352 * g), i1 = *(const LAS f32x4*)(Fim + po + 4352 * g + 4);
#pragma unroll
                    for (int e = 0; e < 4; ++e) { KrR[g * 8 + e] = r0[e]; KrR[g * 8 + 4 + e] = r1[e]; KrI[g * 8 + e] = i0[e]; KrI[g * 8 + 4 + e] = i1[e]; }
                }
#pragma unroll 1
                for (int pk = 0; pk < 2; ++pk) {
                    __syncthreads();
#pragma unroll 1
                    for (int g = 0; g < 4; ++g) {
                        const int n0 = 8 * (tid + 512 * g);
                        float re[8], im[8];
                        if (o == 0) {
                            sconv8(pbT + ((size_t)((2 * pk) * 1536 + ch) << 14), n0, vw0, vw1, vw2, vb, re);
                            if (pk == 0) sconv8(pbT + ((size_t)(1536 + ch) << 14), n0, vw0, vw1, vw2, vb, im);
                        } else {
                            const f32x4 r0 = *(const f32x4*)(z1buf + (2 * pk) * L + n0), r1 = *(const f32x4*)(z1buf + (2 * pk) * L + n0 + 4);
#pragma unroll
                            for (int e = 0; e < 4; ++e) { re[e] = r0[e]; re[4 + e] = r1[e]; }
                            if (pk == 0) { const f32x4 i0 = *(const f32x4*)(z1buf + L + n0), i1 = *(const f32x4*)(z1buf + L + n0 + 4);
#pragma unroll
                                for (int e = 0; e < 4; ++e) { im[e] = i0[e]; im[4 + e] = i1[e]; } }
                        }
                        if (pk == 1) {
#pragma unroll
                            for (int e = 0; e < 8; ++e) im[e] = 0.f;
                        }
                        if (br == 1) {
                            float tr[8], ti[8]; tw8<false>(n0, tr, ti);
#pragma unroll
                            for (int e = 0; e < 8; ++e) { const float xr = re[e] * tr[e] - im[e] * ti[e], xi = re[e] * ti[e] + im[e] * tr[e]; re[e] = xr; im[e] = xi; }
                        }
                        st8(Fre + po + 4352 * g, re); st8(Fim + po + 4352 * g, im);
                    }
                    __syncthreads();
                    fft_fwd(Fre, Fim, tid);
                    __syncthreads();
#pragma unroll
                    for (int g = 0; g < 4; ++g) {
                        float xr[8], xi[8], yr[8], yi[8];
                        ld8(Fre + po + 4352 * g, xr); ld8(Fim + po + 4352 * g, xi);
#pragma unroll
                        for (int e = 0; e < 8; ++e) { yr[e] = xr[e] * KrR[g * 8 + e] - xi[e] * KrI[g * 8 + e]; yi[e] = xr[e] * KrI[g * 8 + e] + xi[e] * KrR[g * 8 + e]; }
                        st8(Fre + po + 4352 * g, yr); st8(Fim + po + 4352 * g, yi);
                    }
                    __syncthreads();
                    fft_inv(Fre, Fim, tid);
                    __syncthreads();
#pragma unroll 1
                    for (int g = 0; g < 4; ++g) {
                        const int n0 = 8 * (tid + 512 * g);
                        float rr[8], ri[8];
                        ld8(Fre + po + 4352 * g, rr); ld8(Fim + po + 4352 * g, ri);
                        float* ybr = ybuf + (size_t)pk * 2 * L + n0; float* ybi = ybr + L;
                        if (br == 0) {
                            *(f32x4*)ybr = (f32x4){rr[0], rr[1], rr[2], rr[3]}; *(f32x4*)(ybr + 4) = (f32x4){rr[4], rr[5], rr[6], rr[7]};
                            *(f32x4*)ybi = (f32x4){ri[0], ri[1], ri[2], ri[3]}; *(f32x4*)(ybi + 4) = (f32x4){ri[4], ri[5], ri[6], ri[7]};
                        } else {
                            const f32x4 yr0 = *(const f32x4*)ybr, yr1 = *(const f32x4*)(ybr + 4), yi0 = *(const f32x4*)ybi, yi1 = *(const f32x4*)(ybi + 4);
                            const int s0 = 2 * pk;
                            Raw8 gt0 = raw8_load(pbT + ((size_t)(s0 * 1536 + xc) << 14), n0), gt1 = gt0, vt0 = gt0, vt1 = gt0;
                            f32x4 za0 = yr0, za1 = yr0, zb0 = yr0, zb1 = yr0;
                            if (pk == 0) gt1 = raw8_load(pbT + ((size_t)(1536 + xc) << 14), n0);
                            if (o == 0) { vt0 = raw8_load(pbT + ((size_t)(s0 * 1536 + ch) << 14), n0); if (pk == 0) vt1 = raw8_load(pbT + ((size_t)(1536 + ch) << 14), n0); }
                            else { za0 = *(const f32x4*)(z1buf + s0 * L + n0); za1 = *(const f32x4*)(z1buf + s0 * L + n0 + 4); if (pk == 0) { zb0 = *(const f32x4*)(z1buf + L + n0); zb1 = *(const f32x4*)(z1buf + L + n0 + 4); } }
                            float tr[8], ti[8]; tw8<true>(n0, tr, ti);
                            float yre[8], yim[8];
#pragma unroll
                            for (int e = 0; e < 8; ++e) {
                                yre[e] = (e < 4 ? yr0[e & 3] : yr1[e & 3]) + rr[e] * tr[e] - ri[e] * ti[e];
                                yim[e] = (e < 4 ? yi0[e & 3] : yi1[e & 3]) + rr[e] * ti[e] + ri[e] * tr[e];
                            }
                            const int nseq = (pk == 0) ? 2 : 1;
#pragma unroll
                            for (int q = 0; q < 2; ++q) if (q < nseq) {
                                const int s = 2 * pk + q;
                                float gate[8];
                                sconv8_raw(q == 0 ? gt0 : gt1, gw0, gw1, gw2, gb, gate);
                                float* zp = z1buf + s * L + n0;
                                float z[8];
                                if (o == 0) {
                                    float vv[8];
                                    sconv8_raw(q == 0 ? vt0 : vt1, vw0, vw1, vw2, vb, vv);
#pragma unroll
                                    for (int e = 0; e < 8; ++e) z[e] = gate[e] * ((q == 0 ? yre[e] : yim[e]) + vv[e] * skp);
                                    *(f32x4*)zp = (f32x4){z[0], z[1], z[2], z[3]}; *(f32x4*)(zp + 4) = (f32x4){z[4], z[5], z[6], z[7]};
                                } else {
                                    const f32x4 z0 = q == 0 ? za0 : zb0, z1 = q == 0 ? za1 : zb1;
#pragma unroll
                                    for (int e = 0; e < 8; ++e) z[e] = gate[e] * ((q == 0 ? yre[e] : yim[e]) + (e < 4 ? z0[e & 3] : z1[e & 3]) * skp);
                                    u32x4 wv; wv.x = pk_bf16(z[0], z[1]); wv.y = pk_bf16(z[2], z[3]); wv.z = pk_bf16(z[4], z[5]); wv.w = pk_bf16(z[6], z[7]);
                                    if (!DRY) *(u32x4*)(pbT + ((size_t)(s * 1536 + ch) << 14) + n0) = wv;
                                }
                            }
                        }
                    }
                }
            }
            __syncthreads();
        }
    }
    __syncthreads();
}

__device__ void ztrans_phase(const bf16_t* pbT, bf16_t* cat, LAS unsigned char* lds) {
    const int tid = opaque_tid();
    LAS unsigned* tl = (LAS unsigned*)lds;
    LAS bf16_t* tb = (LAS bf16_t*)lds;
    for (int tile0 = blockIdx.x * 2; tile0 < 6144; tile0 += gridDim.x * 2) {
        __syncthreads();
        u32x4 v[2];
#pragma unroll
        for (int k = 0; k < 2; ++k) { const int tile = tile0 + k; const int tt0 = (tile & 255) * 64, ct = (tile >> 8) & 7, s = tile >> 11; const int cc = tid >> 3, tk = (tid & 7) * 8;
            v[k] = *(const u32x4*)(pbT + ((size_t)(s * 1536 + ct * 64 + cc) << 14) + tt0 + tk); }
#pragma unroll
        for (int k = 0; k < 2; ++k) { const int cc = tid >> 3, tk = (tid & 7) * 8;
#pragma unroll
            for (int q = 0; q < 4; ++q) tl[k * 2112 + cc * 33 + (tk >> 1) + q] = v[k][q]; }
        __syncthreads();
#pragma unroll
        for (int k = 0; k < 2; ++k) { const int tile = tile0 + k; const int tt0 = (tile & 255) * 64, ct = (tile >> 8) & 7, s = tile >> 11;
            const int tt = tid >> 3, cg8 = (tid & 7) * 8; bf16_t e[8];
#pragma unroll
            for (int i = 0; i < 8; ++i) e[i] = tb[k * 4224 + (cg8 + i) * 66 + tt];
            u32x4 wv; wv.x = e[0] | ((unsigned)e[1] << 16); wv.y = e[2] | ((unsigned)e[3] << 16); wv.z = e[4] | ((unsigned)e[5] << 16); wv.w = e[6] | ((unsigned)e[7] << 16);
            *(u32x4*)(cat + (size_t)(s * L + tt0 + tt) * 1024 + 512 + ct * 64 + cg8) = wv; }
    }
    __syncthreads();
}

typedef unsigned u2v __attribute__((ext_vector_type(2)));
__device__ __forceinline__ u2v xchg32(float x) { const unsigned xi = __float_as_uint(x); return __builtin_amdgcn_permlane32_swap(xi, xi, false, false); }
__device__ void attn_phase(const Args& a, const bf16_t* qkv, bf16_t* ao, LAS unsigned char* lds) {
    const int tid = opaque_tid(), lane = tid & 63, w = tid >> 6, l31 = lane & 31, hh = lane >> 5;
    LAS bf16_t* Ks = (LAS bf16_t*)lds;
    LAS bf16_t* VT = (LAS bf16_t*)(lds + 384 * 72 * 2);
    const float* sink = a.in[26];
    for (int item = blockIdx.x; item < 1536; item += gridDim.x) {
        const int kvh = item & 3, qb = (item >> 2) & 127, seq = item >> 9;
        const int kb0 = qb * 128 - 128;
        __syncthreads();
#pragma unroll 1
        for (int ib = 0; ib < 2; ++ib) {
            u32x4 kv[3], vv[3];
#pragma unroll
            for (int k = 0; k < 3; ++k) {
                const int idx = tid + 512 * (3 * ib + k); const int key = idx % 384, dc = idx / 384, kpos = kb0 + key;
                kv[k] = (u32x4){0u, 0u, 0u, 0u}; vv[k] = kv[k];
                if (kpos >= 0 && kpos < L) { const bf16_t* rp = qkv + (size_t)(seq * L + kpos) * 1536 + kvh * 64 + dc * 8; kv[k] = *(const u32x4*)(rp + 1024); vv[k] = *(const u32x4*)(rp + 1280); }
            }
#pragma unroll
            for (int k = 0; k < 3; ++k) {
                const int idx = tid + 512 * (3 * ib + k); const int key = idx % 384, dc = idx / 384;
                *(LAS u32x4*)(Ks + key * 72 + dc * 8) = kv[k];
#pragma unroll
                for (int i = 0; i < 8; ++i) VT[(dc * 8 + i) * 392 + key] = (bf16_t)((vv[k][i >> 1] >> (16 * (i & 1))) & 0xffffu);
            }
        }
        __syncthreads();
        for (int uu = 0; uu < 2; ++uu) {
            const int u = w + 8 * uu, g = u >> 2, qs = u & 3, h = kvh * 4 + g, q0 = qb * 128 + 32 * qs;
            bf16x8 qf[4];
            const bf16_t* qp = qkv + (size_t)(seq * L + q0 + l31) * 1536 + h * 64 + 8 * hh;
#pragma unroll
            for (int ks = 0; ks < 4; ++ks) qf[ks] = *(const bf16x8*)(qp + 16 * ks);
            const float LOG2E = 1.4426950408889634f;
            const float c1 = 0.125f * LOG2E, slope2 = exp2f(-0.5f * (float)(h + 1)) * LOG2E;
            float m = sink[h] * LOG2E, lsum = 1.0f;
            const bool edge = (qb == 0) || (qb == 127);
            f32x16 O0, O1;
#pragma unroll
            for (int r = 0; r < 16; ++r) { O0[r] = 0.f; O1[r] = 0.f; }
#pragma unroll 1
            for (int kt = 0; kt < 9; ++kt) {
                const int kl0 = 32 * qs + 32 * kt;
                f32x16 S;
#pragma unroll
                for (int r = 0; r < 16; ++r) S[r] = 0.f;
#pragma unroll
                for (int ks = 0; ks < 4; ++ks) { const bf16x8 af = *(const LAS bf16x8*)(Ks + (kl0 + l31) * 72 + 16 * ks + 8 * hh); S = __builtin_amdgcn_mfma_f32_32x32x16_bf16(af, qf[ks], S, 0, 0, 0); }
                float p[16]; float mt = -1e30f;
                const float dbase = (float)(32 * kt - 128 + 4 * hh - l31);
                if (kt == 0 || kt == 8 || edge) {
#pragma unroll
                    for (int r = 0; r < 16; ++r) {
                        const int i = 8 * (r >> 2) + 4 * hh + (r & 3);
                        const int kpos = q0 - 128 + 32 * kt + i;
                        const float ad = __builtin_fabsf(dbase + (float)(8 * (r >> 2) + (r & 3)));
                        const bool valid = (ad <= 128.0f) && (kpos >= 0) && (kpos < L);
                        p[r] = valid ? (S[r] * c1 - slope2 * ad) : -1e30f;
                        mt = fmaxf(mt, p[r]);
                    }
                } else {
#pragma unroll
                    for (int r = 0; r < 16; ++r) {
                        const float ad = __builtin_fabsf(dbase + (float)(8 * (r >> 2) + (r & 3)));
                        p[r] = S[r] * c1 - slope2 * ad;
                        mt = fmaxf(mt, p[r]);
                    }
                }
                { const u2v e = xchg32(mt); mt = fmaxf(__uint_as_float(e.x), __uint_as_float(e.y)); }
                const float mnew = (mt > m + 6.0f) ? mt : m;
                if (__builtin_amdgcn_ballot_w64(mnew != m) != 0ull) {
                    const float alpha = __builtin_amdgcn_exp2f(m - mnew);
                    lsum *= alpha;
#pragma unroll
                    for (int r = 0; r < 16; ++r) { O0[r] *= alpha; O1[r] *= alpha; }
                    m = mnew;
                }
                float rs = 0.f;
#pragma unroll
                for (int r = 0; r < 16; ++r) { p[r] = __builtin_amdgcn_exp2f(p[r] - m); rs += p[r]; }
                { const u2v e = xchg32(rs); rs = __uint_as_float(e.x) + __uint_as_float(e.y); }
                lsum += rs;
#pragma unroll
                for (int kk = 0; kk < 2; ++kk) {
                    u32x4 pw; pw.x = pk_bf16(p[8 * kk], p[8 * kk + 1]); pw.y = pk_bf16(p[8 * kk + 2], p[8 * kk + 3]); pw.z = pk_bf16(p[8 * kk + 4], p[8 * kk + 5]); pw.w = pk_bf16(p[8 * kk + 6], p[8 * kk + 7]);
                    const bf16x8 pf = __builtin_bit_cast(bf16x8, pw);
#pragma unroll
                    for (int dt = 0; dt < 2; ++dt) {
                        const LAS bf16_t* vp = VT + (32 * dt + l31) * 392 + kl0 + 16 * kk + 4 * hh;
                        const u32x2 lo = *(const LAS u32x2*)vp, hi = *(const LAS u32x2*)(vp + 8);
                        const bf16x8 vf = __builtin_bit_cast(bf16x8, (u32x4){lo.x, lo.y, hi.x, hi.y});
                        if (dt == 0) O0 = __builtin_amdgcn_mfma_f32_32x32x16_bf16(vf, pf, O0, 0, 0, 0);
                        else O1 = __builtin_amdgcn_mfma_f32_32x32x16_bf16(vf, pf, O1, 0, 0, 0);
                    }
                }
            }
            const float inv = 1.0f / lsum;
            unsigned char* rowb = (unsigned char*)(ao + (size_t)(seq * L + q0 + l31) * 1024 + h * 64) + (hh ? 16 : 0);
#pragma unroll
            for (int k = 0; k < 8; k += 2) {
                u32x2 pa, pb;
                if (k < 4) { pa.x = pk_bf16(O0[4 * k] * inv, O0[4 * k + 1] * inv); pa.y = pk_bf16(O0[4 * k + 2] * inv, O0[4 * k + 3] * inv);
                             pb.x = pk_bf16(O0[4 * k + 4] * inv, O0[4 * k + 5] * inv); pb.y = pk_bf16(O0[4 * k + 6] * inv, O0[4 * k + 7] * inv); }
                else { pa.x = pk_bf16(O1[4 * (k - 4)] * inv, O1[4 * (k - 4) + 1] * inv); pa.y = pk_bf16(O1[4 * (k - 4) + 2] * inv, O1[4 * (k - 4) + 3] * inv);
                       pb.x = pk_bf16(O1[4 * (k - 4) + 4] * inv, O1[4 * (k - 4) + 5] * inv); pb.y = pk_bf16(O1[4 * (k - 4) + 6] * inv, O1[4 * (k - 4) + 7] * inv); }
                const u2v rx = __builtin_amdgcn_permlane32_swap(pa.x, pb.x, false, false), ry = __builtin_amdgcn_permlane32_swap(pa.y, pb.y, false, false);
                *(u32x4*)(rowb + 16 * k) = (u32x4){rx.x, ry.x, rx.y, ry.y};
            }
        }
    }
    __syncthreads();
}

__global__ void __launch_bounds__(512, 2) mega(Args a) {
    extern __shared__ __attribute__((aligned(16))) unsigned char lds_raw[];
    LAS unsigned char* lds = (LAS unsigned char*)lds_raw;
    unsigned char* ws = a.ws;
    const int lo = a.ph_lo, hi = a.ph_hi;
    bf16_t* XB = (bf16_t*)(ws + WS_H);
    const float* mod = (const float*)(ws + WS_MOD);
    bf16_t* H = (bf16_t*)a.out;
    bf16_t* ACT = (bf16_t*)(ws + WS_ACT);
    bf16_t* PBT = ACT;
    bf16_t* PA = (bf16_t*)(ws + WS_ACT + PBT_BYTES);
    const int G = gridDim.x, bx = blockIdx.x;
    volatile LAS unsigned* bst = (volatile LAS unsigned*)(lds + LDS_BYTES - 16);
    if (threadIdx.x < 4) bst[threadIdx.x] = 0u;
    __syncthreads();
    const XcdBarrier xbar = xcd_barrier_post((unsigned*)(ws + WS_BAR), bst);
#define GSYNC() xcd_barrier(xbar)
#define IN(k) (lo <= (k) && (k) < hi)
#define SEAM(k) do { if (IN(k) && IN((k) + 1)) { GSYNC(); if ((RM >> 15) & 1) GSYNC(); } } while (0)
    int ph = 0;
    if (IN(0)) REP(0) { if (EN(0)) convert_weights(a, (LAS float*)lds); if (EN(1)) ada_phase(a, (LAS float*)lds); if (EN(2)) filter_phase(a, (LAS float*)lds); }
    if (IN(0) && IN(1)) cg::this_grid().sync();
    ph = 1;
#pragma unroll 1
    for (int layer = 0; layer < 2; ++layer) {
        const float* ml = mod + (size_t)layer * 3 * 9216;
        const float* ng = a.in[6] + layer * 3 * 1024;
#pragma unroll 1
        for (int sub = 0; sub < 3; ++sub) {
            const bool first = (layer == 0 && sub == 0);
            const float* xs0 = a.in[0]; const float* xs1 = a.in[1];
            const float* shp = ml + (3 * sub) * 1024; const float* scp = shp + 1024; const float* gp = shp + 2048;
            if (EN(3) && IN(ph)) REP(3) { if (first) norm_phase<true>(xs0, xs1, XB, ng + sub * 1024, shp, scp, H); else norm_phase<false>(xs0, xs1, XB, ng + sub * 1024, shp, scp, H); }
            SEAM(ph); ++ph;
            if (sub != 1) {
                const int fi = layer * 2 + (sub == 2 ? 1 : 0);
                if (EN(4) && IN(ph)) REP(4) { pg8::Gemm g{H, (const bf16_t*)(ws + WS_WIN) + (size_t)fi * 5632 * 1024, T, 5632, 1024}; pg8::StaticOrder S; S.init(T, 5632, G, bx);
                    EpiSwiglu E{ACT}; pg8::gemm_phase<EpiSwiglu>(lds, g, S, E); }
                if (layer == 0 && IN(ph)) convert_tail(a, (LAS float*)lds, sub == 0 ? 0 : 2, 4224);
                SEAM(ph); ++ph;
                if (EN(5) && IN(ph)) { pg8::Gemm g{ACT, (const bf16_t*)(ws + WS_WOUT) + (size_t)fi * 1024 * 2816, T, 1024, DFF}; pg8::StaticOrder S; S.init(T, 1024, G, bx);
                    if (first) { EpiResid<true> E{xs0, xs1, XB, XB, gp, 0.5f}; pg8::gemm_phase<EpiResid<true>>(lds, g, S, E); } else { EpiResid<false> E{xs0, xs1, XB, XB, gp, 0.5f}; pg8::gemm_phase<EpiResid<false>>(lds, g, S, E); } }
                SEAM(ph); ++ph;
            } else if (layer == 0) {
                if (EN(6) && IN(ph)) REP(6) { pg8::Gemm g{H, (const bf16_t*)(ws + WS_WABIN), T, 2560, 1024}; pg8::StaticOrder S; S.init(T, 2560, G, bx);
                    EpiProj E{PA, PBT}; pg8::gemm_phase<EpiProj>(lds, g, S, E); }
                if (IN(ph)) convert_tail(a, (LAS float*)lds, 1, 1920);
                SEAM(ph); ++ph;
                if (IN(ph)) { if (EN(7)) REP(7) conva_phase(a, PA, H, lds); GSYNC(); if ((RM >> 8) & 1) fft_phase<true>(a, PBT, lds); if (EN(8)) fft_phase<false>(a, PBT, lds); }
                SEAM(ph); ++ph;
                if (EN(9) && IN(ph)) REP(9) ztrans_phase(PBT, H, lds);
                SEAM(ph); ++ph;
                if (EN(5) && IN(ph)) { pg8::Gemm g{H, (const bf16_t*)(ws + WS_WABOUT), T, 1024, 1024}; pg8::StaticOrder S; S.init(T, 1024, G, bx);
                    EpiResid<false> E{xs0, xs1, XB, XB, gp, 1.0f}; pg8::gemm_phase<EpiResid<false>>(lds, g, S, E); }
                SEAM(ph); ++ph;
            } else {
                if (EN(10) && IN(ph)) REP(10) { pg8::Gemm g{H, (const bf16_t*)(ws + WS_WQKV), T, 1536, 1024}; pg8::StaticOrder S; S.init(T, 1536, G, bx);
                    EpiBf16 E{ACT, 1536}; pg8::gemm_phase<EpiBf16>(lds, g, S, E); }
                SEAM(ph); ++ph;
                if (EN(11) && IN(ph)) REP(11) attn_phase(a, ACT, H, lds);
                SEAM(ph); ++ph;
                if (EN(5) && IN(ph)) { pg8::Gemm g{H, (const bf16_t*)(ws + WS_WATTO), T, 1024, 1024}; pg8::StaticOrder S; S.init(T, 1024, G, bx);
                    EpiResid<false> E{xs0, xs1, XB, XB, gp, 1.0f}; pg8::gemm_phase<EpiResid<false>>(lds, g, S, E); }
                SEAM(ph); ++ph;
            }
        }
    }
    if (EN(12) && IN(ph)) final_norm_phase(XB, a.out, a.in[9]);
#undef IN
#undef SEAM
}

extern "C" void kernel_launch(void* const* d_in, const int* in_sizes, int n_in, void* d_out, int out_size, void* d_ws, size_t ws_size, hipStream_t stream) {
    static int grid = 0;
    if (grid == 0) {
        int dev = 0, cus = 0, per_cu = 0;
        (void)hipGetDevice(&dev);
        (void)hipDeviceGetAttribute(&cus, hipDeviceAttributeMultiprocessorCount, dev);
        (void)hipFuncSetAttribute((const void*)mega, hipFuncAttributeMaxDynamicSharedMemorySize, LDS_BYTES);
        (void)hipOccupancyMaxActiveBlocksPerMultiprocessor(&per_cu, (const void*)mega, 512, LDS_BYTES);
        if (per_cu < 1) per_cu = 1;
        grid = cus * per_cu;
        if (grid > 256) grid = 256;
        if (ws_size < WS_END) { fprintf(stderr, "workspace too small: %zu < %zu\n", ws_size, (size_t)WS_END); grid = -1; }
    }
    if (grid < 0) return;
    Args a{};
    for (int i = 0; i < 28; ++i) a.in[i] = (const float*)d_in[i];
    a.out = (float*)d_out; a.ws = (unsigned char*)d_ws;
    (void)hipMemsetAsync((unsigned char*)d_ws + WS_BAR, 0, XCD_BAR_WORDS * 4, stream);
#if N_LAUNCH_MODE == 1
    a.ph_lo = 0; a.ph_hi = NPH;
    void* args[] = {&a};
    hipError_t e = hipLaunchCooperativeKernel((const void*)mega, dim3(grid), dim3(512), args, LDS_BYTES, stream);
    if (e != hipSuccess) fprintf(stderr, "cooperative launch failed: %s (grid %d)\n", hipGetErrorString(e), grid);
#else
    for (int p = 0; p < NPH; ++p) { a.ph_lo = p; a.ph_hi = p + 1; hipLaunchKernelGGL(mega, dim3(grid), dim3(512), LDS_BYTES, stream, a); }
#endif
}
```

```cpp
#include <hip/hip_runtime.h>
#include <hip/hip_cooperative_groups.h>
#include <cstdio>
namespace cg = cooperative_groups;

#ifndef PM
#define PM 0xffff
#endif
#define EN(b) ((PM >> (b)) & 1)
#ifndef RM
#define RM 0
#endif
#define REP(b) for (int rep_ = 0; rep_ < 1 + ((RM >> (b)) & 1); ++rep_)
#ifndef N_LAUNCH_MODE
#define N_LAUNCH_MODE 1
#endif

#define LAS __attribute__((address_space(3)))
typedef unsigned short bf16_t;
typedef short bf16x8 __attribute__((ext_vector_type(8)));
typedef float f32x4 __attribute__((ext_vector_type(4)));
typedef float f32x16 __attribute__((ext_vector_type(16)));
typedef unsigned u32x4 __attribute__((ext_vector_type(4)));
typedef unsigned u32x2 __attribute__((ext_vector_type(2)));
typedef __bf16 bf16x2v __attribute__((ext_vector_type(2)));
typedef float f32x2v __attribute__((ext_vector_type(2)));
typedef _Float16 half_t;

constexpr int T = 49152, D = 1024, L = 16384, DFF = 2816, NPH = 23;
constexpr float EPS = 1e-6f;
constexpr int LDS_BYTES = 147456;

constexpr size_t WS_WIN = 0;
constexpr size_t WS_WOUT = WS_WIN + 4ull * 5632 * 1024 * 2;
constexpr size_t WS_WABIN = WS_WOUT + 4ull * 1024 * 2816 * 2;
constexpr size_t WS_WABOUT = WS_WABIN + 2560ull * 1024 * 2;
constexpr size_t WS_WQKV = WS_WABOUT + 1024ull * 1024 * 2;
constexpr size_t WS_WATTO = WS_WQKV + 1536ull * 1024 * 2;
constexpr size_t WS_MOD = WS_WATTO + 1024ull * 1024 * 2;
constexpr size_t WS_BAR = WS_MOD + 221184;
constexpr size_t WS_H = WS_MOD + 262144;
constexpr size_t WS_ACT = WS_H + (size_t)T * 1024 * 2;
constexpr size_t WS_KT = WS_ACT + (size_t)T * DFF * 2;
constexpr size_t WS_END = WS_KT + 2ull * 512 * 2 * L * 2;
constexpr size_t PBT_BYTES = 3ull * 1536 * L * 2;
constexpr size_t FFTSCR_PER_BLOCK = 2ull * L * 8 + 3ull * L * 4;

__device__ __forceinline__ unsigned pk_bf16(float a, float b) { f32x2v f = {a, b}; bf16x2v r = __builtin_convertvector(f, bf16x2v); return __builtin_bit_cast(unsigned, r); }
__device__ __forceinline__ float bf_lo(unsigned v) { return __uint_as_float(v << 16); }
__device__ __forceinline__ float bf_hi(unsigned v) { return __uint_as_float(v & 0xffff0000u); }
__device__ __forceinline__ float bf2f(bf16_t v) { return __uint_as_float((unsigned)v << 16); }
__device__ __forceinline__ bf16_t f2bf(float f) { return (bf16_t)(pk_bf16(f, 0.f) & 0xffffu); }
__device__ __forceinline__ float fsigmoid(float x) { return __builtin_amdgcn_rcpf(1.0f + __expf(-x)); }
__device__ __forceinline__ float hw_sin(float x) { return __builtin_amdgcn_sinf(x * 0.15915494309189535f); }

__device__ __forceinline__ int opaque_tid() { int t = threadIdx.x; asm volatile("" : "+v"(t)); return t; }

#define XB_TMO      128
#define XB_XCNT(j)  (256  + 64 * (j))
#define XB_XSUB(j)  (1280 + 64 * (j))
#define XB_XGEN(j)  (2304 + 64 * (j))
#define XB_TOP      3328
#define XB_TOPGEN   3392
#define XCD_BAR_WORDS 3456
#define XB_SPIN_CAP (1u << 22)
__device__ __forceinline__ unsigned xb_ld(unsigned* p)              { return __hip_atomic_load(p, __ATOMIC_RELAXED, __HIP_MEMORY_SCOPE_AGENT); }
__device__ __forceinline__ unsigned xb_add(unsigned* p, unsigned v) { return __hip_atomic_fetch_add(p, v, __ATOMIC_RELAXED, __HIP_MEMORY_SCOPE_AGENT); }
__device__ __forceinline__ unsigned xb_xcc_id() { return (unsigned)__builtin_amdgcn_s_getreg((3 << 11) | 20) & 0xFu; }
#define XB_SPIN(cond, bar) do { unsigned _sp = 0; while (cond) { __builtin_amdgcn_s_sleep(1); \
    if ((++_sp & 255u) == 0u) { if (xb_ld(&(bar)[XB_TMO])) break; if (_sp > XB_SPIN_CAP) { atomicAdd(&(bar)[XB_TMO], 1u); break; } } } } while (0)
struct XcdBarrier { unsigned* bar; unsigned x; volatile LAS unsigned* st; };
__device__ __forceinline__ XcdBarrier xcd_barrier_post(unsigned* bar, volatile LAS unsigned* st) {
    XcdBarrier b; b.bar = bar; b.x = xb_xcc_id(); b.st = st;
    if (threadIdx.x == 0) (void)xb_add(&bar[XB_XCNT(b.x)], 1u);
    return b;
}
__device__ __forceinline__ void xcd_barrier_complete(unsigned* bar, unsigned x, unsigned& nloc, unsigned& nx) {
    const unsigned G = gridDim.x * gridDim.y * gridDim.z;
    unsigned sum, cnt, mine, sp = 0u;
    for (;;) {
        sum = 0u; cnt = 0u; mine = 0u;
#pragma unroll
        for (unsigned j = 0; j < 16; ++j) { const unsigned c = xb_ld(&bar[XB_XCNT(j)]); sum += c; cnt += (c > 0u) ? 1u : 0u; mine = (j == x) ? c : mine; }
        if (sum == G) break;
        __builtin_amdgcn_s_sleep(1);
        if ((++sp & 255u) == 0u) { if (xb_ld(&bar[XB_TMO])) break; if (sp > XB_SPIN_CAP) { atomicAdd(&bar[XB_TMO], 1u); break; } }
    }
    nloc = mine > 0u ? mine : 1u; nx = cnt > 0u ? cnt : 1u;
}
__device__ __forceinline__ void xcd_barrier(const XcdBarrier& b) {
    asm volatile("s_waitcnt vmcnt(0)" ::: "memory");
    __syncthreads();
    if (threadIdx.x == 0) {
        unsigned* bar = b.bar;
        __builtin_amdgcn_s_waitcnt(0);
        unsigned nloc = b.st[0], nx = b.st[1];
        if (nloc == 0u) { xcd_barrier_complete(bar, b.x, nloc, nx); b.st[0] = nloc; b.st[1] = nx; }
        const unsigned old = xb_add(&bar[XB_XSUB(b.x)], 1u);
        const unsigned gen = old / nloc;
        if (old + 1u == (gen + 1u) * nloc) {
            __builtin_amdgcn_fence(__ATOMIC_RELEASE, "agent");
            asm volatile("s_waitcnt vmcnt(0)" ::: "memory");
            const unsigned og = xb_add(&bar[XB_TOP], 1u);
            const unsigned tg = og / nx;
            if (og + 1u == (tg + 1u) * nx) xb_add(&bar[XB_TOPGEN], 1u);
            else XB_SPIN(xb_ld(&bar[XB_TOPGEN]) == tg, bar);
            __builtin_amdgcn_fence(__ATOMIC_ACQUIRE, "agent");
            xb_add(&bar[XB_XGEN(b.x)], 1u);
            asm volatile("s_waitcnt vmcnt(0)" ::: "memory");
        } else {
            XB_SPIN(xb_ld(&bar[XB_XGEN(b.x)]) == gen, bar);
            __builtin_amdgcn_fence(__ATOMIC_ACQUIRE, "agent");
            asm volatile("s_waitcnt vmcnt(0)" ::: "memory");
        }
    }
    __syncthreads();
}

struct Args { const float* in[28]; float* out; unsigned char* ws; int ph_lo, ph_hi; };

namespace pg8 {
constexpr int BM = 256, BK = 64, HALF = 128, HTB = HALF * BK * 2, STAGE_BYTES = 8 * HTB, NXCD = 8, WGM = 8;
__device__ __forceinline__ int lds_byte(int r, int c) { const int st = (r >> 4) * 2 + (c >> 5), rr = r & 15, cc = c & 31, ob = rr * 64 + cc * 2; return st * 1024 + (ob ^ (((ob >> 9) & 1) << 5)); }
__device__ __forceinline__ void stage_rc(int b, int& R, int& C) { const int st = b / 1024, sb = b % 1024, swz = sb ^ (((sb >> 9) & 1) << 5); R = (st >> 1) * 16 + swz / 64; C = (st & 1) * 32 + (swz % 64) / 2; }
__device__ __forceinline__ int perm32(int rho) { const int n = rho >> 4, i = rho & 15; return 8 * (i >> 2) + 4 * n + (i & 3); }
struct Unit { int pm, pn; };
struct Gemm { const bf16_t* A; const bf16_t* Bt; int M, N, K; };
struct StaticOrder {
    int nM, nN, nwg, G, c;
    __device__ void init(int M, int N, int G_, int c_) { nM = M / BM; nN = N / BM; nwg = nM * nN; G = G_; c = c_; }
    __device__ bool next(int i, Unit& u) const {
        const long Lx = (long)i * G + c; if (Lx >= nwg) return false;
        int wgid = (int)Lx; { const int q = nwg / NXCD, r = nwg % NXCD, xcd = wgid % NXCD, off = wgid / NXCD; wgid = (xcd < r ? xcd * (q + 1) : r * (q + 1) + (xcd - r) * q) + off; }
        const int nig = WGM * nN, gid = wgid / nig, fm = gid * WGM, gsz = (nM - fm) < WGM ? (nM - fm) : WGM;
        u.pm = fm + ((wgid % nig) % gsz); u.pn = (wgid % nig) / gsz; return true;
    }
};

template <class Epi>
__device__ __forceinline__ void gemm_phase(LAS unsigned char* lds, const Gemm g, const StaticOrder& S, const Epi& E) {
    const int tid = opaque_tid(), wid = __builtin_amdgcn_readfirstlane(tid >> 6), lane = tid & 63, wr = wid >> 2, wc = wid & 3, fr = lane & 15, fq = lane >> 4;
    const int K = g.K, nt = K / BK;
    unsigned voffA[2], voffB[2];
#pragma unroll
    for (int i = 0; i < 2; ++i) { int R, C; stage_rc(tid * 16 + i * 8192, R, C); const int Rb = Epi::PERM ? ((R & ~31) + perm32(R & 31)) : R;
        voffA[i] = (unsigned)(R * K + C) * 2u; voffB[i] = (unsigned)(Rb * K + C) * 2u; }
    const size_t kstep = (size_t)(BK * 2);
    const size_t hstep = (size_t)HALF * K * 2;
    const size_t tstep = 2 * hstep;
    const unsigned ldsw = (unsigned)wid * 1024u;
    const int aoff = lds_byte(wr * 64 + fr, fq * 8), boff = lds_byte(wc * 32 + fr, fq * 8);
#define PG8_SA(b, h) (((b) * 2 + (h)) * HTB)
#define PG8_SB(b, h) ((4 + (b) * 2 + (h)) * HTB)
#define PG8_STAGE(bufoff, gbase, voff) do { _Pragma("unroll") for (int _i = 0; _i < 2; ++_i) \
        __builtin_amdgcn_global_load_lds((const unsigned*)((const char*)(gbase) + (voff)[_i]), (LAS unsigned*)(lds + (bufoff) + ldsw + _i * 8192), 16, 0, 0); } while (0)
#define PG8_LDA(dst, b, h) do { _Pragma("unroll") for (int m = 0; m < 4; ++m) _Pragma("unroll") for (int k = 0; k < 2; ++k) dst[m][k] = *(const LAS bf16x8*)(lds + PG8_SA(b, h) + aoff + m * 2048 + k * 1024); } while (0)
#define PG8_LDB(dst, b, h) do { _Pragma("unroll") for (int n = 0; n < 2; ++n) _Pragma("unroll") for (int k = 0; k < 2; ++k) dst[n][k] = *(const LAS bf16x8*)(lds + PG8_SB(b, h) + boff + n * 2048 + k * 1024); } while (0)
#define PG8_MMA(ai, bj, At, Bt) do { __builtin_amdgcn_s_setprio(1); _Pragma("unroll") for (int m = 0; m < 4; ++m) _Pragma("unroll") for (int n = 0; n < 2; ++n) _Pragma("unroll") for (int k = 0; k < 2; ++k) \
        acc[ai][bj][m][n] = __builtin_amdgcn_mfma_f32_16x16x32_bf16(Bt[n][k], At[m][k], acc[ai][bj][m][n], 0, 0, 0); __builtin_amdgcn_s_setprio(0); } while (0)
#define PG8_WAIT_V(n) asm volatile("s_waitcnt vmcnt(" #n ")" ::: "memory")
#define PG8_WAIT_L(n) asm volatile("s_waitcnt lgkmcnt(" #n ")" ::: "memory")
#define PG8_BAR __builtin_amdgcn_s_barrier()
#define PG8_SCHED __builtin_amdgcn_sched_barrier(0)
    Unit cur, nxt; int ui = 0;
    if (!S.next(0, cur)) return;
    f32x4 acc[2][2][4][2];
#pragma unroll
    for (int a = 0; a < 2; ++a)
#pragma unroll
        for (int b = 0; b < 2; ++b)
#pragma unroll
            for (int m = 0; m < 4; ++m)
#pragma unroll
                for (int n = 0; n < 2; ++n) acc[a][b][m][n] = (f32x4){0.f, 0.f, 0.f, 0.f};
    bf16x8 At[4][2], B0[2][2], B1[2][2];
    const char* cA = (const char*)g.A + (size_t)cur.pm * tstep; const char* cB = (const char*)g.Bt + (size_t)cur.pn * tstep;
    PG8_STAGE(PG8_SB(0, 0), cB, voffB); PG8_STAGE(PG8_SA(0, 0), cA, voffA); PG8_STAGE(PG8_SB(0, 1), cB + hstep, voffB); PG8_STAGE(PG8_SA(0, 1), cA + hstep, voffA);
    if (wr == 1) PG8_BAR;
    PG8_WAIT_V(4); PG8_BAR;
    PG8_STAGE(PG8_SB(1, 0), cB + kstep, voffB); PG8_STAGE(PG8_SA(1, 0), cA + kstep, voffA); PG8_STAGE(PG8_SB(1, 1), cB + hstep + kstep, voffB);
    PG8_WAIT_V(6); PG8_BAR;
    for (;;) {
        const bool has_next = S.next(ui + 1, nxt);
        const char* nA = has_next ? (const char*)g.A + (size_t)nxt.pm * tstep : cA; const char* nB = has_next ? (const char*)g.Bt + (size_t)nxt.pn * tstep : cB;
        for (int t = 0; t < nt; t += 2) {
            const bool last = (t == nt - 2);
            const char* a1 = cA + (size_t)(t + 1) * kstep;
            const char* a2 = last ? nA : cA + (size_t)(t + 2) * kstep; const char* b2 = last ? nB : cB + (size_t)(t + 2) * kstep;
            const char* a3 = a2 + kstep; const char* b3 = b2 + kstep;
            PG8_LDB(B0, 0, 0); PG8_SCHED; PG8_LDA(At, 0, 0); PG8_STAGE(PG8_SA(1, 1), a1 + hstep, voffA);
            PG8_WAIT_L(8); PG8_BAR; PG8_WAIT_L(0); PG8_MMA(0, 0, At, B0); PG8_BAR; PG8_SCHED;
            PG8_LDB(B1, 0, 1); PG8_STAGE(PG8_SB(0, 0), b2, voffB);
            PG8_BAR; PG8_WAIT_L(0); PG8_MMA(0, 1, At, B1); PG8_BAR;
            PG8_LDA(At, 0, 1); PG8_STAGE(PG8_SA(0, 0), a2, voffA);
            PG8_BAR; PG8_WAIT_L(0); PG8_MMA(1, 0, At, B0); PG8_BAR; PG8_SCHED;
            PG8_STAGE(PG8_SB(0, 1), b2 + hstep, voffB);
            PG8_WAIT_V(6); PG8_BAR; PG8_MMA(1, 1, At, B1); PG8_BAR;
            PG8_LDB(B0, 1, 0); PG8_SCHED; PG8_LDA(At, 1, 0); PG8_STAGE(PG8_SA(0, 1), a2 + hstep, voffA);
            PG8_WAIT_L(8); PG8_BAR; PG8_WAIT_L(0); PG8_MMA(0, 0, At, B0); PG8_BAR; PG8_SCHED;
            PG8_LDB(B1, 1, 1); PG8_STAGE(PG8_SB(1, 0), b3, voffB);
            PG8_BAR; PG8_WAIT_L(0); PG8_MMA(0, 1, At, B1); PG8_BAR;
            PG8_LDA(At, 1, 1); PG8_STAGE(PG8_SA(1, 0), a3, voffA);
            PG8_BAR; PG8_WAIT_L(0); PG8_MMA(1, 0, At, B0); PG8_BAR; PG8_SCHED;
            PG8_STAGE(PG8_SB(1, 1), b3 + hstep, voffB);
            PG8_WAIT_V(6); PG8_BAR; PG8_MMA(1, 1, At, B1); PG8_BAR;
        }
        E(acc, cur, wr, wc, fr, fq);
        if (!has_next) break;
#pragma unroll
        for (int a = 0; a < 2; ++a)
#pragma unroll
            for (int b = 0; b < 2; ++b)
#pragma unroll
                for (int m = 0; m < 4; ++m)
#pragma unroll
                    for (int n = 0; n < 2; ++n) acc[a][b][m][n] = (f32x4){0.f, 0.f, 0.f, 0.f};
        cur = nxt; cA = nA; cB = nB; ++ui;
    }
    PG8_WAIT_V(0);
    if (wr == 0) PG8_BAR;
    PG8_BAR;
#undef PG8_SA
#undef PG8_SB
#undef PG8_STAGE
#undef PG8_LDA
#undef PG8_LDB
#undef PG8_MMA
#undef PG8_WAIT_V
#undef PG8_WAIT_L
#undef PG8_BAR
#undef PG8_SCHED
}
}

struct EpiSwiglu {
    static constexpr bool PERM = true;
    bf16_t* O;
    __device__ __forceinline__ void operator()(const f32x4 (&acc)[2][2][4][2], const pg8::Unit& u, int wr, int wc, int fr, int fq) const {
        const int row0 = u.pm * 256 + wr * 64 + fr, col0 = u.pn * 128 + wc * 32 + 8 * fq;
#pragma unroll
        for (int ai = 0; ai < 2; ++ai)
#pragma unroll
            for (int m = 0; m < 4; ++m) {
                bf16_t* rowp = O + (size_t)(row0 + ai * 128 + m * 16) * DFF + col0;
                float v[8];
#pragma unroll
                for (int n = 0; n < 2; ++n)
#pragma unroll
                    for (int j = 0; j < 4; ++j) { const float gg = acc[ai][0][m][n][j], uu = acc[ai][1][m][n][j]; v[n * 4 + j] = gg * fsigmoid(gg) * uu; }
                u32x4 w; w.x = pk_bf16(v[0], v[1]); w.y = pk_bf16(v[2], v[3]); w.z = pk_bf16(v[4], v[5]); w.w = pk_bf16(v[6], v[7]);
                *(u32x4*)rowp = w;
            }
    }
};
struct EpiBf16 {
    static constexpr bool PERM = true;
    bf16_t* O; int ldc;
    __device__ __forceinline__ void operator()(const f32x4 (&acc)[2][2][4][2], const pg8::Unit& u, int wr, int wc, int fr, int fq) const {
        const int row0 = u.pm * 256 + wr * 64 + fr, col0 = u.pn * 256 + wc * 32 + 8 * fq;
#pragma unroll
        for (int ai = 0; ai < 2; ++ai)
#pragma unroll
            for (int m = 0; m < 4; ++m) {
                bf16_t* rowp = O + (size_t)(row0 + ai * 128 + m * 16) * ldc + col0;
#pragma unroll
                for (int bj = 0; bj < 2; ++bj) {
                    const f32x4 v0 = acc[ai][bj][m][0], v1 = acc[ai][bj][m][1];
                    u32x4 w; w.x = pk_bf16(v0[0], v0[1]); w.y = pk_bf16(v0[2], v0[3]); w.z = pk_bf16(v1[0], v1[1]); w.w = pk_bf16(v1[2], v1[3]);
                    *(u32x4*)(rowp + bj * 128) = w;
                }
            }
    }
};
struct EpiProj {
    static constexpr bool PERM = true;
    bf16_t* Oa; bf16_t* ObT;
    __device__ __forceinline__ void operator()(const f32x4 (&acc)[2][2][4][2], const pg8::Unit& u, int wr, int wc, int fr, int fq) const {
        const int row0 = u.pm * 256 + wr * 64 + fr;
        if (u.pn < 4) {
            const int col0 = u.pn * 256 + wc * 32 + 8 * fq;
#pragma unroll
            for (int ai = 0; ai < 2; ++ai)
#pragma unroll
                for (int m = 0; m < 4; ++m) {
                    bf16_t* rowp = Oa + (size_t)(row0 + ai * 128 + m * 16) * 1024 + col0;
#pragma unroll
                    for (int bj = 0; bj < 2; ++bj) {
                        const f32x4 v0 = acc[ai][bj][m][0], v1 = acc[ai][bj][m][1];
                        u32x4 w; w.x = pk_bf16(v0[0], v0[1]); w.y = pk_bf16(v0[2], v0[3]); w.z = pk_bf16(v1[0], v1[1]); w.w = pk_bf16(v1[2], v1[3]);
                        *(u32x4*)(rowp + bj * 128) = w;
                    }
                }
        } else {
            const int seq = (u.pm * 256) >> 14;
            const int c0 = (u.pn - 4) * 256 + wc * 32 + 8 * fq;
#pragma unroll
            for (int ai = 0; ai < 2; ++ai)
#pragma unroll
                for (int m = 0; m < 4; ++m) {
                    const int nn = (row0 + ai * 128 + m * 16) & (L - 1);
#pragma unroll
                    for (int bj = 0; bj < 2; ++bj)
#pragma unroll
                        for (int n = 0; n < 2; ++n)
#pragma unroll
                            for (int j = 0; j < 4; ++j)
                                ObT[((size_t)(seq * 1536 + c0 + bj * 128 + 4 * n + j) << 14) + nn] = f2bf(acc[ai][bj][m][n][j]);
                }
        }
    }
};
template <bool SRC_F32> struct EpiResid {
    static constexpr bool PERM = true;
    const float* xs0; const float* xs1; const bf16_t* xbs; bf16_t* xbo; const float* gate; float scale;
    __device__ __forceinline__ void operator()(const f32x4 (&acc)[2][2][4][2], const pg8::Unit& u, int wr, int wc, int fr, int fq) const {
        const int row0 = u.pm * 256 + wr * 64 + fr, col0 = u.pn * 256 + wc * 32 + 8 * fq;
        const int seq = (u.pm * 256) >> 14;
        const float* gb = gate + seq * 9216 + col0;
        const float* sf = (seq < 2 ? xs0 + (size_t)row0 * 1024 : xs1 + (size_t)(row0 - 32768) * 1024) + col0;
        const size_t ob = (size_t)row0 * 1024 + col0;
#pragma unroll
        for (int bj = 0; bj < 2; ++bj) {
            const f32x4 g0 = *(const f32x4*)(gb + bj * 128) * scale, g1 = *(const f32x4*)(gb + bj * 128 + 4) * scale;
            f32x4 x0[2][4], x1[2][4]; u32x4 q[2][4];
#pragma unroll
            for (int ai = 0; ai < 2; ++ai)
#pragma unroll
                for (int m = 0; m < 4; ++m) {
                    const size_t off = (size_t)(ai * 128 + m * 16) * 1024 + bj * 128;
                    if (SRC_F32) { x0[ai][m] = *(const f32x4*)(sf + off); x1[ai][m] = *(const f32x4*)(sf + off + 4); }
                    else q[ai][m] = *(const u32x4*)(xbs + ob + off);
                }
#pragma unroll
            for (int ai = 0; ai < 2; ++ai)
#pragma unroll
                for (int m = 0; m < 4; ++m) {
                    const size_t off = (size_t)(ai * 128 + m * 16) * 1024 + bj * 128;
                    f32x4 a0, a1;
                    if (SRC_F32) { a0 = x0[ai][m]; a1 = x1[ai][m]; }
                    else { const u32x4 t = q[ai][m]; a0 = (f32x4){bf_lo(t.x), bf_hi(t.x), bf_lo(t.y), bf_hi(t.y)}; a1 = (f32x4){bf_lo(t.z), bf_hi(t.z), bf_lo(t.w), bf_hi(t.w)}; }
                    const f32x4 y0 = a0 + g0 * acc[ai][bj][m][0], y1 = a1 + g1 * acc[ai][bj][m][1];
                    u32x4 w; w.x = pk_bf16(y0[0], y0[1]); w.y = pk_bf16(y0[2], y0[3]); w.z = pk_bf16(y1[0], y1[1]); w.w = pk_bf16(y1[2], y1[3]);
                    *(u32x4*)(xbo + ob + off) = w;
                }
        }
    }
};

struct WTile { const float* src; bf16_t* dst; int K, N, k0, np0, n0; };
__device__ __forceinline__ WTile wtile_desc(const Args& a, int ti) {
    unsigned char* ws = a.ws;
    WTile t; int mode = 0, lt;
    if (ti < 5632) { const int mi = ti / 1408; lt = ti % 1408; t.src = a.in[7] + (size_t)mi * 1024 * 5632; t.dst = (bf16_t*)(ws + WS_WIN) + (size_t)mi * 5632 * 1024; t.K = 1024; t.N = 5632; mode = 1; }
    else if (ti < 8448) { const int mi = (ti - 5632) / 704; lt = (ti - 5632) % 704; t.src = a.in[8] + (size_t)mi * 2816 * 1024; t.dst = (bf16_t*)(ws + WS_WOUT) + (size_t)mi * 1024 * 2816; t.K = 2816; t.N = 1024; }
    else if (ti < 9088) { lt = ti - 8448; t.src = a.in[10]; t.dst = (bf16_t*)(ws + WS_WABIN); t.K = 1024; t.N = 2560; }
    else if (ti < 9344) { lt = ti - 9088; t.src = a.in[24]; t.dst = (bf16_t*)(ws + WS_WABOUT); t.K = 1024; t.N = 1024; }
    else if (ti < 9728) { lt = ti - 9344; t.src = a.in[25]; t.dst = (bf16_t*)(ws + WS_WQKV); t.K = 1024; t.N = 1536; }
    else { lt = ti - 9728; t.src = a.in[27]; t.dst = (bf16_t*)(ws + WS_WATTO); t.K = 1024; t.N = 1024; }
    const int nkt = t.K / 64;
    const int kt = lt % nkt, ntp = lt / nkt;
    t.k0 = kt * 64; t.np0 = ntp * 64; t.n0 = t.np0;
    if (mode == 1) { const int pn = t.np0 >> 8, bj = (t.np0 >> 7) & 1, c0 = t.np0 & 127; t.n0 = bj * DFF + 128 * pn + c0; }
    return t;
}
__device__ void convert_span(const Args& a, LAS float* tile, int lo, int hi, int bi, int nb) {
    const int tid = opaque_tid();
    for (int base = lo + bi; base < hi; base += 4 * nb) {
        __syncthreads();
        float v[4][8];
#pragma unroll
        for (int q = 0; q < 4; ++q) {
            const int ti = base + q * nb;
            if (ti < hi) { const WTile t = wtile_desc(a, ti);
#pragma unroll
                for (int i = 0; i < 8; ++i) { const int k = (tid >> 6) + 8 * i, n = tid & 63; v[q][i] = t.src[(size_t)(t.k0 + k) * t.N + t.n0 + n]; } }
        }
#pragma unroll
        for (int q = 0; q < 4; ++q)
#pragma unroll
            for (int i = 0; i < 8; ++i) { const int k = (tid >> 6) + 8 * i, n = tid & 63; tile[q * 4160 + k * 65 + n] = v[q][i]; }
        __syncthreads();
#pragma unroll
        for (int q = 0; q < 4; ++q) {
            const int ti = base + q * nb;
            if (ti < hi) { const WTile t = wtile_desc(a, ti);
                const int nn = tid >> 3, kk = (tid & 7) * 8;
                float x[8];
#pragma unroll
                for (int j = 0; j < 8; ++j) x[j] = tile[q * 4160 + (kk + j) * 65 + nn];
                u32x4 w; w.x = pk_bf16(x[0], x[1]); w.y = pk_bf16(x[2], x[3]); w.z = pk_bf16(x[4], x[5]); w.w = pk_bf16(x[6], x[7]);
                *(u32x4*)(t.dst + (size_t)(t.np0 + nn) * t.K + t.k0 + kk) = w; }
        }
    }
    __syncthreads();
}
__device__ void convert_weights(const Args& a, LAS float* tile) {
    const int G = gridDim.x, bx = blockIdx.x;
#pragma unroll 1
    for (int r = 0; r < 3; ++r) { const int lo = r == 0 ? 0 : r == 1 ? 5632 : 8448, hi = r == 0 ? 2816 : r == 1 ? 7040 : 9344; convert_span(a, tile, lo, hi, bx, G); }
}
__device__ void convert_tail(const Args& a, LAS float* tile, int which, int nwg) {
    const int G = gridDim.x, bx = blockIdx.x, rem = nwg % G;
    int bi = bx, nb = G;
    if (rem != 0) { if (bx < rem) return; bi = bx - rem; nb = G - rem; }
#pragma unroll 1
    for (int r = 0; r < 2; ++r) {
        int lo, hi;
        if (which == 0) { lo = r == 0 ? 2816 : 0; hi = r == 0 ? 4736 : 0; }
        else if (which == 1) { lo = r == 0 ? 4736 : 7040; hi = r == 0 ? 5632 : 8064; }
        else { lo = r == 0 ? 8064 : 9344; hi = r == 0 ? 8448 : 9984; }
        convert_span(a, tile, lo, hi, bi, nb);
    }
}

__device__ void ada_phase(const Args& a, LAS float* lf) {
    const int tid = opaque_tid(), lane = tid & 63, w = tid >> 6;
    LAS float* cs = lf; LAS float* red = lf + 3072;
    float* mod = (float*)(a.ws + WS_MOD);
    __syncthreads();
    for (int i = tid; i < 3072; i += 512) { const int s = i >> 10, k = i & 1023; const float c = s < 2 ? a.in[2][s * 1024 + k] : a.in[3][k]; cs[i] = c * fsigmoid(c); }
    __syncthreads();
    for (int item = blockIdx.x; item < 1152; item += gridDim.x) {
        const int layer = item / 576, cgp = item % 576, cl = lane & 15, ks = lane >> 4, col = cgp * 16 + cl;
        const float* W = a.in[4] + (size_t)layer * 1024 * 9216 + col;
        const int kb = (w * 4 + ks) * 32;
        float a0 = 0.f, a1 = 0.f, a2 = 0.f;
#pragma unroll 16
        for (int k = kb; k < kb + 32; ++k) { const float wv = W[(size_t)k * 9216]; a0 += cs[k] * wv; a1 += cs[1024 + k] * wv; a2 += cs[2048 + k] * wv; }
        a0 += __shfl_xor(a0, 16); a0 += __shfl_xor(a0, 32); a1 += __shfl_xor(a1, 16); a1 += __shfl_xor(a1, 32); a2 += __shfl_xor(a2, 16); a2 += __shfl_xor(a2, 32);
        if (lane < 16) { red[(w * 3 + 0) * 16 + cl] = a0; red[(w * 3 + 1) * 16 + cl] = a1; red[(w * 3 + 2) * 16 + cl] = a2; }
        __syncthreads();
        if (tid < 48) { const int s = tid >> 4, c = tid & 15; float sum = 0.f;
#pragma unroll
            for (int ww = 0; ww < 8; ++ww) sum += red[(ww * 3 + s) * 16 + c];
            mod[(size_t)(layer * 3 + s) * 9216 + cgp * 16 + c] = sum + a.in[5][layer * 9216 + cgp * 16 + c]; }
        __syncthreads();
    }
}

__device__ void filter_phase(const Args& a, LAS float* lf) {
    const int tid = opaque_tid();
    LAS float* feats = lf;
    LAS float* h1 = lf + 64 * 33;
    LAS float* h2T = h1 + 64 * 65;
    const float* w1 = a.in[17]; const float* b1 = a.in[18]; const float* w2 = a.in[19]; const float* b2 = a.in[20]; const float* w3 = a.in[21]; const float* fr = a.in[22];
    half_t* KT = (half_t*)(a.ws + WS_KT);
    for (int item = blockIdx.x; item < 256; item += gridDim.x) {
        const int p0 = item * 64;
        __syncthreads();
        for (int idx = tid; idx < 64 * 33; idx += 512) {
            const int pos = idx / 33, f = idx % 33, n = p0 + pos; float v;
            if (f == 0) v = (float)n / (float)(L - 1);
            else { const int b = (f - 1) & 15; const double band = 1e-4 + (double)b * ((15.0 - 1e-4) / 15.0); double rev = (double)n * band / (double)L; rev -= floor(rev);
                   v = (f <= 16) ? __builtin_amdgcn_cosf((float)rev) : -__builtin_amdgcn_sinf((float)rev); }
            feats[idx] = v;
        }
        __syncthreads();
        { const int pos = tid >> 3, j0 = (tid & 7) * 8; float acc[8];
#pragma unroll
          for (int j = 0; j < 8; ++j) acc[j] = b1[j0 + j];
#pragma unroll 3
          for (int f = 0; f < 33; ++f) { const float x = feats[pos * 33 + f];
#pragma unroll
              for (int j = 0; j < 8; ++j) acc[j] += x * w1[f * 64 + j0 + j]; }
#pragma unroll
          for (int j = 0; j < 8; ++j) h1[pos * 65 + j0 + j] = hw_sin(fr[j0 + j] * acc[j]); }
        __syncthreads();
        { const int pos = tid >> 3, j0 = (tid & 7) * 8; float acc[8];
#pragma unroll
          for (int j = 0; j < 8; ++j) acc[j] = b2[j0 + j];
#pragma unroll 4
          for (int i = 0; i < 64; ++i) { const float x = h1[pos * 65 + i];
#pragma unroll
              for (int j = 0; j < 8; ++j) acc[j] += x * w2[i * 64 + j0 + j]; }
#pragma unroll
          for (int j = 0; j < 8; ++j) h2T[(j0 + j) * 64 + pos] = hw_sin(fr[j0 + j] * acc[j]); }
        __syncthreads();
        const int col0 = tid * 4;
        const int dir = col0 >> 10, ord = (col0 >> 9) & 1, ch0 = col0 & 511;
#pragma unroll 1
        for (int chunk = 0; chunk < 4; ++chunk) {
            float acc[16][4];
#pragma unroll
            for (int p = 0; p < 16; ++p)
#pragma unroll
                for (int c = 0; c < 4; ++c) acc[p][c] = 0.f;
#pragma unroll 2
            for (int j = 0; j < 64; ++j) {
                const f32x4 wv = *(const f32x4*)(w3 + j * 2048 + col0);
                f32x4 hv[4];
#pragma unroll
                for (int q = 0; q < 4; ++q) hv[q] = *(const LAS f32x4*)(h2T + j * 64 + chunk * 16 + q * 4);
#pragma unroll
                for (int p = 0; p < 16; ++p)
#pragma unroll
                    for (int c = 0; c < 4; ++c) acc[p][c] += hv[p >> 2][p & 3] * wv[c];
            }
#pragma unroll
            for (int c = 0; c < 4; ++c) {
                const int ch = ch0 + c;
                const float delta = 3.0701134573253945f + (float)ch * (12.280453829301578f / 511.0f);
                half_t* dstp = KT + ((size_t)((ord * 512 + ch) * 2 + dir) << 14) + p0 + chunk * 16;
                unsigned pk[8];
#pragma unroll
                for (int p = 0; p < 16; p += 2) {
                    const float t0 = (float)(p0 + chunk * 16 + p) / (float)(L - 1), t1 = (float)(p0 + chunk * 16 + p + 1) / (float)(L - 1);
                    const half_t x0 = (half_t)(acc[p][c] * __expf(-t0 * delta)), x1 = (half_t)(acc[p + 1][c] * __expf(-t1 * delta));
                    pk[p >> 1] = (unsigned)__builtin_bit_cast(unsigned short, x0) | ((unsigned)__builtin_bit_cast(unsigned short, x1) << 16);
                }
                *(u32x4*)dstp = (u32x4){pk[0], pk[1], pk[2], pk[3]};
                *(u32x4*)(dstp + 8) = (u32x4){pk[4], pk[5], pk[6], pk[7]};
            }
        }
    }
    __syncthreads();
}

template <bool SRC_F32> __device__ void norm_phase(const float* xs0, const float* xs1, const bf16_t* xb, const float* g, const float* sh, const float* sc, bf16_t* h) {
    constexpr int NR = SRC_F32 ? 2 : 4;
    const int tid_ = opaque_tid(); const int lane = tid_ & 63, w = tid_ >> 6;
    f32x4 gg[2][2];
#pragma unroll
    for (int i = 0; i < 2; ++i) { gg[i][0] = *(const f32x4*)(g + i * 512 + lane * 8); gg[i][1] = *(const f32x4*)(g + i * 512 + lane * 8 + 4); }
    for (int rb = (blockIdx.x * 8 + w) * NR; rb < T; rb += gridDim.x * 8 * NR) {
        const int seq = rb >> 14;
        f32x4 v[NR][2][2]; u32x4 q[NR][2];
#pragma unroll
        for (int r = 0; r < NR; ++r) {
            const int row = rb + r;
            if (SRC_F32) {
                const float* xr = seq < 2 ? xs0 + (size_t)row * 1024 : xs1 + (size_t)(row - 32768) * 1024;
#pragma unroll
                for (int i = 0; i < 2; ++i) { v[r][i][0] = *(const f32x4*)(xr + i * 512 + lane * 8); v[r][i][1] = *(const f32x4*)(xr + i * 512 + lane * 8 + 4); }
            } else {
#pragma unroll
                for (int i = 0; i < 2; ++i) q[r][i] = *(const u32x4*)(xb + (size_t)row * 1024 + i * 512 + lane * 8);
            }
        }
        f32x4 s1[2][2], s0[2][2];
#pragma unroll
        for (int i = 0; i < 2; ++i)
#pragma unroll
            for (int k = 0; k < 2; ++k) { s1[i][k] = *(const f32x4*)(sc + seq * 9216 + i * 512 + lane * 8 + 4 * k) + 1.0f; s0[i][k] = *(const f32x4*)(sh + seq * 9216 + i * 512 + lane * 8 + 4 * k); }
#pragma unroll
        for (int r = 0; r < NR; ++r) {
            const int row = rb + r;
            if (!SRC_F32) {
#pragma unroll
                for (int i = 0; i < 2; ++i) { const u32x4 t = q[r][i]; v[r][i][0] = (f32x4){bf_lo(t.x), bf_hi(t.x), bf_lo(t.y), bf_hi(t.y)}; v[r][i][1] = (f32x4){bf_lo(t.z), bf_hi(t.z), bf_lo(t.w), bf_hi(t.w)}; }
            }
            float ss = 0.f;
#pragma unroll
            for (int i = 0; i < 2; ++i)
#pragma unroll
                for (int k = 0; k < 2; ++k) ss += v[r][i][k][0] * v[r][i][k][0] + v[r][i][k][1] * v[r][i][k][1] + v[r][i][k][2] * v[r][i][k][2] + v[r][i][k][3] * v[r][i][k][3];
#pragma unroll
            for (int o = 32; o > 0; o >>= 1) ss += __shfl_xor(ss, o);
            const float rstd = rsqrtf(ss * (1.0f / 1024.0f) + EPS);
#pragma unroll
            for (int i = 0; i < 2; ++i) {
                const f32x4 y0 = v[r][i][0] * rstd * gg[i][0] * s1[i][0] + s0[i][0], y1 = v[r][i][1] * rstd * gg[i][1] * s1[i][1] + s0[i][1];
                u32x4 o; o.x = pk_bf16(y0[0], y0[1]); o.y = pk_bf16(y0[2], y0[3]); o.z = pk_bf16(y1[0], y1[1]); o.w = pk_bf16(y1[2], y1[3]);
                *(u32x4*)(h + (size_t)row * 1024 + i * 512 + lane * 8) = o;
            }
        }
    }
}
__device__ void final_norm_phase(const bf16_t* xb, float* out, const float* g) {
    constexpr int NR = 4;
    const int tid_ = opaque_tid(); const int lane = tid_ & 63, w = tid_ >> 6;
    f32x4 gg[2][2];
#pragma unroll
    for (int i = 0; i < 2; ++i) { gg[i][0] = *(const f32x4*)(g + i * 512 + lane * 8); gg[i][1] = *(const f32x4*)(g + i * 512 + lane * 8 + 4); }
    for (int rb = (blockIdx.x * 8 + w) * NR; rb < T; rb += gridDim.x * 8 * NR) {
        u32x4 q[NR][2];
#pragma unroll
        for (int r = 0; r < NR; ++r)
#pragma unroll
            for (int i = 0; i < 2; ++i) q[r][i] = *(const u32x4*)(xb + (size_t)(rb + r) * 1024 + i * 512 + lane * 8);
#pragma unroll
        for (int r = 0; r < NR; ++r) {
            f32x4 v[2][2]; float ss = 0.f;
#pragma unroll
            for (int i = 0; i < 2; ++i) { const u32x4 t = q[r][i]; v[i][0] = (f32x4){bf_lo(t.x), bf_hi(t.x), bf_lo(t.y), bf_hi(t.y)}; v[i][1] = (f32x4){bf_lo(t.z), bf_hi(t.z), bf_lo(t.w), bf_hi(t.w)}; }
#pragma unroll
            for (int i = 0; i < 2; ++i)
#pragma unroll
                for (int k = 0; k < 2; ++k) ss += v[i][k][0] * v[i][k][0] + v[i][k][1] * v[i][k][1] + v[i][k][2] * v[i][k][2] + v[i][k][3] * v[i][k][3];
#pragma unroll
            for (int o = 32; o > 0; o >>= 1) ss += __shfl_xor(ss, o);
            const float rstd = rsqrtf(ss * (1.0f / 1024.0f) + EPS);
#pragma unroll
            for (int i = 0; i < 2; ++i)
#pragma unroll
                for (int k = 0; k < 2; ++k) *(f32x4*)(out + (size_t)(rb + r) * 1024 + i * 512 + lane * 8 + 4 * k) = v[i][k] * rstd * gg[i][k];
        }
    }
}

__device__ void conva_phase(const Args& a, const bf16_t* pa, bf16_t* cat, LAS unsigned char* lds) {
    const int tid = opaque_tid(), lane = tid & 63, w = tid >> 6;
    LAS bf16_t* glu = (LAS bf16_t*)lds;
    LAS float* stage = (LAS float*)(lds + 94 * 512 * 2);
    const float* cw = a.in[11]; const float* cb = a.in[12]; const float* lg = a.in[13]; const float* lb = a.in[14];
    float wt[31];
#pragma unroll
    for (int j = 0; j < 31; ++j) wt[j] = cw[j * 512 + tid];
    const float bias = cb[tid];
    float lgv[8], lbv[8];
#pragma unroll
    for (int i = 0; i < 8; ++i) { lgv[i] = lg[lane + 64 * i]; lbv[i] = lb[lane + 64 * i]; }
    for (int tile = blockIdx.x; tile < 768; tile += gridDim.x) {
        const int seq = tile >> 8, t0 = (tile & 255) * 64;
        __syncthreads();
#pragma unroll 1
        for (int ib = 0; ib < 3; ++ib) {
            u32x4 x1[4], x2[4];
#pragma unroll
            for (int k = 0; k < 4; ++k) {
                const int idx = tid + 512 * (4 * ib + k); const int r = idx >> 6, cc = idx & 63, t = t0 - 15 + r;
                x1[k] = (u32x4){0u, 0u, 0u, 0u}; x2[k] = x1[k];
                if (idx < 94 * 64 && t >= 0 && t < L) { const bf16_t* rp = pa + (size_t)(seq * L + t) * 1024 + cc * 8; x1[k] = *(const u32x4*)rp; x2[k] = *(const u32x4*)(rp + 512); }
            }
#pragma unroll
            for (int k = 0; k < 4; ++k) {
                const int idx = tid + 512 * (4 * ib + k); const int r = idx >> 6, cc = idx & 63;
                u32x4 res;
#pragma unroll
                for (int q = 0; q < 4; ++q) res[q] = pk_bf16(bf_lo(x1[k][q]) * fsigmoid(bf_lo(x2[k][q])), bf_hi(x1[k][q]) * fsigmoid(bf_hi(x2[k][q])));
                if (idx < 94 * 64) *(LAS u32x4*)(glu + r * 512 + cc * 8) = res;
            }
        }
        __syncthreads();
        for (int chunk = 0; chunk < 8; ++chunk) {
            float o[8];
#pragma unroll
            for (int tt = 0; tt < 8; ++tt) o[tt] = bias;
#pragma unroll
            for (int i = 0; i < 38; ++i) {
                const float x = bf2f(glu[(chunk * 8 + i) * 512 + tid]);
#pragma unroll
                for (int tt = 0; tt < 8; ++tt) { const int j = i - tt; if (j >= 0 && j < 31) o[tt] += wt[j] * x; }
            }
#pragma unroll
            for (int tt = 0; tt < 8; ++tt) stage[tt * 512 + tid] = o[tt];
            __syncthreads();
            {
                float v[8]; float s = 0.f;
#pragma unroll
                for (int i = 0; i < 8; ++i) { v[i] = stage[w * 512 + lane + 64 * i]; s += v[i]; }
#pragma unroll
                for (int of = 32; of > 0; of >>= 1) s += __shfl_xor(s, of);
                const float mean = s * (1.0f / 512.0f);
                float q = 0.f;
#pragma unroll
                for (int i = 0; i < 8; ++i) { const float d = v[i] - mean; q += d * d; }
#pragma unroll
                for (int of = 32; of > 0; of >>= 1) q += __shfl_xor(q, of);
                const float rstd = rsqrtf(q * (1.0f / 512.0f) + EPS);
                bf16_t* op = cat + (size_t)(seq * L + t0 + chunk * 8 + w) * 1024;
#pragma unroll
                for (int i = 0; i < 8; ++i) { const float y = (v[i] - mean) * rstd * lgv[i] + lbv[i]; op[lane + 64 * i] = f2bf(y * fsigmoid(y)); }
            }
            __syncthreads();
        }
    }
    __syncthreads();
}

typedef float v2 __attribute__((ext_vector_type(2)));
__device__ __forceinline__ int fphys(int i) { return i + ((i >> 6) << 2); }
struct C2 { v2 r, i; };
__device__ __forceinline__ C2 cmul2(const C2& a, const C2& b) { C2 o; o.r = a.r * b.r - a.i * b.i; o.i = a.r * b.i + a.i * b.r; return o; }
__device__ __forceinline__ C2 cmulc(const C2& a, float cr, float ci) { C2 o; o.r = a.r * cr - a.i * ci; o.i = a.r * ci + a.i * cr; return o; }
template <bool INV> __device__ __forceinline__ void bf4(C2& a, C2& b, C2& c, C2& d) {
    C2 t0, t1, t2, e, t3;
    t0.r = a.r + c.r; t0.i = a.i + c.i; t1.r = a.r - c.r; t1.i = a.i - c.i; t2.r = b.r + d.r; t2.i = b.i + d.i; e.r = b.r - d.r; e.i = b.i - d.i;
    if (INV) { t3.r = -e.i; t3.i = e.r; } else { t3.r = e.i; t3.i = -e.r; }
    a.r = t0.r + t2.r; a.i = t0.i + t2.i; b.r = t1.r + t3.r; b.i = t1.i + t3.i; c.r = t0.r - t2.r; c.i = t0.i - t2.i; d.r = t1.r - t3.r; d.i = t1.i - t3.i;
}
template <bool INV, int K16> __device__ __forceinline__ C2 mulc16(const C2& a) {
    constexpr float cs[10] = {1.0f, 0.92387953251128674f, 0.70710678118654752f, 0.38268343236508977f, 0.0f, -0.38268343236508977f, -0.70710678118654752f, -0.92387953251128674f, -1.0f, -0.92387953251128674f};
    constexpr float sn[10] = {0.0f, 0.38268343236508977f, 0.70710678118654752f, 0.92387953251128674f, 1.0f, 0.92387953251128674f, 0.70710678118654752f, 0.38268343236508977f, 0.0f, -0.38268343236508977f};
    if (K16 == 4) { C2 o; if (INV) { o.r = -a.i; o.i = a.r; } else { o.r = a.i; o.i = -a.r; } return o; }
    return cmulc(a, cs[K16], INV ? sn[K16] : -sn[K16]);
}
template <bool INV, int LOGQ> __device__ __forceinline__ void r16_pass(LAS float* Fre, LAS float* Fim, int tid) {
    constexpr int Q = 1 << LOGQ;
    constexpr int PSTR = (Q >= 64) ? (Q + (Q >> 4)) : Q;
    const int b0 = 2 * tid, pos0 = b0 & (Q - 1), grp = b0 >> LOGQ, base = (grp << (LOGQ + 4)) + pos0;
    const int p = fphys(base);
    C2 x[16];
#pragma unroll
    for (int r = 0; r < 16; ++r) { x[r].r = *(const LAS v2*)(Fre + p + r * PSTR); x[r].i = *(const LAS v2*)(Fim + p + r * PSTR); }
    int posv = pos0; asm volatile("" : "+v"(posv));
    const float rev0 = (float)posv * (1.0f / (float)(16 * Q)), rev1 = (float)(posv + 1) * (1.0f / (float)(16 * Q));
    C2 w1; w1.r = (v2){__builtin_amdgcn_cosf(rev0), __builtin_amdgcn_cosf(rev1)};
    { const v2 sn = (v2){__builtin_amdgcn_sinf(rev0), __builtin_amdgcn_sinf(rev1)}; w1.i = INV ? sn : -sn; }
    const C2 w2 = cmul2(w1, w1), w3 = cmul2(w2, w1), w4 = cmul2(w2, w2), w8 = cmul2(w4, w4), w12 = cmul2(w8, w4);
    if (!INV) {
#pragma unroll
        for (int j = 0; j < 4; ++j) {
            bf4<false>(x[j], x[j + 4], x[j + 8], x[j + 12]);
            x[j + 4] = cmul2(x[j + 4], w1); x[j + 8] = cmul2(x[j + 8], w2); x[j + 12] = cmul2(x[j + 12], w3);
        }
        x[5] = mulc16<false, 1>(x[5]); x[9] = mulc16<false, 2>(x[9]); x[13] = mulc16<false, 3>(x[13]);
        x[6] = mulc16<false, 2>(x[6]); x[10] = mulc16<false, 4>(x[10]); x[14] = mulc16<false, 6>(x[14]);
        x[7] = mulc16<false, 3>(x[7]); x[11] = mulc16<false, 6>(x[11]); x[15] = mulc16<false, 9>(x[15]);
#pragma unroll
        for (int r = 0; r < 4; ++r) {
            bf4<false>(x[4 * r], x[4 * r + 1], x[4 * r + 2], x[4 * r + 3]);
            x[4 * r + 1] = cmul2(x[4 * r + 1], w4); x[4 * r + 2] = cmul2(x[4 * r + 2], w8); x[4 * r + 3] = cmul2(x[4 * r + 3], w12);
        }
    } else {
#pragma unroll
        for (int r = 0; r < 4; ++r) {
            x[4 * r + 1] = cmul2(x[4 * r + 1], w4); x[4 * r + 2] = cmul2(x[4 * r + 2], w8); x[4 * r + 3] = cmul2(x[4 * r + 3], w12);
            bf4<true>(x[4 * r], x[4 * r + 1], x[4 * r + 2], x[4 * r + 3]);
        }
        x[5] = mulc16<true, 1>(x[5]); x[9] = mulc16<true, 2>(x[9]); x[13] = mulc16<true, 3>(x[13]);
        x[6] = mulc16<true, 2>(x[6]); x[10] = mulc16<true, 4>(x[10]); x[14] = mulc16<true, 6>(x[14]);
        x[7] = mulc16<true, 3>(x[7]); x[11] = mulc16<true, 6>(x[11]); x[15] = mulc16<true, 9>(x[15]);
#pragma unroll
        for (int j = 0; j < 4; ++j) {
            x[j + 4] = cmul2(x[j + 4], w1); x[j + 8] = cmul2(x[j + 8], w2); x[j + 12] = cmul2(x[j + 12], w3);
            bf4<true>(x[j], x[j + 4], x[j + 8], x[j + 12]);
        }
    }
#pragma unroll
    for (int r = 0; r < 16; ++r) { *(LAS v2*)(Fre + p + r * PSTR) = x[r].r; *(LAS v2*)(Fim + p + r * PSTR) = x[r].i; }
}
template <bool INV> __device__ __forceinline__ void r4_pass(LAS float* Fre, LAS float* Fim, int tid) {
#pragma unroll 2
    for (int bi = 0; bi < 4; ++bi) {
        const int p = fphys(8 * (tid + 512 * bi));
        const f32x4 ra = *(const LAS f32x4*)(Fre + p), rb = *(const LAS f32x4*)(Fre + p + 4), ia = *(const LAS f32x4*)(Fim + p), ib = *(const LAS f32x4*)(Fim + p + 4);
        C2 x0, x1, x2, x3;
        x0.r = (v2){ra[0], rb[0]}; x1.r = (v2){ra[1], rb[1]}; x2.r = (v2){ra[2], rb[2]}; x3.r = (v2){ra[3], rb[3]};
        x0.i = (v2){ia[0], ib[0]}; x1.i = (v2){ia[1], ib[1]}; x2.i = (v2){ia[2], ib[2]}; x3.i = (v2){ia[3], ib[3]};
        bf4<INV>(x0, x1, x2, x3);
        *(LAS f32x4*)(Fre + p) = (f32x4){x0.r[0], x1.r[0], x2.r[0], x3.r[0]}; *(LAS f32x4*)(Fre + p + 4) = (f32x4){x0.r[1], x1.r[1], x2.r[1], x3.r[1]};
        *(LAS f32x4*)(Fim + p) = (f32x4){x0.i[0], x1.i[0], x2.i[0], x3.i[0]}; *(LAS f32x4*)(Fim + p + 4) = (f32x4){x0.i[1], x1.i[1], x2.i[1], x3.i[1]};
    }
}
__device__ __forceinline__ void fft_fwd(LAS float* Fre, LAS float* Fim, int tid) {
    r16_pass<false, 10>(Fre, Fim, tid); __syncthreads(); r16_pass<false, 6>(Fre, Fim, tid); __syncthreads(); r16_pass<false, 2>(Fre, Fim, tid); __syncthreads(); r4_pass<false>(Fre, Fim, tid);
}
__device__ __forceinline__ void fft_inv(LAS float* Fre, LAS float* Fim, int tid) {
    r4_pass<true>(Fre, Fim, tid); __syncthreads(); r16_pass<true, 2>(Fre, Fim, tid); __syncthreads(); r16_pass<true, 6>(Fre, Fim, tid); __syncthreads(); r16_pass<true, 10>(Fre, Fim, tid);
}
typedef _Float16 h8v __attribute__((ext_vector_type(8)));
__device__ __forceinline__ void sconv8(const bf16_t* row, int n0, float w0, float w1, float w2, float b, float (&out)[8]) {
    const u32x4 q = *(const u32x4*)(row + n0);
    float x[10];
    x[0] = n0 > 0 ? bf2f(row[n0 - 1]) : 0.f;
    x[9] = n0 + 8 < L ? bf2f(row[n0 + 8]) : 0.f;
#pragma unroll
    for (int i = 0; i < 4; ++i) { x[1 + 2 * i] = bf_lo(q[i]); x[2 + 2 * i] = bf_hi(q[i]); }
#pragma unroll
    for (int e = 0; e < 8; ++e) out[e] = b + w0 * x[e] + w1 * x[e + 1] + w2 * x[e + 2];
}
struct Raw8 { u32x4 q; unsigned short lo, hi; };
__device__ __forceinline__ Raw8 raw8_load(const bf16_t* row, int n0) {
    Raw8 r; r.q = *(const u32x4*)(row + n0);
    r.lo = n0 > 0 ? row[n0 - 1] : (unsigned short)0; r.hi = n0 + 8 < L ? row[n0 + 8] : (unsigned short)0;
    return r;
}
__device__ __forceinline__ void sconv8_raw(const Raw8& r, float w0, float w1, float w2, float b, float (&out)[8]) {
    float x[10];
    x[0] = bf2f(r.lo); x[9] = bf2f(r.hi);
#pragma unroll
    for (int i = 0; i < 4; ++i) { x[1 + 2 * i] = bf_lo(r.q[i]); x[2 + 2 * i] = bf_hi(r.q[i]); }
#pragma unroll
    for (int e = 0; e < 8; ++e) out[e] = b + w0 * x[e] + w1 * x[e + 1] + w2 * x[e + 2];
}
template <bool CONJ> __device__ __forceinline__ void tw8(int n0, float (&tr)[8], float (&ti)[8]) {
    const float rev = (float)n0 * (1.0f / (float)(2 * L));
    const float sr = 0.99999998161642933f, si = CONJ ? 1.9174759731070330e-4f : -1.9174759731070330e-4f;
    tr[0] = __builtin_amdgcn_cosf(rev); ti[0] = CONJ ? __builtin_amdgcn_sinf(rev) : -__builtin_amdgcn_sinf(rev);
#pragma unroll
    for (int e = 1; e < 8; ++e) { tr[e] = tr[e - 1] * sr - ti[e - 1] * si; ti[e] = tr[e - 1] * si + ti[e - 1] * sr; }
}
__device__ __forceinline__ void st8(LAS float* p, const float (&v)[8]) { *(LAS f32x4*)p = (f32x4){v[0], v[1], v[2], v[3]}; *(LAS f32x4*)(p + 4) = (f32x4){v[4], v[5], v[6], v[7]}; }
__device__ __forceinline__ void ld8(const LAS float* p, float (&v)[8]) { const f32x4 a = *(const LAS f32x4*)p, b = *(const LAS f32x4*)(p + 4);
#pragma unroll
    for (int e = 0; e < 4; ++e) { v[e] = a[e]; v[4 + e] = b[e]; } }
template <bool DRY> __device__ void fft_phase(const Args& a, bf16_t* pbT, LAS unsigned char* lds) {
    const int tid = opaque_tid(), lane = tid & 63, w = tid >> 6;
    LAS float* Fre = (LAS float*)lds; LAS float* Fim = Fre + 17408;
    LAS float* red = (LAS float*)(lds + 17408 * 8);
    const int po = fphys(8 * tid);
    const half_t* KT = (const half_t*)(a.ws + WS_KT);
    unsigned char* scr = a.ws + WS_ACT + PBT_BYTES + (size_t)blockIdx.x * FFTSCR_PER_BLOCK;
    float* ybuf = (float*)scr;
    float* z1buf = (float*)(scr + 2ull * L * 8);
    const float* sw = a.in[15]; const float* sb = a.in[16]; const float* skip = a.in[23];
    for (int ch = blockIdx.x; ch < 512; ch += gridDim.x) {
        const float vw0 = sw[ch], vw1 = sw[1536 + ch], vw2 = sw[3072 + ch], vb = sb[ch];
#pragma unroll 1
        for (int o = 0; o < 2; ++o) {
            const half_t* kf = KT + ((size_t)((o * 512 + ch) * 2) << 14); const half_t* kb = kf + L;
            const int xc = (o == 0 ? 512 : 1024) + ch;
            const float gw0 = sw[xc], gw1 = sw[1536 + xc], gw2 = sw[3072 + xc], gb = sb[xc];
            const float skp = skip[o * 512 + ch];
            float ss = 0.f;
#pragma unroll 1
            for (int g = 0; g < 4; ++g) {
                const int n0 = 8 * (tid + 512 * g);
                const h8v f = *(const h8v*)(kf + n0), bk = *(const h8v*)(kb + n0);
#pragma unroll
                for (int e = 0; e < 8; ++e) { const float ff = (float)f[e], bb = (n0 + e > 0) ? (float)bk[e] : 0.f; ss += ff * ff + bb * bb; }
            }
#pragma unroll
            for (int of = 32; of > 0; of >>= 1) ss += __shfl_xor(ss, of);
            __syncthreads();
            if (lane == 0) red[w] = ss;
            __syncthreads();
            float tot = 0.f;
#pragma unroll
            for (int ww = 0; ww < 8; ++ww) tot += red[ww];
            const float kscale = rsqrtf(tot + EPS) * (0.5f / (float)L);
#pragma unroll 1
            for (int br = 0; br < 2; ++br) {
                __syncthreads();
#pragma unroll 1
                for (int g = 0; g < 4; ++g) {
                    const int n0 = 8 * (tid + 512 * g);
                    const h8v f = *(const h8v*)(kf + n0), bc = *(const h8v*)(kb + (L - 8 - n0));
                    const float b0 = n0 > 0 ? (float)kb[L - n0] : 0.f;
                    float d[8], vr[8], vi[8];
#pragma unroll
                    for (int e = 0; e < 8; ++e) { const float bk = (e == 0) ? b0 : (float)bc[8 - e]; d[e] = (br == 0 ? (float)f[e] + bk : (float)f[e] - bk) * kscale; }
                    if (br == 0) {
#pragma unroll
                        for (int e = 0; e < 8; ++e) { vr[e] = d[e]; vi[e] = 0.f; }
                    } else {
                        float tr[8], ti[8]; tw8<false>(n0, tr, ti);
#pragma unroll
                        for (int e = 0; e < 8; ++e) { vr[e] = d[e] * tr[e]; vi[e] = d[e] * ti[e]; }
                    }
                    st8(Fre + po + 4352 * g, vr); st8(Fim + po + 4352 * g, vi);
                }
                __syncthreads();
                fft_fwd(Fre, Fim, tid);
                __syncthreads();
                float KrR[32], KrI[32];
#pragma unroll
                for (int g = 0; g < 4; ++g) {
                    const f32x4 r0 = *(const LAS f32x4*)(Fre + po + 4352 * g), r1 = *(const LAS f32x4*)(Fre + po + 4352 * g + 4), i0 = *(const LAS f32x4*)(Fim + po + 4352 * g), i1 = *(const LAS f32x4*)(Fim + po + 4352 * g + 4);
#pragma unroll
                    for (int e = 0; e < 4; ++e) { KrR[g * 8 + e] = r0[e]; KrR[g * 8 + 4 + e] = r1[e]; KrI[g * 8 + e] = i0[e]; KrI[g * 8 + 4 + e] = i1[e]; }
                }
#pragma unroll 1
                for (int pk = 0; pk < 2; ++pk) {
                    __syncthreads();
#pragma unroll 1
                    for (int g = 0; g < 4; ++g) {
                        const int n0 = 8 * (tid + 512 * g);
                        float re[8], im[8];
                        if (o == 0) {
                            sconv8(pbT + ((size_t)((2 * pk) * 1536 + ch) << 14), n0, vw0, vw1, vw2, vb, re);
                            if (pk == 0) sconv8(pbT + ((size_t)(1536 + ch) << 14), n0, vw0, vw1, vw2, vb, im);
                        } else {
                            const f32x4 r0 = *(const f32x4*)(z1buf + (2 * pk) * L + n0), r1 = *(const f32x4*)(z1buf + (2 * pk) * L + n0 + 4);
#pragma unroll
                            for (int e = 0; e < 4; ++e) { re[e] = r0[e]; re[4 + e] = r1[e]; }
                            if (pk == 0) { const f32x4 i0 = *(const f32x4*)(z1buf + L + n0), i1 = *(const f32x4*)(z1buf + L + n0 + 4);
#pragma unroll
                                for (int e = 0; e < 4; ++e) { im[e] = i0[e]; im[4 + e] = i1[e]; } }
                        }
                        if (pk == 1) {
#pragma unroll
                            for (int e = 0; e < 8; ++e) im[e] = 0.f;
                        }
                        if (br == 1) {
                            float tr[8], ti[8]; tw8<false>(n0, tr, ti);
#pragma unroll
                            for (int e = 0; e < 8; ++e) { const float xr = re[e] * tr[e] - im[e] * ti[e], xi = re[e] * ti[e] + im[e] * tr[e]; re[e] = xr; im[e] = xi; }
                        }
                        st8(Fre + po + 4352 * g, re); st8(Fim + po + 4352 * g, im);
                    }
                    __syncthreads();
                    fft_fwd(Fre, Fim, tid);
                    __syncthreads();
#pragma unroll
                    for (int g = 0; g < 4; ++g) {
                        float xr[8], xi[8], yr[8], yi[8];
                        ld8(Fre + po + 4352 * g, xr); ld8(Fim + po + 4352 * g, xi);
#pragma unroll
                        for (int e = 0; e < 8; ++e) { yr[e] = xr[e] * KrR[g * 8 + e] - xi[e] * KrI[g * 8 + e]; yi[e] = xr[e] * KrI[g * 8 + e] + xi[e] * KrR[g * 8 + e]; }
                        st8(Fre + po + 4352 * g, yr); st8(Fim + po + 4352 * g, yi);
                    }
                    __syncthreads();
                    fft_inv(Fre, Fim, tid);
                    __syncthreads();
#pragma unroll 1
                    for (int g = 0; g < 4; ++g) {
                        const int n0 = 8 * (tid + 512 * g);
                        float rr[8], ri[8];
                        ld8(Fre + po + 4352 * g, rr); ld8(Fim + po + 4352 * g, ri);
                        float* ybr = ybuf + (size_t)pk * 2 * L + n0; float* ybi = ybr + L;
                        if (br == 0) {
                            *(f32x4*)ybr = (f32x4){rr[0], rr[1], rr[2], rr[3]}; *(f32x4*)(ybr + 4) = (f32x4){rr[4], rr[5], rr[6], rr[7]};
                            *(f32x4*)ybi = (f32x4){ri[0], ri[1], ri[2], ri[3]}; *(f32x4*)(ybi + 4) = (f32x4){ri[4], ri[5], ri[6], ri[7]};
                        } else {
                            const f32x4 yr0 = *(const f32x4*)ybr, yr1 = *(const f32x4*)(ybr + 4), yi0 = *(const f32x4*)ybi, yi1 = *(const f32x4*)(ybi + 4);
                            const int s0 = 2 * pk;
                            Raw8 gt0 = raw8_load(pbT + ((size_t)(s0 * 1536 + xc) << 14), n0), gt1 = gt0, vt0 = gt0, vt1 = gt0;
                            f32x4 za0 = yr0, za1 = yr0, zb0 = yr0, zb1 = yr0;
                            if (pk == 0) gt1 = raw8_load(pbT + ((size_t)(1536 + xc) << 14), n0);
                            if (o == 0) { vt0 = raw8_load(pbT + ((size_t)(s0 * 1536 + ch) << 14), n0); if (pk == 0) vt1 = raw8_load(pbT + ((size_t)(1536 + ch) << 14), n0); }
                            else { za0 = *(const f32x4*)(z1buf + s0 * L + n0); za1 = *(const f32x4*)(z1buf + s0 * L + n0 + 4); if (pk == 0) { zb0 = *(const f32x4*)(z1buf + L + n0); zb1 = *(const f32x4*)(z1buf + L + n0 + 4); } }
                            float tr[8], ti[8]; tw8<true>(n0, tr, ti);
                            float yre[8], yim[8];
#pragma unroll
                            for (int e = 0; e < 8; ++e) {
                                yre[e] = (e < 4 ? yr0[e & 3] : yr1[e & 3]) + rr[e] * tr[e] - ri[e] * ti[e];
                                yim[e] = (e < 4 ? yi0[e & 3] : yi1[e & 3]) + rr[e] * ti[e] + ri[e] * tr[e];
                            }
                            const int nseq = (pk == 0) ? 2 : 1;
#pragma unroll
                            for (int q = 0; q < 2; ++q) if (q < nseq) {
                                const int s = 2 * pk + q;
                                float gate[8];
                                sconv8_raw(q == 0 ? gt0 : gt1, gw0, gw1, gw2, gb, gate);
                                float* zp = z1buf + s * L + n0;
                                float z[8];
                                if (o == 0) {
                                    float vv[8];
                                    sconv8_raw(q == 0 ? vt0 : vt1, vw0, vw1, vw2, vb, vv);
#pragma unroll
                                    for (int e = 0; e < 8; ++e) z[e] = gate[e] * ((q == 0 ? yre[e] : yim[e]) + vv[e] * skp);
                                    *(f32x4*)zp = (f32x4){z[0], z[1], z[2], z[3]}; *(f32x4*)(zp + 4) = (f32x4){z[4], z[5], z[6], z[7]};
                                } else {
                                    const f32x4 z0 = q == 0 ? za0 : zb0, z1 = q == 0 ? za1 : zb1;
#pragma unroll
                                    for (int e = 0; e < 8; ++e) z[e] = gate[e] * ((q == 0 ? yre[e] : yim[e]) + (e < 4 ? z0[e & 3] : z1[e & 3]) * skp);
                                    u32x4 wv; wv.x = pk_bf16(z[0], z[1]); wv.y = pk_bf16(z[2], z[3]); wv.z = pk_bf16(z[4], z[5]); wv.w = pk_bf16(z[6], z[7]);
                                    if (!DRY) *(u32x4*)(pbT + ((size_t)(s * 1536 + ch) << 14) + n0) = wv;
                                }
                            }
                        }
                    }
                }
            }
            __syncthreads();
        }
    }
    __syncthreads();
}

__device__ void ztrans_phase(const bf16_t* pbT, bf16_t* cat, LAS unsigned char* lds) {
    const int tid = opaque_tid();
    LAS unsigned* tl = (LAS unsigned*)lds;
    LAS bf16_t* tb = (LAS bf16_t*)lds;
    for (int tile0 = blockIdx.x * 2; tile0 < 6144; tile0 += gridDim.x * 2) {
        __syncthreads();
        u32x4 v[2];
#pragma unroll
        for (int k = 0; k < 2; ++k) { const int tile = tile0 + k; const int tt0 = (tile & 255) * 64, ct = (tile >> 8) & 7, s = tile >> 11; const int cc = tid >> 3, tk = (tid & 7) * 8;
            v[k] = *(const u32x4*)(pbT + ((size_t)(s * 1536 + ct * 64 + cc) << 14) + tt0 + tk); }
#pragma unroll
        for (int k = 0; k < 2; ++k) { const int cc = tid >> 3, tk = (tid & 7) * 8;
#pragma unroll
            for (int q = 0; q < 4; ++q) tl[k * 2112 + cc * 33 + (tk >> 1) + q] = v[k][q]; }
        __syncthreads();
#pragma unroll
        for (int k = 0; k < 2; ++k) { const int tile = tile0 + k; const int tt0 = (tile & 255) * 64, ct = (tile >> 8) & 7, s = tile >> 11;
            const int tt = tid >> 3, cg8 = (tid & 7) * 8; bf16_t e[8];
#pragma unroll
            for (int i = 0; i < 8; ++i) e[i] = tb[k * 4224 + (cg8 + i) * 66 + tt];
            u32x4 wv; wv.x = e[0] | ((unsigned)e[1] << 16); wv.y = e[2] | ((unsigned)e[3] << 16); wv.z = e[4] | ((unsigned)e[5] << 16); wv.w = e[6] | ((unsigned)e[7] << 16);
            *(u32x4*)(cat + (size_t)(s * L + tt0 + tt) * 1024 + 512 + ct * 64 + cg8) = wv; }
    }
    __syncthreads();
}

typedef unsigned u2v __attribute__((ext_vector_type(2)));
__device__ __forceinline__ u2v xchg32(float x) { const unsigned xi = __float_as_uint(x); return __builtin_amdgcn_permlane32_swap(xi, xi, false, false); }
__device__ void attn_phase(const Args& a, const bf16_t* qkv, bf16_t* ao, LAS unsigned char* lds) {
    const int tid = opaque_tid(), lane = tid & 63, w = tid >> 6, l31 = lane & 31, hh = lane >> 5;
    LAS bf16_t* Ks = (LAS bf16_t*)lds;
    LAS bf16_t* VT = (LAS bf16_t*)(lds + 384 * 72 * 2);
    const float* sink = a.in[26];
    for (int item = blockIdx.x; item < 1536; item += gridDim.x) {
        const int kvh = item & 3, qb = (item >> 2) & 127, seq = item >> 9;
        const int kb0 = qb * 128 - 128;
        __syncthreads();
#pragma unroll 1
        for (int ib = 0; ib < 2; ++ib) {
            u32x4 kv[3], vv[3];
#pragma unroll
            for (int k = 0; k < 3; ++k) {
                const int idx = tid + 512 * (3 * ib + k); const int key = idx % 384, dc = idx / 384, kpos = kb0 + key;
                kv[k] = (u32x4){0u, 0u, 0u, 0u}; vv[k] = kv[k];
                if (kpos >= 0 && kpos < L) { const bf16_t* rp = qkv + (size_t)(seq * L + kpos) * 1536 + kvh * 64 + dc * 8; kv[k] = *(const u32x4*)(rp + 1024); vv[k] = *(const u32x4*)(rp + 1280); }
            }
#pragma unroll
            for (int k = 0; k < 3; ++k) {
                const int idx = tid + 512 * (3 * ib + k); const int key = idx % 384, dc = idx / 384;
                *(LAS u32x4*)(Ks + key * 72 + dc * 8) = kv[k];
#pragma unroll
                for (int i = 0; i < 8; ++i) VT[(dc * 8 + i) * 392 + key] = (bf16_t)((vv[k][i >> 1] >> (16 * (i & 1))) & 0xffffu);
            }
        }
        __syncthreads();
        for (int uu = 0; uu < 2; ++uu) {
            const int u = w + 8 * uu, g = u >> 2, qs = u & 3, h = kvh * 4 + g, q0 = qb * 128 + 32 * qs;
            bf16x8 qf[4];
            const bf16_t* qp = qkv + (size_t)(seq * L + q0 + l31) * 1536 + h * 64 + 8 * hh;
#pragma unroll
            for (int ks = 0; ks < 4; ++ks) qf[ks] = *(const bf16x8*)(qp + 16 * ks);
            const float LOG2E = 1.4426950408889634f;
            const float c1 = 0.125f * LOG2E, slope2 = exp2f(-0.5f * (float)(h + 1)) * LOG2E, nslope2 = -slope2;
            float m = sink[h] * LOG2E, lsum = 1.0f;
            const bool edge = (qb == 0) || (qb == 127);
            f32x16 O0, O1;
#pragma unroll
            for (int r = 0; r < 16; ++r) { O0[r] = 0.f; O1[r] = 0.f; }
#pragma unroll 1
            for (int kt = 0; kt < 9; ++kt) {
                const int kl0 = 32 * qs + 32 * kt;
                f32x16 S;
#pragma unroll
                for (int r = 0; r < 16; ++r) S[r] = 0.f;
#pragma unroll
                for (int ks = 0; ks < 4; ++ks) { const bf16x8 af = *(const LAS bf16x8*)(Ks + (kl0 + l31) * 72 + 16 * ks + 8 * hh); S = __builtin_amdgcn_mfma_f32_32x32x16_bf16(af, qf[ks], S, 0, 0, 0); }
                float p[16]; float mt = -1e30f;
                float dbase = (float)(32 * kt - 128 + 4 * hh - l31);
                asm volatile("" : "+v"(dbase));
                if (kt == 0 || kt == 8 || edge) {
#pragma unroll
                    for (int r = 0; r < 16; ++r) {
                        const int i = 8 * (r >> 2) + 4 * hh + (r & 3);
                        const int kpos = q0 - 128 + 32 * kt + i;
                        const float ad = __builtin_fabsf(dbase + (float)(8 * (r >> 2) + (r & 3)));
                        const bool valid = (ad <= 128.0f) && (kpos >= 0) && (kpos < L);
                        p[r] = valid ? (S[r] * c1 - slope2 * ad) : -1e30f;
                        mt = fmaxf(mt, p[r]);
                    }
                } else {
#pragma unroll
                    for (int r = 0; r < 16; ++r) {
                        const float bias = __builtin_fabsf(dbase + (float)(8 * (r >> 2) + (r & 3))) * nslope2;
                        p[r] = __builtin_fmaf(S[r], c1, bias);
                        mt = fmaxf(mt, p[r]);
                    }
                }
                { const u2v e = xchg32(mt); mt = fmaxf(__uint_as_float(e.x), __uint_as_float(e.y)); }
                const float mnew = (mt > m + 6.0f) ? mt : m;
                if (__builtin_amdgcn_ballot_w64(mnew != m) != 0ull) {
                    const float alpha = __builtin_amdgcn_exp2f(m - mnew);
                    lsum *= alpha;
#pragma unroll
                    for (int r = 0; r < 16; ++r) { O0[r] *= alpha; O1[r] *= alpha; }
                    m = mnew;
                }
                float rs = 0.f;
#pragma unroll
                for (int r = 0; r < 16; ++r) { p[r] = __builtin_amdgcn_exp2f(p[r] - m); rs += p[r]; }
                { const u2v e = xchg32(rs); rs = __uint_as_float(e.x) + __uint_as_float(e.y); }
                lsum += rs;
#pragma unroll
                for (int kk = 0; kk < 2; ++kk) {
                    u32x4 pw; pw.x = pk_bf16(p[8 * kk], p[8 * kk + 1]); pw.y = pk_bf16(p[8 * kk + 2], p[8 * kk + 3]); pw.z = pk_bf16(p[8 * kk + 4], p[8 * kk + 5]); pw.w = pk_bf16(p[8 * kk + 6], p[8 * kk + 7]);
                    const bf16x8 pf = __builtin_bit_cast(bf16x8, pw);
#pragma unroll
                    for (int dt = 0; dt < 2; ++dt) {
                        const LAS bf16_t* vp = VT + (32 * dt + l31) * 392 + kl0 + 16 * kk + 4 * hh;
                        const u32x2 lo = *(const LAS u32x2*)vp, hi = *(const LAS u32x2*)(vp + 8);
                        const bf16x8 vf = __builtin_bit_cast(bf16x8, (u32x4){lo.x, lo.y, hi.x, hi.y});
                        if (dt == 0) O0 = __builtin_amdgcn_mfma_f32_32x32x16_bf16(vf, pf, O0, 0, 0, 0);
                        else O1 = __builtin_amdgcn_mfma_f32_32x32x16_bf16(vf, pf, O1, 0, 0, 0);
                    }
                }
            }
            const float inv = 1.0f / lsum;
            unsigned char* rowb = (unsigned char*)(ao + (size_t)(seq * L + q0 + l31) * 1024 + h * 64) + (hh ? 16 : 0);
#pragma unroll
            for (int k = 0; k < 8; k += 2) {
                u32x2 pa, pb;
                if (k < 4) { pa.x = pk_bf16(O0[4 * k] * inv, O0[4 * k + 1] * inv); pa.y = pk_bf16(O0[4 * k + 2] * inv, O0[4 * k + 3] * inv);
                             pb.x = pk_bf16(O0[4 * k + 4] * inv, O0[4 * k + 5] * inv); pb.y = pk_bf16(O0[4 * k + 6] * inv, O0[4 * k + 7] * inv); }
                else { pa.x = pk_bf16(O1[4 * (k - 4)] * inv, O1[4 * (k - 4) + 1] * inv); pa.y = pk_bf16(O1[4 * (k - 4) + 2] * inv, O1[4 * (k - 4) + 3] * inv);
                       pb.x = pk_bf16(O1[4 * (k - 4) + 4] * inv, O1[4 * (k - 4) + 5] * inv); pb.y = pk_bf16(O1[4 * (k - 4) + 6] * inv, O1[4 * (k - 4) + 7] * inv); }
                const u2v rx = __builtin_amdgcn_permlane32_swap(pa.x, pb.x, false, false), ry = __builtin_amdgcn_permlane32_swap(pa.y, pb.y, false, false);
                *(u32x4*)(rowb + 16 * k) = (u32x4){rx.x, ry.x, rx.y, ry.y};
            }
        }
    }
    __syncthreads();
}

__global__ void __launch_bounds__(512, 2) mega(Args a) {
    extern __shared__ __attribute__((aligned(16))) unsigned char lds_raw[];
    LAS unsigned char* lds = (LAS unsigned char*)lds_raw;
    unsigned char* ws = a.ws;
    const int lo = a.ph_lo, hi = a.ph_hi;
    bf16_t* XB = (bf16_t*)(ws + WS_H);
    const float* mod = (const float*)(ws + WS_MOD);
    bf16_t* H = (bf16_t*)a.out;
    bf16_t* ACT = (bf16_t*)(ws + WS_ACT);
    bf16_t* PBT = ACT;
    bf16_t* PA = (bf16_t*)(ws + WS_ACT + PBT_BYTES);
    const int G = gridDim.x, bx = blockIdx.x;
    volatile LAS unsigned* bst = (volatile LAS unsigned*)(lds + LDS_BYTES - 16);
    if (threadIdx.x < 4) bst[threadIdx.x] = 0u;
    __syncthreads();
    const XcdBarrier xbar = xcd_barrier_post((unsigned*)(ws + WS_BAR), bst);
#define GSYNC() xcd_barrier(xbar)
#define IN(k) (lo <= (k) && (k) < hi)
#define SEAM(k) do { if (IN(k) && IN((k) + 1)) { GSYNC(); if ((RM >> 15) & 1) GSYNC(); } } while (0)
    int ph = 0;
    if (IN(0)) REP(0) { if (EN(0)) convert_weights(a, (LAS float*)lds); if (EN(1)) ada_phase(a, (LAS float*)lds); if (EN(2)) filter_phase(a, (LAS float*)lds); }
    if (IN(0) && IN(1)) cg::this_grid().sync();
    ph = 1;
#pragma unroll 1
    for (int layer = 0; layer < 2; ++layer) {
        const float* ml = mod + (size_t)layer * 3 * 9216;
        const float* ng = a.in[6] + layer * 3 * 1024;
#pragma unroll 1
        for (int sub = 0; sub < 3; ++sub) {
            const bool first = (layer == 0 && sub == 0);
            const float* xs0 = a.in[0]; const float* xs1 = a.in[1];
            const float* shp = ml + (3 * sub) * 1024; const float* scp = shp + 1024; const float* gp = shp + 2048;
            if (EN(3) && IN(ph)) REP(3) { if (first) norm_phase<true>(xs0, xs1, XB, ng + sub * 1024, shp, scp, H); else norm_phase<false>(xs0, xs1, XB, ng + sub * 1024, shp, scp, H); }
            SEAM(ph); ++ph;
            if (sub != 1) {
                const int fi = layer * 2 + (sub == 2 ? 1 : 0);
                if (EN(4) && IN(ph)) REP(4) { pg8::Gemm g{H, (const bf16_t*)(ws + WS_WIN) + (size_t)fi * 5632 * 1024, T, 5632, 1024}; pg8::StaticOrder S; S.init(T, 5632, G, bx);
                    EpiSwiglu E{ACT}; pg8::gemm_phase<EpiSwiglu>(lds, g, S, E); }
                if (layer == 0 && IN(ph)) convert_tail(a, (LAS float*)lds, sub == 0 ? 0 : 2, 4224);
                SEAM(ph); ++ph;
                if (EN(5) && IN(ph)) { pg8::Gemm g{ACT, (const bf16_t*)(ws + WS_WOUT) + (size_t)fi * 1024 * 2816, T, 1024, DFF}; pg8::StaticOrder S; S.init(T, 1024, G, bx);
                    if (first) { EpiResid<true> E{xs0, xs1, XB, XB, gp, 0.5f}; pg8::gemm_phase<EpiResid<true>>(lds, g, S, E); } else { EpiResid<false> E{xs0, xs1, XB, XB, gp, 0.5f}; pg8::gemm_phase<EpiResid<false>>(lds, g, S, E); } }
                SEAM(ph); ++ph;
            } else if (layer == 0) {
                if (EN(6) && IN(ph)) REP(6) { pg8::Gemm g{H, (const bf16_t*)(ws + WS_WABIN), T, 2560, 1024}; pg8::StaticOrder S; S.init(T, 2560, G, bx);
                    EpiProj E{PA, PBT}; pg8::gemm_phase<EpiProj>(lds, g, S, E); }
                if (IN(ph)) convert_tail(a, (LAS float*)lds, 1, 1920);
                SEAM(ph); ++ph;
                if (IN(ph)) { if (EN(7)) REP(7) conva_phase(a, PA, H, lds); GSYNC(); if ((RM >> 8) & 1) fft_phase<true>(a, PBT, lds); if (EN(8)) fft_phase<false>(a, PBT, lds); }
                SEAM(ph); ++ph;
                if (EN(9) && IN(ph)) REP(9) ztrans_phase(PBT, H, lds);
                SEAM(ph); ++ph;
                if (EN(5) && IN(ph)) { pg8::Gemm g{H, (const bf16_t*)(ws + WS_WABOUT), T, 1024, 1024}; pg8::StaticOrder S; S.init(T, 1024, G, bx);
                    EpiResid<false> E{xs0, xs1, XB, XB, gp, 1.0f}; pg8::gemm_phase<EpiResid<false>>(lds, g, S, E); }
                SEAM(ph); ++ph;
            } else {
                if (EN(10) && IN(ph)) REP(10) { pg8::Gemm g{H, (const bf16_t*)(ws + WS_WQKV), T, 1536, 1024}; pg8::StaticOrder S; S.init(T, 1536, G, bx);
                    EpiBf16 E{ACT, 1536}; pg8::gemm_phase<EpiBf16>(lds, g, S, E); }
                SEAM(ph); ++ph;
                if (EN(11) && IN(ph)) REP(11) attn_phase(a, ACT, H, lds);
                SEAM(ph); ++ph;
                if (EN(5) && IN(ph)) { pg8::Gemm g{H, (const bf16_t*)(ws + WS_WATTO), T, 1024, 1024}; pg8::StaticOrder S; S.init(T, 1024, G, bx);
                    EpiResid<false> E{xs0, xs1, XB, XB, gp, 1.0f}; pg8::gemm_phase<EpiResid<false>>(lds, g, S, E); }
                SEAM(ph); ++ph;
            }
        }
    }
    if (EN(12) && IN(ph)) final_norm_phase(XB, a.out, a.in[9]);
#undef IN
#undef SEAM
}

extern "C" void kernel_launch(void* const* d_in, const int* in_sizes, int n_in, void* d_out, int out_size, void* d_ws, size_t ws_size, hipStream_t stream) {
    static int grid = 0;
    if (grid == 0) {
        int dev = 0, cus = 0, per_cu = 0;
        (void)hipGetDevice(&dev);
        (void)hipDeviceGetAttribute(&cus, hipDeviceAttributeMultiprocessorCount, dev);
        (void)hipFuncSetAttribute((const void*)mega, hipFuncAttributeMaxDynamicSharedMemorySize, LDS_BYTES);
        (void)hipOccupancyMaxActiveBlocksPerMultiprocessor(&per_cu, (const void*)mega, 512, LDS_BYTES);
        if (per_cu < 1) per_cu = 1;
        grid = cus * per_cu;
        if (grid > 256) grid = 256;
        if (ws_size < WS_END) { fprintf(stderr, "workspace too small: %zu < %zu\n", ws_size, (size_t)WS_END); grid = -1; }
    }
    if (grid < 0) return;
    Args a{};
    for (int i = 0; i < 28; ++i) a.in[i] = (const float*)d_in[i];
    a.out = (float*)d_out; a.ws = (unsigned char*)d_ws;
    (void)hipMemsetAsync((unsigned char*)d_ws + WS_BAR, 0, XCD_BAR_WORDS * 4, stream);
#if N_LAUNCH_MODE == 1
    a.ph_lo = 0; a.ph_hi = NPH;
    void* args[] = {&a};
    hipError_t e = hipLaunchCooperativeKernel((const void*)mega, dim3(grid), dim3(512), args, LDS_BYTES, stream);
    if (e != hipSuccess) fprintf(stderr, "cooperative launch failed: %s (grid %d)\n", hipGetErrorString(e), grid);
#else
    for (int p = 0; p < NPH; ++p) { a.ph_lo = p; a.ph_hi = p + 1; hipLaunchKernelGGL(mega, dim3(grid), dim3(512), LDS_BYTES, stream, a); }
#endif
}
```
